# Optimizing an MI355X kernel written in HIP

```python
import math
import jax
import jax.numpy as jnp
from jax import lax
import numpy as np

D_MODEL = 1024
BATCH = 8
SEQ = 4096
DEPTH = 4

GRID_W = 64
CTX_LEN = 256
N_MIXERS = 4
W_GROUP = D_MODEL // N_MIXERS
HEAD_DIM = 64
SHORT_CONV = 3
GDN_HEADS = W_GROUP // HEAD_DIM
GDN_CHUNK = 64
HY_BANDS = 16
HY_EMB = 2 * HY_BANDS + 1
HY_HIDDEN = 64
HY_FILTER_INIT = 0.005
HG_HEADS = W_GROUP // HEAD_DIM
HG_DK = HEAD_DIM
HG_CHUNK = 64
DA_HEADS = W_GROUP // HEAD_DIM
DA_DK = HEAD_DIM // 2
Q_BLOCK = 128
ROPE_THETA = 10000.0
D_FF = 4 * D_MODEL
EPS = 1e-6

GDN_COLS = 4 * W_GROUP + 4 * GDN_HEADS
HY_COLS = 3 * W_GROUP
HG_COLS = 5 * W_GROUP
DA_COLS = 3 * W_GROUP
GROUP_COLS = (GDN_COLS, HY_COLS, HG_COLS, DA_COLS)
P_IN = GDN_COLS + HY_COLS + HG_COLS + DA_COLS

kernel_name = 'hybrid_parallel_heads_flow_block'


def _split(t, sizes):
    return jnp.split(t, np.cumsum(sizes)[:-1].tolist(), axis=-1)


def rms_norm(x, w):
    xf = x.astype(jnp.float32)
    y = xf * lax.rsqrt(jnp.mean(xf * xf, axis=-1, keepdims=True) + EPS)
    return (y * w.astype(jnp.float32)).astype(x.dtype)


def l2_norm(x):
    xf = x.astype(jnp.float32)
    return xf * lax.rsqrt(jnp.sum(xf * xf, axis=-1, keepdims=True) + EPS)


def modulate(x, norm_w, shift, scale):
    return rms_norm(x, norm_w) * (1.0 + scale) + shift


def conv_centred(u, w):
    k, ch = w.shape
    return lax.conv_general_dilated(u, w.reshape(k, 1, ch).astype(u.dtype), window_strides=(1,),
                                    padding=[(k // 2, k // 2)], dimension_numbers=('NWC', 'WIO', 'NWC'),
                                    feature_group_count=ch)


def _flip(t, d):
    return t if d == 0 else jnp.flip(t, axis=1)


def _to_chunks(t, size):
    b, n, h = t.shape[:3]
    t = t.reshape(b, n // size, size, h, *t.shape[3:])
    return jnp.moveaxis(t, 3, 1)


def _from_chunks(t):
    t = jnp.moveaxis(t, 1, 3)
    b, n, c, h = t.shape[:4]
    return t.reshape(b, n * c, h, *t.shape[4:])


def gated_delta_chunked(q, k, v, g, beta, s0):
    dk = q.shape[-1]
    dv = v.shape[-1]
    f32 = jnp.float32
    q, k, v = [_to_chunks(t.astype(f32), GDN_CHUNK) for t in (q, k, v)]
    g, beta = [_to_chunks(t.astype(f32), GDN_CHUNK) for t in (g, beta)]
    q = q * dk ** -0.5
    gc = jnp.cumsum(g, axis=-1)
    tril = jnp.tril(jnp.ones((GDN_CHUNK, GDN_CHUNK), bool))
    stril = jnp.tril(jnp.ones((GDN_CHUNK, GDN_CHUNK), bool), -1)
    decay = jnp.exp(jnp.where(tril, gc[..., :, None] - gc[..., None, :], -jnp.inf))
    kk = jnp.einsum('bhnid,bhnjd->bhnij', k, k)
    t_mat = jnp.where(stril, kk * beta[..., :, None] * decay, 0.0) + jnp.eye(GDN_CHUNK, dtype=f32)
    rhs = jnp.concatenate([v * beta[..., None], k * (beta * jnp.exp(gc))[..., None]], axis=-1)
    sol = lax.linalg.triangular_solve(t_mat, rhs, left_side=True, lower=True)
    u, w = sol[..., :dv], sol[..., dv:]
    attn = jnp.einsum('bhnid,bhnjd->bhnij', q, k) * decay
    qg = q * jnp.exp(gc)[..., None]
    kg = k * jnp.exp(gc[..., -1:] - gc)[..., None]
    glast = jnp.exp(gc[..., -1])
    xs = [jnp.moveaxis(t, 2, 0) for t in (u, w, attn, qg, kg, glast)]

    def step(s, inp):
        u_i, w_i, a_i, qg_i, kg_i, gl_i = inp
        v_new = u_i - jnp.einsum('bhck,bhkv->bhcv', w_i, s)
        o = jnp.einsum('bhck,bhkv->bhcv', qg_i, s) + jnp.einsum('bhcs,bhsv->bhcv', a_i, v_new)
        s = s * gl_i[..., None, None] + jnp.einsum('bhck,bhcv->bhkv', kg_i, v_new)
        return s, o

    s_fin, o = lax.scan(step, s0, xs)
    return _from_chunks(jnp.moveaxis(o, 0, 2)), s_fin


def gla_chunked(q, k, v, logf, s0):
    f32 = jnp.float32
    xs = [jnp.moveaxis(_to_chunks(t.astype(f32), HG_CHUNK), 2, 0) for t in (q, k, v, logf)]
    tril = jnp.tril(jnp.ones((HG_CHUNK, HG_CHUNK), bool))[:, :, None]

    def step(s, inp):
        q_i, k_i, v_i, lf_i = inp
        gcum = jnp.cumsum(lf_i, axis=2)
        dec = jnp.exp(jnp.where(tril, gcum[:, :, :, None, :] - gcum[:, :, None, :, :], -jnp.inf))
        a = jnp.einsum('bhtd,bhsd,bhtsd->bhts', q_i, k_i, dec)
        o = jnp.einsum('bhtd,bhdv->bhtv', q_i * jnp.exp(gcum), s) + jnp.einsum('bhts,bhsv->bhtv', a, v_i)
        g_end = gcum[:, :, -1:, :]
        s = s * jnp.exp(g_end)[:, :, 0, :, None] + jnp.einsum('bhsd,bhsv->bhdv', k_i * jnp.exp(g_end - gcum), v_i)
        return s, o

    s_fin, o = lax.scan(step, s0, xs)
    return _from_chunks(jnp.moveaxis(o, 0, 2)), s_fin


def gdn_mixer(p_lat, p_ctx, conv_w, a_log, dt_bias, norm_w, want_ctx):
    def prep(t):
        b, n = t.shape[:2]
        qkv, z, a, bt = _split(t, [3 * W_GROUP, W_GROUP, 2 * GDN_HEADS, 2 * GDN_HEADS])
        q, k, v = _split(jax.nn.silu(conv_centred(qkv, conv_w)), [W_GROUP] * 3)
        hs = (b, n, GDN_HEADS, HEAD_DIM)
        a = a.astype(jnp.float32).reshape(b, n, 2, GDN_HEADS)
        g = -jnp.exp(a_log.astype(jnp.float32)) * jax.nn.softplus(a + dt_bias.astype(jnp.float32))
        beta = jax.nn.sigmoid(bt.astype(jnp.float32).reshape(b, n, 2, GDN_HEADS))
        return l2_norm(q.reshape(hs)), l2_norm(k.reshape(hs)), v.reshape(hs), z, g, beta

    def run(pk, d, s_init):
        q, k, v, _, g, beta = pk
        o, s = gated_delta_chunked(_flip(q, d), _flip(k, d), _flip(v, d), _flip(g[:, :, d], d),
                                   _flip(beta[:, :, d], d), s_init)
        return _flip(o, d), s

    def finish(o, z):
        b, n = z.shape[:2]
        gate = jax.nn.silu(z.astype(jnp.float32)).reshape(b, n, GDN_HEADS, HEAD_DIM)
        return (rms_norm(o, norm_w) * gate).reshape(b, n, W_GROUP).astype(z.dtype)

    pk_lat, pk_ctx = prep(p_lat), prep(p_ctx)
    s0 = jnp.zeros((p_lat.shape[0], GDN_HEADS, HEAD_DIM, HEAD_DIM), jnp.float32)
    o_lat, o_ctx = 0.0, 0.0
    for d in range(2):
        oc, s_ctx = run(pk_ctx, d, s0)
        ol, _ = run(pk_lat, d, s_ctx)
        o_lat = o_lat + ol
        o_ctx = o_ctx + oc
    return finish(o_lat, pk_lat[3]), (finish(o_ctx, pk_ctx[3]) if want_ctx else None)


def hyena_filters(n, w1, b1, f1, w2, b2, f2, w3, decay):
    f32 = jnp.float32
    pos = jnp.arange(n, dtype=f32)
    t01 = pos / max(n - 1, 1)
    bands = jnp.linspace(1e-4, HY_BANDS - 1, HY_BANDS, dtype=f32)
    ang = (2.0 * math.pi / n) * pos[:, None] * bands
    z = jnp.concatenate([t01[:, None], jnp.cos(ang), -jnp.sin(ang)], axis=-1)
    h = jnp.sin(f1.astype(f32) * (z @ w1.astype(f32) + b1.astype(f32)))
    h = jnp.sin(f2.astype(f32) * (h @ w2.astype(f32) + b2.astype(f32)))
    h = (h @ w3.astype(f32)).reshape(n, 2, 2, W_GROUP)
    window = jnp.exp(-t01[:, None, None] * jnp.abs(decay.astype(f32)))
    return h * window[:, None]


def long_conv_bidir(u, h_fwd, h_bwd, skip):
    n, ch = h_fwd.shape
    kern = jnp.concatenate([h_fwd, jnp.zeros((1, ch), jnp.float32), jnp.flip(h_bwd[1:], axis=0)], axis=0)
    kf = jnp.fft.rfft(kern, n=2 * n, axis=0)
    uf = jnp.fft.rfft(u.astype(jnp.float32), n=2 * n, axis=1)
    y = jnp.fft.irfft(uf * kf, n=2 * n, axis=1)[:, :n]
    return (y + u.astype(jnp.float32) * skip.astype(jnp.float32)).astype(u.dtype)


def hyena_mixer(p_lat, p_ctx, conv_w, filt_params, decay, skip, want_ctx):
    def run(t):
        v, x1, x2 = _split(conv_centred(t, conv_w), [W_GROUP] * 3)
        h = hyena_filters(t.shape[1], *filt_params, decay)
        z = x1 * long_conv_bidir(v, h[:, 0, 0], h[:, 1, 0], skip[0])
        return x2 * long_conv_bidir(z, h[:, 0, 1], h[:, 1, 1], skip[1])
    return run(p_lat), (run(p_ctx) if want_ctx else None)


def hgrn2_mixer(p_lat, p_ctx, lb, norm_w, want_ctx):
    lbh = lb.reshape(HG_HEADS, HG_DK)

    def prep(t):
        b, n = t.shape[:2]
        q, i, f_fwd, f_bwd, og = _split(t, [W_GROUP] * 5)
        fl = jnp.stack([f_fwd, f_bwd], axis=2).astype(jnp.float32).reshape(b, n, 2, HG_HEADS, HG_DK)
        logf = jnp.logaddexp(jnp.log(lbh), jnp.log1p(-lbh) + jax.nn.log_sigmoid(fl))
        key = (1.0 - lbh) * jax.nn.sigmoid(-fl)
        return (jax.nn.silu(q).reshape(b, n, HG_HEADS, HG_DK), i.reshape(b, n, HG_HEADS, HEAD_DIM), logf, key, og)

    def run(pk, d, s_init):
        q, i, logf, key, _ = pk
        o, s = gla_chunked(_flip(q, d), _flip(key[:, :, d], d), _flip(i, d), _flip(logf[:, :, d], d), s_init)
        return _flip(o, d), s

    def finish(o, og):
        b, n = og.shape[:2]
        gate = jax.nn.silu(og.astype(jnp.float32)).reshape(b, n, HG_HEADS, HEAD_DIM)
        return (rms_norm(o, norm_w) * gate).reshape(b, n, W_GROUP).astype(og.dtype)

    pk_lat, pk_ctx = prep(p_lat), prep(p_ctx)
    s0 = jnp.zeros((p_lat.shape[0], HG_HEADS, HG_DK, HEAD_DIM), jnp.float32)
    o_lat, o_ctx = 0.0, 0.0
    for d in range(2):
        oc, s_ctx = run(pk_ctx, d, s0)
        ol, _ = run(pk_lat, d, s_ctx)
        o_lat = o_lat + ol
        o_ctx = o_ctx + oc
    return finish(o_lat, pk_lat[4]), (finish(o_ctx, pk_ctx[4]) if want_ctx else None)


def axial_rope_tables(rows):
    n_freq = DA_DK // 4
    inv = ROPE_THETA ** (-jnp.arange(n_freq, dtype=jnp.float32) / n_freq)
    r = jnp.repeat(jnp.arange(rows, dtype=jnp.float32), GRID_W)
    col = jnp.tile(jnp.arange(GRID_W, dtype=jnp.float32), rows)
    ang_r = r[:, None] * inv
    ang_c = col[:, None] * inv
    return tuple(t[None, :, None, None, :] for t in (jnp.cos(ang_r), jnp.sin(ang_r), jnp.cos(ang_c), jnp.sin(ang_c)))


def _rotate(x, cos, sin):
    x1, x2 = jnp.split(x, 2, axis=-1)
    return jnp.concatenate([x1 * cos - x2 * sin, x2 * cos + x1 * sin], axis=-1)


def apply_axial_rope(x, rope):
    cos_r, sin_r, cos_c, sin_c = rope
    xr, xcol = jnp.split(x.astype(jnp.float32), 2, axis=-1)
    return jnp.concatenate([_rotate(xr, cos_r, sin_r), _rotate(xcol, cos_c, sin_c)], axis=-1).astype(x.dtype)


def diff_attn_mixer(p_lat, p_ctx, rope, qn_w, kn_w, lam_p, subln_w, lam_init, want_ctx):
    def prep(t):
        b, n = t.shape[:2]
        q, k, v = _split(t, [W_GROUP] * 3)
        hs = (b, n, DA_HEADS, 2, DA_DK)
        return rms_norm(q.reshape(hs), qn_w), rms_norm(k.reshape(hs), kn_w), v.reshape(b, n, DA_HEADS, 2 * DA_DK)

    q, k, v = prep(p_lat)
    qc, kc, vc = prep(p_ctx)
    q = apply_axial_rope(q, rope)
    k = apply_axial_rope(k, rope)
    lp = lam_p.astype(jnp.float32)
    lam = jnp.exp(jnp.sum(lp[0] * lp[1])) - jnp.exp(jnp.sum(lp[2] * lp[3])) + lam_init
    scale = DA_DK ** -0.5

    def attend(qb, kk, vv):
        s = jnp.einsum('bqhjd,bkhjd->bhjqk', qb, kk).astype(jnp.float32) * scale
        pr = jax.nn.softmax(s, axis=-1)
        w = (pr[:, :, 0] - lam * pr[:, :, 1]).astype(vv.dtype)
        return jnp.einsum('bhqk,bkhe->bqhe', w, vv)

    def finish(o):
        b, n = o.shape[:2]
        return (rms_norm(o, subln_w) * (1.0 - lam_init)).reshape(b, n, W_GROUP)

    b, n = q.shape[:2]
    k_all = jnp.concatenate([k, kc], axis=1)
    v_all = jnp.concatenate([v, vc], axis=1)
    q_blocks = jnp.moveaxis(q.reshape(b, n // Q_BLOCK, Q_BLOCK, DA_HEADS, 2, DA_DK), 1, 0)
    o = lax.map(lambda qb: attend(qb, k_all, v_all), q_blocks)
    o = jnp.moveaxis(o, 0, 1).reshape(b, n, DA_HEADS, 2 * DA_DK)
    o_ctx = finish(attend(qc, kc, vc)) if want_ctx else None
    return finish(o), o_ctx


def sq_relu_mlp(h, w1, w2):
    return jnp.square(jax.nn.relu(h @ w1)) @ w2


def setup_inputs(seed: int = 0) -> dict:
    key = jax.random.key(seed)
    ks = iter(jax.random.split(key, 40))
    f32 = jnp.float32

    def nrm(shape, s):
        return jax.random.normal(next(ks), shape, f32) * s

    d = D_MODEL
    x = nrm((BATCH, SEQ, d), 1.0)
    c = nrm((BATCH, d), 1.0)
    ctx = nrm((BATCH, CTX_LEN, d), 1.0)
    c_ctx = nrm((d,), 1.0)
    mod_w = nrm((DEPTH, d, 6 * d), 0.5 * d ** -0.5)
    mod_b = nrm((DEPTH, 6 * d), 0.02)
    ln1_w = 1.0 + nrm((DEPTH, d), 0.05)
    ln2_w = 1.0 + nrm((DEPTH, d), 0.05)
    w_in = nrm((DEPTH, d, P_IN), d ** -0.5)
    gdn_conv_w = nrm((DEPTH, SHORT_CONV, 3 * W_GROUP), SHORT_CONV ** -0.5)
    gdn_a_log = jnp.log(jax.random.uniform(next(ks), (DEPTH, 2, GDN_HEADS), f32, 1.0, 16.0))
    dt = jnp.exp(jax.random.uniform(next(ks), (DEPTH, 2, GDN_HEADS), f32, math.log(1e-3), math.log(1e-1)))
    gdn_dt_bias = dt + jnp.log(-jnp.expm1(-dt))
    gdn_norm_w = 1.0 + nrm((DEPTH, HEAD_DIM), 0.05)
    hy_conv_w = nrm((DEPTH, SHORT_CONV, 3 * W_GROUP), SHORT_CONV ** -0.5)
    hy_w1 = nrm((DEPTH, HY_EMB, HY_HIDDEN), HY_EMB ** -0.5)
    hy_b1 = nrm((DEPTH, HY_HIDDEN), 0.1)
    hy_f1 = 1.0 + nrm((DEPTH, HY_HIDDEN), 0.05)
    hy_w2 = nrm((DEPTH, HY_HIDDEN, HY_HIDDEN), HY_HIDDEN ** -0.5)
    hy_b2 = nrm((DEPTH, HY_HIDDEN), 0.1)
    hy_f2 = 1.0 + nrm((DEPTH, HY_HIDDEN), 0.05)
    hy_w3 = nrm((DEPTH, HY_HIDDEN, 4 * W_GROUP), HY_FILTER_INIT)
    base = jnp.linspace(abs(math.log(1e-2)) / 1.5, abs(math.log(1e-2)) / 0.3, W_GROUP, dtype=f32)
    hy_decay = base + nrm((DEPTH, 2, W_GROUP), 0.1)
    hy_bias = nrm((DEPTH, 2, W_GROUP), 0.3)
    hg_lb_raw = nrm((DEPTH, W_GROUP), 0.5)
    hg_norm_w = 1.0 + nrm((DEPTH, HEAD_DIM), 0.05)
    da_q_norm = 1.0 + nrm((DEPTH, DA_DK), 0.05)
    da_k_norm = 1.0 + nrm((DEPTH, DA_DK), 0.05)
    da_lam = nrm((DEPTH, 4, DA_DK), 0.1)
    da_subln = 1.0 + nrm((DEPTH, 2 * DA_DK), 0.05)
    w_out = nrm((DEPTH, d, d), d ** -0.5)
    mlp_w1 = nrm((DEPTH, d, D_FF), d ** -0.5)
    mlp_w2 = nrm((DEPTH, D_FF, d), D_FF ** -0.5)
    return {'x': x, 'c': c, 'ctx': ctx, 'c_ctx': c_ctx, 'mod_w': mod_w, 'mod_b': mod_b,
            'ln1_w': ln1_w, 'ln2_w': ln2_w, 'w_in': w_in, 'gdn_conv_w': gdn_conv_w,
            'gdn_a_log': gdn_a_log, 'gdn_dt_bias': gdn_dt_bias, 'gdn_norm_w': gdn_norm_w,
            'hy_conv_w': hy_conv_w, 'hy_w1': hy_w1, 'hy_b1': hy_b1, 'hy_f1': hy_f1,
            'hy_w2': hy_w2, 'hy_b2': hy_b2, 'hy_f2': hy_f2, 'hy_w3': hy_w3,
            'hy_decay': hy_decay, 'hy_bias': hy_bias, 'hg_lb_raw': hg_lb_raw,
            'hg_norm_w': hg_norm_w, 'da_q_norm': da_q_norm, 'da_k_norm': da_k_norm,
            'da_lam': da_lam, 'da_subln': da_subln, 'w_out': w_out, 'mlp_w1': mlp_w1,
            'mlp_w2': mlp_w2}


def reference(x, c, ctx, c_ctx, mod_w, mod_b, ln1_w, ln2_w, w_in, gdn_conv_w, gdn_a_log,
              gdn_dt_bias, gdn_norm_w, hy_conv_w, hy_w1, hy_b1, hy_f1, hy_w2, hy_b2, hy_f2,
              hy_w3, hy_decay, hy_bias, hg_lb_raw, hg_norm_w, da_q_norm, da_k_norm, da_lam,
              da_subln, w_out, mlp_w1, mlp_w2):
    rows = x.shape[1] // GRID_W
    rope = axial_rope_tables(rows)
    lb_all = jnp.cumsum(jax.nn.softmax(hg_lb_raw.astype(jnp.float32), axis=0), axis=0)
    lb_all = lb_all - lb_all[0]
    s_lat = jax.nn.silu(c)
    s_ctx = jax.nn.silu(c_ctx)
    xc = ctx
    for l in range(DEPTH):
        want_ctx = l < DEPTH - 1
        sh1, s1, g1, sh2, s2, g2 = jnp.split((s_lat @ mod_w[l] + mod_b[l])[:, None, :], 6, axis=-1)
        ch1, cs1, cg1, ch2, cs2, cg2 = jnp.split(s_ctx @ mod_w[l] + mod_b[l], 6, axis=-1)
        lat_gdn, lat_hy, lat_hg, lat_da = _split(modulate(x, ln1_w[l], sh1, s1) @ w_in[l], GROUP_COLS)
        ctx_gdn, ctx_hy, ctx_hg, ctx_da = _split(modulate(xc, ln1_w[l], ch1, cs1) @ w_in[l], GROUP_COLS)
        o_a, o_a_c = gdn_mixer(lat_gdn, ctx_gdn, gdn_conv_w[l], gdn_a_log[l], gdn_dt_bias[l],
                               gdn_norm_w[l], want_ctx)
        o_b, o_b_c = hyena_mixer(lat_hy, ctx_hy, hy_conv_w[l],
                                 (hy_w1[l], hy_b1[l], hy_f1[l], hy_w2[l], hy_b2[l], hy_f2[l], hy_w3[l]),
                                 hy_decay[l], hy_bias[l], want_ctx)
        o_c, o_c_c = hgrn2_mixer(lat_hg, ctx_hg, lb_all[l], hg_norm_w[l], want_ctx)
        lam_init = 0.8 - 0.6 * math.exp(-0.3 * l)
        o_d, o_d_c = diff_attn_mixer(lat_da, ctx_da, rope, da_q_norm[l], da_k_norm[l], da_lam[l],
                                     da_subln[l], lam_init, want_ctx)
        x = x + g1 * (jnp.concatenate([o_a, o_b, o_c, o_d], axis=-1) @ w_out[l])
        x = x + g2 * sq_relu_mlp(modulate(x, ln2_w[l], sh2, s2), mlp_w1[l], mlp_w2[l])
        if want_ctx:
            xc = xc + cg1 * (jnp.concatenate([o_a_c, o_b_c, o_c_c, o_d_c], axis=-1) @ w_out[l])
            xc = xc + cg2 * sq_relu_mlp(modulate(xc, ln2_w[l], ch2, cs2), mlp_w1[l], mlp_w2[l])
    return x
```

```cpp
#include <hip/hip_runtime.h>
#include <hip/hip_bf16.h>
#include <hip/hip_cooperative_groups.h>
#include <cstdio>
#include <cstdint>
namespace cg = cooperative_groups;

typedef unsigned short bfr;
using bf16x8 = __attribute__((ext_vector_type(8))) short;
using f32x4 = __attribute__((ext_vector_type(4))) float;

#define NLAT 32768
#define NCTX 2048
#define NTOK 34816
#define MIB ((size_t)1 << 20)
#define OFF_CTR 0
#define OFF_MOD (1 * MIB)
#define OFF_LB (OFF_MOD + 884736)
#define OFF_ROPE (OFF_LB + 4096)
#define OFF_XC (2 * MIB)
#define OFF_WIN (10 * MIB)
#define OFF_WOUT (OFF_WIN + 8126464)
#define OFF_W1 (OFF_WOUT + 2 * MIB)
#define OFF_W2 (OFF_W1 + 8 * MIB)
#define OFF_HN (36 * MIB)
#define OFF_AB (104 * MIB)
#define OFF_PGDN (107 * MIB)
#define OFF_PHY (175 * MIB)
#define OFF_PHG (226 * MIB)
#define OFF_PDA (311 * MIB)
#define OFF_GQ (362 * MIB)
#define OFF_HVT (413 * MIB)
#define OFF_HVC (429 * MIB)
#define OFF_X1T (430 * MIB)
#define OFF_HZC (446 * MIB)
#define OFF_RF (447 * MIB)
#define OFF_GFC (463 * MIB)
#define OFF_VT (464 * MIB)
#define OFF_X2T (482 * MIB)
#define OFF_SLAB (379 * MIB)
#define OFF_HID OFF_PGDN
#define OFF_GFC2 (498 * MIB)
#define WS_NEED (499 * MIB)
#define LDS_BYTES 73728

struct Params {
  const float* in[32];
  float* out;
  unsigned char* ws;
};

__device__ __forceinline__ float bf2f(bfr v) { return __uint_as_float(((unsigned)v) << 16); }
typedef __attribute__((ext_vector_type(2))) __bf16 bf2v_t;
typedef __attribute__((ext_vector_type(2))) float f2v_t;
using f32x16 = __attribute__((ext_vector_type(16))) float;
__device__ __forceinline__ unsigned pk2(float lo, float hi) {
  f2v_t f = {lo, hi};
  return __builtin_bit_cast(unsigned, __builtin_convertvector(f, bf2v_t));
}
__device__ __forceinline__ bfr f2bf(float f) { return (bfr)(pk2(f, 0.f) & 0xffffu); }
__device__ __forceinline__ float sigmoidf_(float x) { return 1.f / (1.f + expf(-x)); }
__device__ __forceinline__ float siluf_(float x) { return x / (1.f + expf(-x)); }
__device__ __forceinline__ float fsigmoid(float x) { return __builtin_amdgcn_rcpf(1.f + __expf(-x)); }
__device__ __forceinline__ float wave_sum(float v) {
#pragma unroll
  for (int o = 32; o >= 1; o >>= 1) v += __shfl_xor(v, o);
  return v;
}
__device__ __forceinline__ float quad_sum(float v) {
  v += __int_as_float(__builtin_amdgcn_mov_dpp(__float_as_int(v), 0xB1, 0xF, 0xF, true));
  v += __int_as_float(__builtin_amdgcn_mov_dpp(__float_as_int(v), 0x4E, 0xF, 0xF, true));
  return v;
}
typedef float v2f __attribute__((ext_vector_type(2)));

__device__ __forceinline__ int tidx() { int t = threadIdx.x; asm volatile("" : "+v"(t)); return t; }
#define WSP(T, off) ((T*)(p.ws + (off)))


#define XB_TMO      128
#define XB_XCNT(j)  (256  + 64 * (j))
#define XB_XSUB(j)  (1280 + 64 * (j))
#define XB_XGEN(j)  (2304 + 64 * (j))
#define XB_TOP      3328
#define XB_TOPGEN   3392
#define XCD_BAR_WORDS 3456
#define XB_SPIN_CAP (1u << 24)
#define LAS __attribute__((address_space(3)))
__device__ __forceinline__ unsigned xb_ld(unsigned* p) { return __hip_atomic_load(p, __ATOMIC_RELAXED, __HIP_MEMORY_SCOPE_AGENT); }
__device__ __forceinline__ unsigned xb_add(unsigned* p, unsigned v) { return __hip_atomic_fetch_add(p, v, __ATOMIC_RELAXED, __HIP_MEMORY_SCOPE_AGENT); }
__device__ __forceinline__ unsigned xb_xcc_id() { return (unsigned)__builtin_amdgcn_s_getreg((3 << 11) | 20) & 0xFu; }
#define XB_SPIN(cond, bar) do { unsigned _sp = 0; while (cond) { __builtin_amdgcn_s_sleep(1); \
    if ((++_sp & 255u) == 0u) { if (xb_ld(&(bar)[XB_TMO])) break; if (_sp > XB_SPIN_CAP) { atomicAdd(&(bar)[XB_TMO], 1u); break; } } } } while (0)
struct XcdBarrier { unsigned* bar; unsigned x; volatile LAS unsigned* st; };
__device__ __forceinline__ XcdBarrier xcd_barrier_post(unsigned* bar, volatile LAS unsigned* st) {
  XcdBarrier b; b.bar = bar; b.x = xb_xcc_id(); b.st = st;
  if (threadIdx.x == 0) (void)xb_add(&bar[XB_XCNT(b.x)], 1u);
  return b;
}
__device__ __forceinline__ void xcd_barrier_complete(unsigned* bar, unsigned x, unsigned& nloc, unsigned& nx) {
  const unsigned G = gridDim.x * gridDim.y * gridDim.z;
  unsigned sum, cnt, mine, sp = 0u;
  for (;;) {
    sum = 0u; cnt = 0u; mine = 0u;
#pragma unroll
    for (unsigned j = 0; j < 16; ++j) { const unsigned c = xb_ld(&bar[XB_XCNT(j)]); sum += c; cnt += (c > 0u) ? 1u : 0u; mine = (j == x) ? c : mine; }
    if (sum == G) break;
    __builtin_amdgcn_s_sleep(1);
    if ((++sp & 255u) == 0u) { if (xb_ld(&bar[XB_TMO])) break; if (sp > XB_SPIN_CAP) { atomicAdd(&bar[XB_TMO], 1u); break; } }
  }
  nloc = mine > 0u ? mine : 1u; nx = cnt > 0u ? cnt : 1u;
}
__device__ __forceinline__ void xcd_barrier(const XcdBarrier& b) {
  asm volatile("s_waitcnt vmcnt(0)" ::: "memory");
  __syncthreads();
  if (threadIdx.x == 0) {
    unsigned* bar = b.bar;
    __builtin_amdgcn_s_waitcnt(0);
    unsigned nloc = b.st[0], nx = b.st[1];
    if (nloc == 0u) { xcd_barrier_complete(bar, b.x, nloc, nx); b.st[0] = nloc; b.st[1] = nx; }
    const unsigned old = xb_add(&bar[XB_XSUB(b.x)], 1u);
    const unsigned gen = old / nloc;
    if (old + 1u == (gen + 1u) * nloc) {
      __builtin_amdgcn_fence(__ATOMIC_RELEASE, "agent");
      asm volatile("s_waitcnt vmcnt(0)" ::: "memory");
      const unsigned og = xb_add(&bar[XB_TOP], 1u);
      const unsigned tg = og / nx;
      if (og + 1u == (tg + 1u) * nx) xb_add(&bar[XB_TOPGEN], 1u);
      else XB_SPIN(xb_ld(&bar[XB_TOPGEN]) == tg, bar);
      __builtin_amdgcn_fence(__ATOMIC_ACQUIRE, "agent");
      xb_add(&bar[XB_XGEN(b.x)], 1u);
      asm volatile("s_waitcnt vmcnt(0)" ::: "memory");
    } else {
      XB_SPIN(xb_ld(&bar[XB_XGEN(b.x)]) == gen, bar);
      __builtin_amdgcn_fence(__ATOMIC_ACQUIRE, "agent");
      asm volatile("s_waitcnt vmcnt(0)" ::: "memory");
    }
  }
  __syncthreads();
}

__device__ __forceinline__ void phase_mod(const Params& p, float* smem) {
  const int tid = tidx();
  float* sc = smem;
  float* red = smem + 9 * 1024;
  float* mod = WSP(float, OFF_MOD);
  bool loaded = false;
  for (int task = blockIdx.x; task < 4 * 96; task += gridDim.x) {
    if (!loaded) {
      for (int i = tid; i < 9 * 1024; i += 256) {
        int m = i >> 10, k = i & 1023;
        float v = m < 8 ? p.in[1][m * 1024 + k] : p.in[3][k];
        sc[i] = siluf_(v);
      }
      __syncthreads();
      loaded = true;
    }
    int l = task / 96, cgp = task % 96;
    int col = cgp * 64 + (tid & 63), ks = tid >> 6;
    const float* w = p.in[4] + (size_t)l * 1024 * 6144 + col;
    float acc[9];
#pragma unroll
    for (int m = 0; m < 9; ++m) acc[m] = 0.f;
#pragma unroll 8
    for (int k = ks * 256; k < ks * 256 + 256; ++k) {
      float wv = w[(size_t)k * 6144];
#pragma unroll
      for (int m = 0; m < 9; ++m) acc[m] += sc[m * 1024 + k] * wv;
    }
#pragma unroll
    for (int m = 0; m < 9; ++m) red[(ks * 9 + m) * 64 + (tid & 63)] = acc[m];
    __syncthreads();
    if (tid < 64) {
#pragma unroll
      for (int m = 0; m < 9; ++m) {
        float s = red[(0 * 9 + m) * 64 + tid] + red[(1 * 9 + m) * 64 + tid] + red[(2 * 9 + m) * 64 + tid] + red[(3 * 9 + m) * 64 + tid];
        mod[(size_t)(l * 9 + m) * 6144 + col] = s + p.in[5][l * 6144 + col];
      }
    }
    __syncthreads();
  }
  if (blockIdx.x == gridDim.x - 2) {
    float* rope = WSP(float, OFF_ROPE);
    for (int e = tid; e < 512; e += 256) {
      const int pos = e >> 3, i = e & 7;
      const float inv = powf(10000.f, -(float)i / 8.f);
      float sn, cs;
      sincosf((float)pos * inv, &sn, &cs);
      rope[pos * 16 + i] = cs;
      rope[pos * 16 + 8 + i] = sn;
    }
  }
  if (blockIdx.x == gridDim.x - 1) {
    int c = tid;
    const float* raw = p.in[23];
    float r0 = raw[c], r1 = raw[256 + c], r2 = raw[512 + c], r3 = raw[768 + c];
    float mx = fmaxf(fmaxf(r0, r1), fmaxf(r2, r3));
    float e0 = expf(r0 - mx), e1 = expf(r1 - mx), e2 = expf(r2 - mx), e3 = expf(r3 - mx);
    float inv = 1.f / (e0 + e1 + e2 + e3);
    float* lb = WSP(float, OFF_LB);
    lb[c] = 0.f;
    lb[256 + c] = e1 * inv;
    lb[512 + c] = (e1 + e2) * inv;
    lb[768 + c] = (e1 + e2 + e3) * inv;
  }
}

__device__ __forceinline__ const float* xin_row(const Params& p, int l, int row) {
  if (row < NLAT) return (l == 0 ? p.in[0] : (const float*)p.out) + (size_t)row * 1024;
  return (l == 0 ? p.in[2] : (const float*)WSP(float, OFF_XC)) + (size_t)(row - NLAT) * 1024;
}
__device__ __forceinline__ float* xout_row(const Params& p, int row) {
  if (row < NLAT) return p.out + (size_t)row * 1024;
  return WSP(float, OFF_XC) + (size_t)(row - NLAT) * 1024;
}
__device__ __forceinline__ int mod_idx(int row) { return row < NLAT ? (row >> 12) : 8; }

__device__ __forceinline__ void norm_rows(const Params& p, int l, int which, int task  ) {
  const int tid = tidx(), lane = tid & 63, wave = tid >> 6;
  const float* lnw = p.in[which == 0 ? 6 : 7] + l * 1024;
  bfr* hn = WSP(bfr, OFF_HN);
  for (int rr = wave; rr < 32; rr += 4) {
    int row = task * 32 + rr;
    const float* xr = which == 0 ? xin_row(p, l, row) : (const float*)xout_row(p, row);
    const float* mv = WSP(float, OFF_MOD) + (size_t)(l * 9 + mod_idx(row)) * 6144 + (which == 0 ? 0 : 3072);
    float4 v[4];
    float ss = 0.f;
    const bool fold = (which == 0) && (l >= 1) && (row >= NLAT);
#pragma unroll
    for (int i = 0; i < 4; ++i) {
      v[i] = ((const float4*)xr)[lane + 64 * i];
      if (fold) {
        const int col = 4 * (lane + 64 * i), rc = row - NLAT;
        const float* sl = WSP(float, OFF_SLAB) + (size_t)(((rc >> 8) * 8 + (col >> 7)) * 8) * 32768 + (size_t)(rc & 255) * 128 + (col & 127);
        float4 sm = *(const float4*)sl;
#pragma unroll
        for (int ks = 1; ks < 8; ++ks) { const float4 t = *(const float4*)(sl + (size_t)ks * 32768); sm.x += t.x; sm.y += t.y; sm.z += t.z; sm.w += t.w; }
        const float4 g4 = *(const float4*)(WSP(float, OFF_MOD) + (size_t)((l - 1) * 9 + 8) * 6144 + 5120 + col);
        v[i].x += g4.x * sm.x; v[i].y += g4.y * sm.y; v[i].z += g4.z * sm.z; v[i].w += g4.w * sm.w;
        ((float4*)xout_row(p, row))[lane + 64 * i] = v[i];
      }
      ss += v[i].x * v[i].x + v[i].y * v[i].y + v[i].z * v[i].z + v[i].w * v[i].w;
    }
    ss = wave_sum(ss);
    float r = rsqrtf(ss * (1.f / 1024.f) + 1e-6f);
#pragma unroll
    for (int i = 0; i < 4; ++i) {
      int c = 4 * (lane + 64 * i);
      float4 w = *(const float4*)(lnw + c);
      float4 sh = *(const float4*)(mv + c);
      float4 sc = *(const float4*)(mv + 1024 + c);
      ushort4 o;
      o.x = f2bf(v[i].x * r * w.x * (1.f + sc.x) + sh.x);
      o.y = f2bf(v[i].y * r * w.y * (1.f + sc.y) + sh.y);
      o.z = f2bf(v[i].z * r * w.z * (1.f + sc.z) + sh.z);
      o.w = f2bf(v[i].w * r * w.w * (1.f + sc.w) + sh.w);
      *(ushort4*)(hn + (size_t)row * 1024 + c) = o;
    }
  }
}

__device__ __forceinline__ void wconv_tile(const Params& p, int l, int task, float* smem) {
  const int tid = tidx();
  const float* src;
  bfr* dst;
  int K, N, kt, nt, mode = 0;
  if (task < 992) { src = p.in[8] + (size_t)l * 1024 * 3856; dst = WSP(bfr, OFF_WIN); K = 1024; N = 3856; kt = task / 62; nt = task % 62; mode = 1; }
  else if (task < 992 + 256) { int t = task - 992; src = p.in[29] + (size_t)l * 1024 * 1024; dst = WSP(bfr, OFF_WOUT); K = 1024; N = 1024; kt = t / 16; nt = t % 16; }
  else if (task < 992 + 256 + 1024) { int t = task - 1248; src = p.in[30] + (size_t)l * 1024 * 4096; dst = WSP(bfr, OFF_W1); K = 1024; N = 4096; kt = t / 64; nt = t % 64; }
  else { int t = task - 2272; src = p.in[31] + (size_t)l * 4096 * 1024; dst = WSP(bfr, OFF_W2); K = 4096; N = 1024; kt = t / 16; nt = t % 16; }
  float* tile = smem;
  {
    int nl = tid & 63;
    int np = nt * 64 + nl;
    int sc = np;
    if (mode == 1) sc = np < 1024 ? np : (np < 3840 ? np + 16 : (np < 3856 ? np - 3840 + 1024 : -1));
#pragma unroll
    for (int i = 0; i < 16; ++i) {
      int kl = (tid >> 6) + 4 * i;
      tile[kl * 65 + nl] = sc >= 0 ? src[(size_t)(kt * 64 + kl) * N + sc] : 0.f;
    }
  }
  __syncthreads();
  {
    int kl = tid & 63;
#pragma unroll
    for (int i = 0; i < 16; ++i) {
      int nl = (tid >> 6) + 4 * i;
      dst[(size_t)(nt * 64 + nl) * K + kt * 64 + kl] = f2bf(tile[kl * 65 + nl]);
    }
  }
  __syncthreads();
}

__device__ __forceinline__ void filt_task(const Params& p, int l, int task, float* smem) {
  const int tid = tidx();
  int n, pos0;
  float* G;
  if (task < 256) { n = 4096; pos0 = task * 16; G = nullptr; }
  else { n = 256; pos0 = (task - 256) * 16; G = (l & 1) ? WSP(float, OFF_GFC2) : WSP(float, OFF_GFC); }
  float* zs = smem;
  float* h1s = smem + 16 * 36;
  float* h2t = h1s + 16 * 64;
  const float* w1 = p.in[14] + l * 33 * 64;
  const float* b1 = p.in[15] + l * 64;
  const float* f1 = p.in[16] + l * 64;
  const float* w2 = p.in[17] + l * 64 * 64;
  const float* b2 = p.in[18] + l * 64;
  const float* f2 = p.in[19] + l * 64;
  const float* w3 = p.in[20] + (size_t)l * 64 * 1024;
  const float* dec = p.in[21] + l * 512;
  const float* skp = p.in[22] + l * 512;
  const float inv_nm1 = (n == 4096) ? (1.f / 4095.f) : (1.f / 255.f);
  const float twopi_n = (n == 4096) ? (6.283185307179586f / 4096.f) : (6.283185307179586f / 256.f);
  for (int i = tid; i < 16 * 33; i += 256) {
    int pp = i / 33, e = i % 33;
    float pos = (float)(pos0 + pp);
    float zv;
    if (e == 0) zv = pos * inv_nm1;
    else {
      int bi = (e - 1) & 15;
      float band = 1e-4f + (float)bi * ((15.f - 1e-4f) / 15.f);
      float ang = twopi_n * pos * band;
      zv = (e <= 16) ? cosf(ang) : -sinf(ang);
    }
    zs[pp * 36 + e] = zv;
  }
  __syncthreads();
  for (int i = tid; i < 16 * 64; i += 256) {
    int pp = i >> 6, j = i & 63;
    float a = b1[j];
    for (int e = 0; e < 33; ++e) a += zs[pp * 36 + e] * w1[e * 64 + j];
    h1s[pp * 64 + j] = sinf(f1[j] * a);
  }
  __syncthreads();
  for (int i = tid; i < 16 * 64; i += 256) {
    int pp = i >> 6, j = i & 63;
    float a = b2[j];
    for (int k = 0; k < 64; ++k) a += h1s[pp * 64 + k] * w2[k * 64 + j];
    h2t[j * 16 + pp] = sinf(f2[j] * a);
  }
  __syncthreads();
#pragma unroll 1
  for (int jj = 0; jj < 4; ++jj) {
    int col = tid + 256 * jj;
    float acc[16];
#pragma unroll
    for (int i = 0; i < 16; ++i) acc[i] = 0.f;
#pragma unroll 8
    for (int k = 0; k < 64; ++k) {
      float wv = w3[k * 1024 + col];
      const float4* h4 = (const float4*)(h2t + k * 16);
#pragma unroll
      for (int q = 0; q < 4; ++q) {
        float4 hv = h4[q];
        acc[4 * q + 0] += hv.x * wv; acc[4 * q + 1] += hv.y * wv; acc[4 * q + 2] += hv.z * wv; acc[4 * q + 3] += hv.w * wv;
      }
    }
    int side = col >> 9, f = (col >> 8) & 1, ch = col & 255;
    float dc = fabsf(dec[f * 256 + ch]);
    if (G) {
      float* Gf = G + (size_t)f * (2 * n - 1) * 256;
#pragma unroll
      for (int i = 0; i < 16; ++i) {
        int pos = pos0 + i;
        float val = acc[i] * expf(-(float)pos * inv_nm1 * dc);
        if (side == 0) {
          if (pos == 0) val += skp[f * 256 + ch];
          Gf[(size_t)(pos + n - 1) * 256 + ch] = val;
        } else if (pos >= 1) {
          Gf[(size_t)(n - 1 - pos) * 256 + ch] = val;
        }
      }
    } else {
      bfr* R = WSP(bfr, OFF_RF) + (size_t)(l & 1) * (4 * MIB) + ((size_t)(f * 256 + ch)) * 8192;
#pragma unroll
      for (int i = 0; i < 16; ++i) {
        int pos = pos0 + i;
        float val = acc[i] * expf(-(float)pos * inv_nm1 * dc);
        if (side == 0) {
          if (pos == 0) { val += skp[f * 256 + ch]; R[0] = 0; }
          R[4096 - pos] = f2bf(val);
        } else if (pos >= 1) {
          R[4096 + pos] = f2bf(val);
        }
      }
    }
  }
  __syncthreads();
}

template <bool RELU2>
__device__ __forceinline__ void store_tile_bf16(const f32x4 (&acc)[8][4], bfr* dst, int ld, int row_base, int col_base, bfr* wbuf, int lane) {
  const int fr = lane & 15, fq = lane >> 4;
#pragma unroll
  for (int pass = 0; pass < 2; ++pass) {
#pragma unroll
    for (int mm = 0; mm < 4; ++mm)
#pragma unroll
      for (int n = 0; n < 4; ++n) {
        f32x4 a = acc[4 * pass + mm][n];
        if (RELU2) {
          a[0] = fmaxf(a[0], 0.f); a[1] = fmaxf(a[1], 0.f); a[2] = fmaxf(a[2], 0.f); a[3] = fmaxf(a[3], 0.f);
          a[0] *= a[0]; a[1] *= a[1]; a[2] *= a[2]; a[3] *= a[3];
        }
        uint2 o; o.x = pk2(a[0], a[1]); o.y = pk2(a[2], a[3]);
        *(uint2*)(wbuf + (mm * 16 + fr) * 72 + n * 16 + fq * 4) = o;
      }
#pragma unroll
    for (int q = 0; q < 8; ++q) {
      const int chunk = lane + 64 * q, rowl = chunk >> 3, c16 = chunk & 7;
      const uint4 v = *(const uint4*)(wbuf + rowl * 72 + c16 * 8);
      *(uint4*)(dst + (size_t)(row_base + pass * 64 + rowl) * ld + col_base + c16 * 8) = v;
    }
  }
}

template <int EPI>
__device__ __forceinline__ void gemm_phase(const Params& p, int l, const bfr* A, int lda, const bfr* Bt, int K, int Mtiles, int Ntiles, char* smemc) {
  bfr* sA = (bfr*)smemc;
  bfr* sB = sA + 2 * 256 * 40;
  const int tid = tidx(), wave = __builtin_amdgcn_readfirstlane(tid >> 6), lane = tid & 63;
  const int wr = wave >> 1, wc = wave & 1, fr = lane & 15, fq = lane >> 4;
  const int ntiles = Mtiles * Ntiles;
  const int nk = K / 32;
  const int gsb = lane * 16, gsw = gsb ^ (((gsb >> 9) & 1) << 5);
  const int grl = gsw >> 6, gcl = (gsw & 63) >> 1;
  const int flo = (fr * 64 + fq * 16) ^ ((fr >> 3) << 5);
  const int xcd = blockIdx.x & 7, xidx = blockIdx.x >> 3, xnb = gridDim.x >> 3;
  const int SN = (Ntiles + 7) >> 3, nsup = (Mtiles >> 3) * SN;
  (void)ntiles;
  const int qper = (64 + xnb - 1) / xnb;
  const bool splitctx = (EPI == 3) && (Mtiles == 136);
  const int nsupm = splitctx ? 16 * SN : nsup;
  const int nmain = ((nsupm + 7) >> 3) * qper;
  const int nextra = splitctx ? (512 + (int)gridDim.x - 1) / (int)gridDim.x : 0;
  for (int it = 0; it < nmain + nextra; ++it) {
    int tm, tn, kt0 = 0, nkk = nk, item = -1;
    if (it < nmain) {
      const int sup = xcd + 8 * (it / qper), q = xidx + xnb * (it % qper);
      if (sup >= nsupm || q >= 64) continue;
      tm = (sup / SN) * 8 + (q >> 3); tn = (sup % SN) * 8 + (q & 7);
      if (tn >= Ntiles) continue;
    } else {
      item = blockIdx.x + gridDim.x * (it - nmain);
      if (item >= 512) continue;
      const int tl = item >> 3;
      tm = 128 + (tl >> 3); tn = tl & 7; nkk = nk >> 3; kt0 = (item & 7) * nkk;
    }
    const bfr* Ab = A + (size_t)tm * 256 * lda + (size_t)(wave * 16 + grl) * lda + gcl + kt0 * 32;
    const bfr* Bb = Bt + (size_t)tn * 128 * K + (size_t)(wave * 16 + grl) * K + gcl + kt0 * 32;
    f32x4 acc[8][4];
#pragma unroll
    for (int m = 0; m < 8; ++m)
#pragma unroll
      for (int n = 0; n < 4; ++n) acc[m][n] = (f32x4){0.f, 0.f, 0.f, 0.f};
#define GLDS_STAGE(BUF, K0) { char* la = smemc + (BUF) * 24576 + wave * 1024; \
      __builtin_amdgcn_global_load_lds((const unsigned*)(Ab + (K0)), (unsigned*)(la), 16, 0, 0); \
      __builtin_amdgcn_global_load_lds((const unsigned*)(Ab + (size_t)64 * lda + (K0)), (unsigned*)(la + 4096), 16, 0, 0); \
      __builtin_amdgcn_global_load_lds((const unsigned*)(Ab + (size_t)128 * lda + (K0)), (unsigned*)(la + 8192), 16, 0, 0); \
      __builtin_amdgcn_global_load_lds((const unsigned*)(Ab + (size_t)192 * lda + (K0)), (unsigned*)(la + 12288), 16, 0, 0); \
      __builtin_amdgcn_global_load_lds((const unsigned*)(Bb + (K0)), (unsigned*)(la + 16384), 16, 0, 0); \
      __builtin_amdgcn_global_load_lds((const unsigned*)(Bb + (size_t)64 * K + (K0)), (unsigned*)(la + 16384 + 4096), 16, 0, 0); }
#define MM4(M, AF) { acc[M][0] = __builtin_amdgcn_mfma_f32_16x16x32_bf16(bg0, AF, acc[M][0], 0, 0, 0); \
      acc[M][1] = __builtin_amdgcn_mfma_f32_16x16x32_bf16(bg1, AF, acc[M][1], 0, 0, 0); \
      acc[M][2] = __builtin_amdgcn_mfma_f32_16x16x32_bf16(bg2, AF, acc[M][2], 0, 0, 0); \
      acc[M][3] = __builtin_amdgcn_mfma_f32_16x16x32_bf16(bg3, AF, acc[M][3], 0, 0, 0); }
#define AFR(M) (*(const bf16x8*)(rap + (M) * 1024))
    __syncthreads();
    GLDS_STAGE(0, 0);
    GLDS_STAGE(1, 32);
    asm volatile("s_waitcnt vmcnt(6)" ::: "memory");
    asm volatile("s_waitcnt lgkmcnt(0)" ::: "memory");
    __builtin_amdgcn_s_barrier();
    int cur = 0, nx2 = 2;
    for (int kt = 0; kt < nkk; ++kt) {
      if (kt + 2 < nkk) GLDS_STAGE(nx2, (kt + 2) * 32);
      const char* rbp = smemc + cur * 24576 + 16384 + (wc * 4) * 1024 + flo;
      const char* rap = smemc + cur * 24576 + (wr * 8) * 1024 + flo;
      bf16x8 bg0 = *(const bf16x8*)(rbp), bg1 = *(const bf16x8*)(rbp + 1024), bg2 = *(const bf16x8*)(rbp + 2048), bg3 = *(const bf16x8*)(rbp + 3072);
      bf16x8 a0 = AFR(0), a1 = AFR(1), a2 = AFR(2);
      MM4(0, a0); a0 = AFR(3);
      MM4(1, a1); a1 = AFR(4);
      MM4(2, a2); a2 = AFR(5);
      MM4(3, a0); a0 = AFR(6);
      MM4(4, a1); a1 = AFR(7);
      MM4(5, a2);
      MM4(6, a0);
      MM4(7, a1);
      __builtin_amdgcn_sched_group_barrier(0x100, 7, 0);
      __builtin_amdgcn_sched_group_barrier(0x008, 4, 0);
      __builtin_amdgcn_sched_group_barrier(0x100, 1, 0);
      __builtin_amdgcn_sched_group_barrier(0x008, 4, 0);
      __builtin_amdgcn_sched_group_barrier(0x100, 1, 0);
      __builtin_amdgcn_sched_group_barrier(0x008, 4, 0);
      __builtin_amdgcn_sched_group_barrier(0x100, 1, 0);
      __builtin_amdgcn_sched_group_barrier(0x008, 4, 0);
      __builtin_amdgcn_sched_group_barrier(0x100, 1, 0);
      __builtin_amdgcn_sched_group_barrier(0x008, 4, 0);
      __builtin_amdgcn_sched_group_barrier(0x100, 1, 0);
      __builtin_amdgcn_sched_group_barrier(0x008, 12, 0);
      __builtin_amdgcn_sched_barrier(0);
      if (kt + 2 < nkk) asm volatile("s_waitcnt vmcnt(6)" ::: "memory");
      else asm volatile("s_waitcnt vmcnt(0)" ::: "memory");
      asm volatile("s_waitcnt lgkmcnt(0)" ::: "memory");
      __builtin_amdgcn_s_barrier();
      cur = (cur == 2) ? 0 : cur + 1;
      nx2 = (nx2 == 2) ? 0 : nx2 + 1;
    }
#undef GLDS_STAGE
#undef MM4
#undef AFR
    if (EPI == 0) {
      bfr* dst; int ld, c0;
      if (tn < 8) { dst = WSP(bfr, OFF_PGDN); ld = 1024; c0 = tn * 128; }
      else if (tn < 14) { dst = WSP(bfr, OFF_PHY); ld = 768; c0 = (tn - 8) * 128; }
      else if (tn < 24) { dst = WSP(bfr, OFF_PHG); ld = 1280; c0 = (tn - 14) * 128; }
      else if (tn < 30) { dst = WSP(bfr, OFF_PDA); ld = 768; c0 = (tn - 24) * 128; }
      else { dst = nullptr; ld = 0; c0 = 0; }
      if (dst) {
        store_tile_bf16<false>(acc, dst, ld, tm * 256 + wr * 128, c0 + wc * 64, (bfr*)smemc + wave * (64 * 72), lane);
      } else if (wc == 0) {
        float* ab = WSP(float, OFF_AB);
#pragma unroll
        for (int m = 0; m < 8; ++m) {
          int row = tm * 256 + wr * 128 + m * 16 + fr;
          *(float4*)(ab + (size_t)row * 16 + fq * 4) = (float4){acc[m][0][0], acc[m][0][1], acc[m][0][2], acc[m][0][3]};
        }
      }
    } else if (EPI == 2) {
      store_tile_bf16<true>(acc, WSP(bfr, OFF_HID), 4096, tm * 256 + wr * 128, tn * 128 + wc * 64, (bfr*)smemc + wave * (64 * 72), lane);
    } else {
      const int midx = tm < 128 ? (tm >> 4) : 8;
      const float* gv = WSP(float, OFF_MOD) + (size_t)(l * 9 + midx) * 6144 + (EPI == 1 ? 2048 : 5120);
      float* wbuf = (float*)smemc + wave * (32 * 68);
      const int colw = tn * 128 + wc * 64;
      if (item >= 0) {
        float* slb = WSP(float, OFF_SLAB) + (size_t)item * 32768 + (size_t)(wr * 128) * 128 + wc * 64;
#pragma unroll
        for (int pass = 0; pass < 4; ++pass) {
#pragma unroll
          for (int mm = 0; mm < 2; ++mm)
#pragma unroll
            for (int n = 0; n < 4; ++n)
              *(f32x4*)(wbuf + (mm * 16 + fr) * 68 + n * 16 + fq * 4) = acc[2 * pass + mm][n];
#pragma unroll
          for (int q = 0; q < 8; ++q) {
            const int chunk = lane + 64 * q, rowl = chunk >> 4, c16 = chunk & 15;
            *(f32x4*)(slb + (size_t)(pass * 32 + rowl) * 128 + c16 * 4) = *(const f32x4*)(wbuf + rowl * 68 + c16 * 4);
          }
        }
      } else {
#pragma unroll
        for (int pass = 0; pass < 4; ++pass) {
#pragma unroll
          for (int mm = 0; mm < 2; ++mm)
#pragma unroll
            for (int n = 0; n < 4; ++n)
              *(f32x4*)(wbuf + (mm * 16 + fr) * 68 + n * 16 + fq * 4) = acc[2 * pass + mm][n];
#pragma unroll
          for (int q = 0; q < 8; ++q) {
            const int chunk = lane + 64 * q, rowl = chunk >> 4, c16 = chunk & 15;
            const int row = tm * 256 + wr * 128 + pass * 32 + rowl, col = colw + c16 * 4;
            const f32x4 a = *(const f32x4*)(wbuf + rowl * 68 + c16 * 4);
            const float* xi = (EPI == 1) ? xin_row(p, l, row) : (const float*)xout_row(p, row);
            float* xo = xout_row(p, row);
            float4 xv = *(const float4*)(xi + col);
            const float4 g4 = *(const float4*)(gv + col);
            xv.x += g4.x * a[0]; xv.y += g4.y * a[1]; xv.z += g4.z * a[2]; xv.w += g4.w * a[3];
            *(float4*)(xo + col) = xv;
          }
        }
      }
    }
  }
}

__device__ __forceinline__ void prep_task(const Params& p, int l, int task  , char* smemc) {
  const int tid = tidx();
  const bfr* pg = WSP(bfr, OFF_PGDN);
  const bfr* ph = WSP(bfr, OFF_PHY);
  bfr* gq = WSP(bfr, OFF_GQ);
  bfr* hv = WSP(bfr, OFF_HVC) - (size_t)NLAT * 256;
  const float* gw = p.in[9] + l * 3 * 768;
  const float* hw = p.in[13] + l * 3 * 768;
  float gw0[3], gw1[3], gw2[3], hw0[3];
#pragma unroll
  for (int i = 0; i < 3; ++i) {
    gw0[i] = gw[i * 768 + tid]; gw1[i] = gw[i * 768 + 256 + tid]; gw2[i] = gw[i * 768 + 512 + tid]; hw0[i] = hw[i * 768 + tid];
  }
  {
    const int row0 = task * 32;
    int t0, n;
    if (row0 < NLAT) { t0 = row0 & 4095; n = 4096; } else { t0 = (row0 - NLAT) & 255; n = 256; }
    const bool isctx = row0 >= NLAT;
#pragma unroll 1
    for (int rb = 0; rb < 32; rb += 8) {
      float xq[10], xk[10], xv[10], xh[10];
#pragma unroll
      for (int j = 0; j < 10; ++j) {
        const int tt = t0 + rb - 1 + j;
        const bool ok = tt >= 0 && tt < n;
        const bfr* r = pg + (size_t)(row0 + rb - 1 + j) * 1024;
        xq[j] = ok ? bf2f(r[tid]) : 0.f;
        xk[j] = ok ? bf2f(r[256 + tid]) : 0.f;
        xv[j] = ok ? bf2f(r[512 + tid]) : 0.f;
        xh[j] = (ok && isctx) ? bf2f(ph[(size_t)(row0 + rb - 1 + j) * 768 + tid]) : 0.f;
      }
#pragma unroll
      for (int r8 = 0; r8 < 8; ++r8) {
        const int row = row0 + rb + r8;
        float aq = gw0[0] * xq[r8] + gw0[1] * xq[r8 + 1] + gw0[2] * xq[r8 + 2];
        float ak = gw1[0] * xk[r8] + gw1[1] * xk[r8 + 1] + gw1[2] * xk[r8 + 2];
        float av = gw2[0] * xv[r8] + gw2[1] * xv[r8 + 1] + gw2[2] * xv[r8 + 2];
        aq *= fsigmoid(aq); ak *= fsigmoid(ak); av *= fsigmoid(av);
        float sq = wave_sum(aq * aq), sk = wave_sum(ak * ak);
        aq *= rsqrtf(sq + 1e-6f); ak *= rsqrtf(sk + 1e-6f);
        gq[(size_t)row * 768 + tid] = f2bf(aq);
        gq[(size_t)row * 768 + 256 + tid] = f2bf(ak);
        gq[(size_t)row * 768 + 512 + tid] = f2bf(av);
        if (isctx) hv[(size_t)row * 256 + tid] = f2bf(hw0[0] * xh[r8] + hw0[1] * xh[r8 + 1] + hw0[2] * xh[r8 + 2]);
      }
    }
  }
  bfr* pd = WSP(bfr, OFF_PDA);
  for (int gi = tid; gi < 512; gi += 256) {
    int rr = gi >> 4, g = gi & 15;
    int row = task * 32 + rr;
    int qk = g >> 3;
    bfr* ptr = pd + (size_t)row * 768 + g * 32;
    const float* nw = p.in[qk == 0 ? 25 : 26] + l * 32;
    float x[32];
    uint4 raw[4];
#pragma unroll
    for (int i = 0; i < 4; ++i) raw[i] = ((const uint4*)ptr)[i];
#pragma unroll
    for (int i = 0; i < 4; ++i) {
      unsigned w0 = raw[i].x, w1 = raw[i].y, w2 = raw[i].z, w3 = raw[i].w;
      x[8 * i + 0] = __uint_as_float(w0 << 16); x[8 * i + 1] = __uint_as_float(w0 & 0xffff0000u);
      x[8 * i + 2] = __uint_as_float(w1 << 16); x[8 * i + 3] = __uint_as_float(w1 & 0xffff0000u);
      x[8 * i + 4] = __uint_as_float(w2 << 16); x[8 * i + 5] = __uint_as_float(w2 & 0xffff0000u);
      x[8 * i + 6] = __uint_as_float(w3 << 16); x[8 * i + 7] = __uint_as_float(w3 & 0xffff0000u);
    }
    float ss = 0.f;
#pragma unroll
    for (int i = 0; i < 32; ++i) ss += x[i] * x[i];
    float r = rsqrtf(ss * (1.f / 32.f) + 1e-6f);
    if (qk == 0) r *= 0.25503486f;
#pragma unroll
    for (int i = 0; i < 32; ++i) x[i] = x[i] * r * nw[i];
    if (row < NLAT) {
      int t = row & 4095;
      const float* rr_ = WSP(float, OFF_ROPE) + (t >> 6) * 16;
      const float* rc_ = WSP(float, OFF_ROPE) + (t & 63) * 16;
      float crv[8], srv[8], ccv[8], scv[8];
#pragma unroll
      for (int i = 0; i < 2; ++i) {
        float4 a4 = ((const float4*)rr_)[i], b4 = ((const float4*)rr_)[2 + i], c4 = ((const float4*)rc_)[i], d4 = ((const float4*)rc_)[2 + i];
        crv[4 * i] = a4.x; crv[4 * i + 1] = a4.y; crv[4 * i + 2] = a4.z; crv[4 * i + 3] = a4.w;
        srv[4 * i] = b4.x; srv[4 * i + 1] = b4.y; srv[4 * i + 2] = b4.z; srv[4 * i + 3] = b4.w;
        ccv[4 * i] = c4.x; ccv[4 * i + 1] = c4.y; ccv[4 * i + 2] = c4.z; ccv[4 * i + 3] = c4.w;
        scv[4 * i] = d4.x; scv[4 * i + 1] = d4.y; scv[4 * i + 2] = d4.z; scv[4 * i + 3] = d4.w;
      }
#pragma unroll
      for (int i = 0; i < 8; ++i) {
        const float sr = srv[i], cr = crv[i], scn = scv[i], cc = ccv[i];
        float a = x[i], b = x[8 + i];
        x[i] = a * cr - b * sr; x[8 + i] = b * cr + a * sr;
        float c = x[16 + i], d = x[24 + i];
        x[16 + i] = c * cc - d * scn; x[24 + i] = d * cc + c * scn;
      }
    }
#pragma unroll
    for (int i = 0; i < 4; ++i) {
      uint4 o;
      o.x = (unsigned)f2bf(x[8 * i + 0]) | ((unsigned)f2bf(x[8 * i + 1]) << 16);
      o.y = (unsigned)f2bf(x[8 * i + 2]) | ((unsigned)f2bf(x[8 * i + 3]) << 16);
      o.z = (unsigned)f2bf(x[8 * i + 4]) | ((unsigned)f2bf(x[8 * i + 5]) << 16);
      o.w = (unsigned)f2bf(x[8 * i + 6]) | ((unsigned)f2bf(x[8 * i + 7]) << 16);
      ((uint4*)ptr)[i] = o;
    }
  }
  if (task < 1024) {
    bfr* tile = (bfr*)smemc;
    const int row0 = task * 32;
    const int bb = row0 >> 12, t0 = row0 & 4095;
#pragma unroll 1
    for (int k = 0; k < 3; ++k) {
      const int ch = k * 256 + tid;
      const float w0 = hw[ch], w1 = hw[768 + ch], w2 = hw[1536 + ch];
      bfr xr[34];
#pragma unroll
      for (int j = 0; j < 34; ++j) {
        const int tt = t0 - 1 + j;
        xr[j] = (tt >= 0 && tt < 4096) ? ph[(size_t)(row0 - 1 + j) * 768 + ch] : (bfr)0;
      }
#pragma unroll
      for (int rr = 0; rr < 32; rr += 2) {
        const float y0 = w0 * bf2f(xr[rr]) + w1 * bf2f(xr[rr + 1]) + w2 * bf2f(xr[rr + 2]);
        const float y1 = w0 * bf2f(xr[rr + 1]) + w1 * bf2f(xr[rr + 2]) + w2 * bf2f(xr[rr + 3]);
        *(unsigned*)(tile + tid * 40 + rr) = pk2(y0, y1);
      }
      __syncthreads();
      bfr* dst = WSP(bfr, k == 0 ? OFF_HVT : (k == 1 ? OFF_X1T : OFF_X2T)) + ((size_t)(tid * 8 + bb)) * 4096 + t0;
#pragma unroll
      for (int i = 0; i < 4; ++i) ((uint4*)dst)[i] = *(const uint4*)(tile + tid * 40 + 8 * i);
      __syncthreads();
    }
  }
  {
    bfr* tile = (bfr*)smemc;
    const int row0 = task * 32;
    bfr vr[32];
#pragma unroll
    for (int rr = 0; rr < 32; ++rr) vr[rr] = pd[(size_t)(row0 + rr) * 768 + 512 + tid];
#pragma unroll
    for (int rr = 0; rr < 32; ++rr) {
      int pp = rr & 15;
      int g = pp >> 2;
      g = (g == 1) ? 2 : (g == 2 ? 1 : g);
      int pos = (rr & 16) | (g << 2) | (pp & 3);
      tile[tid * 40 + pos] = vr[rr];
    }
    __syncthreads();
    int bb, kbase;
    if (row0 < NLAT) { bb = row0 >> 12; kbase = row0 & 4095; } else { bb = (row0 - NLAT) >> 8; kbase = 4096 + ((row0 - NLAT) & 255); }
    bfr* vt = WSP(bfr, OFF_VT) + ((size_t)(bb * 256 + tid)) * 4352 + kbase;
#pragma unroll
    for (int i = 0; i < 4; ++i) ((uint4*)vt)[i] = *(const uint4*)(tile + tid * 40 + 8 * i);
    __syncthreads();
  }
}

__device__ __forceinline__ size_t scan_row(int b, int d, int ci, int i) {
  if (ci < 8) { int c0 = ci * 32; int t = d == 0 ? c0 + i : 255 - c0 - i; return (size_t)NLAT + b * 256 + t; }
  int c0 = (ci - 8) * 32; int t = d == 0 ? c0 + i : 4095 - c0 - i; return (size_t)b * 4096 + t;
}

__device__ __forceinline__ void hgrn_scan(const Params& p, int l, int task, float* smem) {
  const int b = task >> 3, h = (task >> 1) & 3, d = task & 1;
  const int tid = tidx(), lane = tid & 63, wave = tid >> 6;
  const int kg = lane & 3, vv = wave * 16 + (lane >> 2);
  float* sq = smem;
  float* sf = smem + 2048;
  float* sv = smem + 4096;
  float* so = smem + 6144;
  bfr* P = WSP(bfr, OFF_PHG);
  const int ch = tid & 63, i0 = tid >> 6;
  const float lbv = WSP(float, OFF_LB)[l * 256 + h * 64 + ch];
  v2f S2[8];
#pragma unroll
  for (int i = 0; i < 8; ++i) S2[i] = (v2f){0.f, 0.f};
  __builtin_amdgcn_s_setprio(3);
  bfr rq[8], ri[8], rf[8];
#pragma unroll
  for (int j = 0; j < 8; ++j) {
    const bfr* pr = P + scan_row(b, d, 0, i0 + 4 * j) * 1280 + h * 64 + ch;
    rq[j] = pr[0]; ri[j] = pr[256]; rf[j] = pr[512 + d * 256];
  }
  for (int ci = 0; ci < 136; ++ci) {
#pragma unroll
    for (int j = 0; j < 8; ++j) {
      const int e = (i0 + 4 * j) * 64 + ch;
      sq[e] = siluf_(bf2f(rq[j]));
      sf[e] = lbv + (1.f - lbv) * sigmoidf_(bf2f(rf[j]));
      sv[e] = bf2f(ri[j]);
    }
    __syncthreads();
    if (ci + 1 < 136) {
#pragma unroll
      for (int j = 0; j < 8; ++j) {
        const bfr* pr = P + scan_row(b, d, ci + 1, i0 + 4 * j) * 1280 + h * 64 + ch;
        rq[j] = pr[0]; ri[j] = pr[256]; rf[j] = pr[512 + d * 256];
      }
    }
#pragma unroll 4
    for (int i = 0; i < 32; ++i) {
      const float vcur = sv[i * 64 + vv];
      const v2f vc2 = {vcur, vcur};
      const float4* f4 = (const float4*)(sf + i * 64 + kg * 16);
      const float4* q4 = (const float4*)(sq + i * 64 + kg * 16);
      v2f pa = {0.f, 0.f}, pb = {0.f, 0.f};
#pragma unroll
      for (int j = 0; j < 4; ++j) {
        float4 f = f4[j], q = q4[j];
        v2f fa = {f.x, f.y}, fb = {f.z, f.w}, qa = {q.x, q.y}, qb = {q.z, q.w};
        S2[2 * j] = fa * (S2[2 * j] - vc2) + vc2;
        S2[2 * j + 1] = fb * (S2[2 * j + 1] - vc2) + vc2;
        pa += S2[2 * j] * qa;
        pb += S2[2 * j + 1] * qb;
      }
      float po = quad_sum((pa.x + pa.y) + (pb.x + pb.y));
      if (kg == 0) so[i * 64 + vv] = po;
    }
    __syncthreads();
#pragma unroll
    for (int j = 0; j < 8; ++j) {
      const int i = i0 + 4 * j;
      P[scan_row(b, d, ci, i) * 1280 + 512 + d * 256 + h * 64 + ch] = f2bf(so[i * 64 + ch]);
    }
  }
  __builtin_amdgcn_s_setprio(0);
}

__device__ __forceinline__ bfr* sw_addr(bfr* base, int R, int chunk) { return base + R * 64 + ((chunk ^ (R & 7)) << 3); }
__device__ __forceinline__ bf16x8 frag_nat(bfr* base, int R, int kk, int hf) { return *(const bf16x8*)sw_addr(base, R, 2 * kk + hf); }
__device__ __forceinline__ bf16x8 frag_krow(bfr* base, int R, int c0, int hf) {
  uint2 lo = *(const uint2*)(sw_addr(base, R, c0) + 4 * hf);
  uint2 hi = *(const uint2*)(sw_addr(base, R, c0 + 1) + 4 * hf);
  return __builtin_bit_cast(bf16x8, (uint4){lo.x, lo.y, hi.x, hi.y});
}
__device__ __forceinline__ bf16x8 pack8(const f32x16& x, int st) {
  return __builtin_bit_cast(bf16x8, (uint4){pk2(x[8 * st + 0], x[8 * st + 1]), pk2(x[8 * st + 2], x[8 * st + 3]),
                                            pk2(x[8 * st + 4], x[8 * st + 5]), pk2(x[8 * st + 6], x[8 * st + 7])});
}
__device__ __forceinline__ int crow_(int reg, int hf) { return (reg & 3) + 8 * (reg >> 2) + 4 * hf; }
__device__ __forceinline__ size_t scan_row64(int b, int d, int ci, int i) {
  if (ci < 4) { int c0 = ci * 64; int t = d == 0 ? c0 + i : 255 - c0 - i; return (size_t)NLAT + b * 256 + t; }
  int c0 = (ci - 4) * 64; int t = d == 0 ? c0 + i : 4095 - c0 - i; return (size_t)b * 4096 + t;
}

__device__ __forceinline__ void hgrn_chunked(const Params& p, int l, int task, char* smemc) {
  const int b = task >> 3, h = (task >> 1) & 3, d = task & 1;
  const int tid = tidx(), lane = tid & 63, wave = tid >> 6, r = lane & 31, hf = lane >> 5;
  const int tb = wave >> 1, vb = wave & 1;
  bfr* QG = (bfr*)smemc;
  bfr* QT = QG + 4096;
  bfr* KT = QT + 4096;
  bfr* KET = KT + 4096;
  bfr* VT = KET + 4096;
  float* TOT = (float*)(smemc + 40960);
  float* EG = TOT + 256;
  bfr* P = WSP(bfr, OFF_PHG);
  const int c = tid & 63, qd = tid >> 6;
  const float lbv = WSP(float, OFF_LB)[l * 256 + h * 64 + c];
  f32x16 S[2];
#pragma unroll
  for (int m = 0; m < 2; ++m)
#pragma unroll
    for (int i = 0; i < 16; ++i) S[m][i] = 0.f;
  __builtin_amdgcn_s_setprio(3);
  bfr rq[16], ri[16], rf[16];
#pragma unroll
  for (int j = 0; j < 16; ++j) {
    const bfr* pr = P + scan_row64(b, d, 0, 16 * qd + j) * 1280 + h * 64 + c;
    rq[j] = pr[0]; ri[j] = pr[256]; rf[j] = pr[512 + d * 256];
  }
#pragma unroll 1
  for (int ci = 0; ci < 68; ++ci) {
    float g[16], ky[16], qh[16];
    float run = 0.f;
#pragma unroll
    for (int j = 0; j < 16; ++j) {
      float f = lbv + (1.f - lbv) * fsigmoid(bf2f(rf[j]));
      run += __logf(f);
      const float qv = bf2f(rq[j]);
      g[j] = run; ky[j] = 1.f - f; qh[j] = qv * fsigmoid(qv);
    }
    __syncthreads();
    TOT[qd * 64 + c] = run;
    __syncthreads();
    const float t0 = TOT[c], t1 = TOT[64 + c], t2 = TOT[128 + c], t3 = TOT[192 + c];
    const float off = (qd > 0 ? t0 : 0.f) + (qd > 1 ? t1 : 0.f) + (qd > 2 ? t2 : 0.f);
    const float gm = t0 + t1, g63 = (t0 + t1) + (t2 + t3);
    const float egm = __expf(gm), e6m = __expf(g63 - gm);
    unsigned wke[8], wvt[8];
#pragma unroll
    for (int j = 0; j < 16; ++j) {
      const int i = 16 * qd + j;
      const float gi = g[j] + off;
      const float e1 = __expf(fminf(fmaxf(gi - gm, -80.f), 80.f));
      const float e2 = __builtin_amdgcn_rcpf(e1);
      const float eg = e1 * egm;
      const float e3 = e2 * e6m;
      const int sw = ((c >> 3) ^ (i & 7)) * 8 + (c & 7);
      QG[i * 64 + sw] = f2bf(qh[j] * eg);
      QT[i * 64 + sw] = f2bf(qh[j] * e1);
      KT[i * 64 + sw] = f2bf(ky[j] * e2);
      const float ke = ky[j] * e3, vv = bf2f(ri[j]);
      if (j & 1) { wke[j >> 1] |= ((unsigned)f2bf(ke)) << 16; wvt[j >> 1] |= ((unsigned)ri[j]) << 16; }
      else { wke[j >> 1] = f2bf(ke); wvt[j >> 1] = ri[j]; }
      (void)vv;
    }
    *(uint4*)sw_addr(KET, c, 2 * qd) = (uint4){wke[0], wke[1], wke[2], wke[3]};
    *(uint4*)sw_addr(KET, c, 2 * qd + 1) = (uint4){wke[4], wke[5], wke[6], wke[7]};
    *(uint4*)sw_addr(VT, c, 2 * qd) = (uint4){wvt[0], wvt[1], wvt[2], wvt[3]};
    *(uint4*)sw_addr(VT, c, 2 * qd + 1) = (uint4){wvt[4], wvt[5], wvt[6], wvt[7]};
    if (qd == 0) EG[c] = __expf(g63);
    __syncthreads();
    if (ci + 1 < 68) {
#pragma unroll
      for (int j = 0; j < 16; ++j) {
        const bfr* pr = P + scan_row64(b, d, ci + 1, 16 * qd + j) * 1280 + h * 64 + c;
        rq[j] = pr[0]; ri[j] = pr[256]; rf[j] = pr[512 + d * 256];
      }
    }
    f32x16 AT[2];
#pragma unroll
    for (int m = 0; m < 2; ++m) {
#pragma unroll
      for (int i = 0; i < 16; ++i) AT[m][i] = 0.f;
      if (m <= tb) {
#pragma unroll
        for (int kk = 0; kk < 4; ++kk)
          AT[m] = __builtin_amdgcn_mfma_f32_32x32x16_bf16(frag_nat(KT, 32 * m + r, kk, hf), frag_nat(QT, 32 * tb + r, kk, hf), AT[m], 0, 0, 0);
        if (m == tb) {
#pragma unroll
          for (int i = 0; i < 16; ++i) if (crow_(i, hf) > r) AT[m][i] = 0.f;
        }
      }
    }
    f32x16 o;
#pragma unroll
    for (int i = 0; i < 16; ++i) o[i] = 0.f;
#pragma unroll
    for (int m = 0; m < 2; ++m)
#pragma unroll
      for (int st = 0; st < 2; ++st)
        o = __builtin_amdgcn_mfma_f32_32x32x16_bf16(frag_krow(QG, 32 * tb + r, 4 * m + 2 * st, hf), pack8(S[m], st), o, 0, 0, 0);
#pragma unroll
    for (int m = 0; m < 2; ++m) {
      if (m <= tb) {
#pragma unroll
        for (int st = 0; st < 2; ++st)
          o = __builtin_amdgcn_mfma_f32_32x32x16_bf16(pack8(AT[m], st), frag_krow(VT, 32 * vb + r, 4 * m + 2 * st, hf), o, 0, 0, 0);
      }
    }
#pragma unroll
    for (int m = 0; m < 2; ++m) {
#pragma unroll
      for (int gq = 0; gq < 4; ++gq) {
        float4 e4 = *(const float4*)(EG + 32 * m + 8 * gq + 4 * hf);
        S[m][4 * gq + 0] *= e4.x; S[m][4 * gq + 1] *= e4.y; S[m][4 * gq + 2] *= e4.z; S[m][4 * gq + 3] *= e4.w;
      }
#pragma unroll
      for (int kk = 0; kk < 4; ++kk)
        S[m] = __builtin_amdgcn_mfma_f32_32x32x16_bf16(frag_nat(KET, 32 * m + r, kk, hf), frag_nat(VT, 32 * vb + r, kk, hf), S[m], 0, 0, 0);
    }
#pragma unroll
    for (int i = 0; i < 16; ++i) {
      const int t = 32 * tb + crow_(i, hf);
      P[scan_row64(b, d, ci, t) * 1280 + 512 + d * 256 + h * 64 + 32 * vb + r] = f2bf(o[i]);
    }
  }
  __builtin_amdgcn_s_setprio(0);
}

__device__ __forceinline__ void gdn_solve_task(const Params& p, int l, int task, char* smemc) {
  const int tid = tidx(), lane = tid & 63, wave = __builtin_amdgcn_readfirstlane(tid >> 6), r = lane & 31, hf = lane >> 5;
  const int chunk = task >> 2, h = task & 3;
  const int row0 = chunk * 64;
  int t0, n;
  if (row0 < NLAT) { t0 = row0 & 4095; n = 4096; } else { t0 = (row0 - NLAT) & 255; n = 256; }
  bfr* Kt = (bfr*)smemc;
  float* T0 = (float*)(smemc + 8192);
  float* T1 = T0 + 4096;
  float* GC = T1 + 4096;
  float* BT = GC + 128;
  {
    const int c = lane, qd = wave;
    const int ch = 256 + h * 64 + c;
    const float* gw = p.in[9] + l * 3 * 768;
    const float w0 = gw[ch], w1 = gw[768 + ch], w2 = gw[1536 + ch];
    const bfr* pg = WSP(bfr, OFF_PGDN);
    float x[18];
#pragma unroll
    for (int j = 0; j < 18; ++j) {
      const int tt = t0 + 16 * qd - 1 + j;
      x[j] = (tt >= 0 && tt < n) ? bf2f(pg[(size_t)(row0 + 16 * qd - 1 + j) * 1024 + ch]) : 0.f;
    }
#pragma unroll
    for (int j = 0; j < 16; ++j) {
      float a = w0 * x[j] + w1 * x[j + 1] + w2 * x[j + 2];
      a *= fsigmoid(a);
      float ss = wave_sum(a * a);
      a *= rsqrtf(ss + 1e-6f);
      const int i = 16 * qd + j;
      Kt[i * 64 + (((c >> 3) ^ (i & 7)) << 3) + (c & 7)] = f2bf(a);
    }
  }
  if (wave < 2) {
    const int d = wave, i = lane;
    const int tok = d == 0 ? i : 63 - i;
    const float* ar = WSP(float, OFF_AB) + (size_t)(row0 + tok) * 16;
    const float x = ar[d * 4 + h] + p.in[11][l * 8 + d * 4 + h];
    const float sp = fmaxf(x, 0.f) + log1pf(expf(-fabsf(x)));
    float g = -expf(p.in[10][l * 8 + d * 4 + h]) * sp;
#pragma unroll
    for (int off = 1; off < 64; off <<= 1) { float t = __shfl_up(g, off); if (lane >= off) g += t; }
    GC[d * 64 + i] = g;
    BT[d * 64 + i] = sigmoidf_(ar[8 + d * 4 + h]);
    (WSP(float, OFF_AB) + (size_t)(row0 + tok) * 16)[d * 4 + h] = g;
  }
  __syncthreads();
  {
    const int mi = wave >> 1, nj = wave & 1;
    f32x16 acc;
#pragma unroll
    for (int i = 0; i < 16; ++i) acc[i] = 0.f;
#pragma unroll
    for (int kk = 0; kk < 4; ++kk)
      acc = __builtin_amdgcn_mfma_f32_32x32x16_bf16(frag_nat(Kt, 32 * mi + r, kk, hf), frag_nat(Kt, 32 * nj + r, kk, hf), acc, 0, 0, 0);
    const int tj = 32 * nj + r;
#pragma unroll
    for (int reg = 0; reg < 16; ++reg) {
      const int ti = 32 * mi + crow_(reg, hf);
      if (tj < ti) T0[ti * 64 + tj] = BT[ti] * acc[reg] * __expf(GC[ti] - GC[tj]);
      else if (tj > ti) { const int i = 63 - ti, j = 63 - tj; T1[i * 64 + j] = BT[64 + i] * acc[reg] * __expf(GC[64 + i] - GC[64 + j]); }
    }
  }
  __syncthreads();
  if (wave < 2) {
    const int d = wave, c = lane;
    const float* T = T0 + d * 4096;
    float X[64];
#pragma unroll
    for (int i = 0; i < 64; ++i) {
      float a0 = (i == c) ? 1.f : 0.f, a1 = 0.f, a2 = 0.f, a3 = 0.f;
#pragma unroll
      for (int j = 0; j < i; ++j) {
        const float tx = T[i * 64 + j] * X[j];
        if ((j & 3) == 0) a0 -= tx; else if ((j & 3) == 1) a1 -= tx; else if ((j & 3) == 2) a2 -= tx; else a3 -= tx;
      }
      X[i] = (a0 + a1) + (a2 + a3);
    }
    const float bc = BT[d * 64 + c];
    const int hd = h * 2 + d;
    const int colbase = hd < 4 ? hd * 64 : 512 + (hd - 4) * 64;
    bfr* oc = WSP(bfr, OFF_HN) + (size_t)row0 * 1024 + colbase + c;
#pragma unroll
    for (int i = 0; i < 64; ++i) {
      const int tok = d == 0 ? i : 63 - i;
      oc[(size_t)tok * 1024] = f2bf(X[i] * bc);
    }
  }
  __syncthreads();
}

__device__ __forceinline__ void gdn_chunked(const Params& p, int l, int task, char* smemc) {
  const int b = task >> 3, h = (task >> 1) & 3, d = task & 1;
  const int tid = tidx(), lane = tid & 63, wave = tid >> 6, r = lane & 31, hf = lane >> 5;
  const int tb = wave >> 1, vb = wave & 1;
  bfr* Qn = (bfr*)smemc;
  bfr* Kn = Qn + 4096;
  bfr* NKG = Kn + 4096;
  bfr* QG = NKG + 4096;
  bfr* KGET = QG + 4096;
  bfr* ABm = KGET + 4096;
  bfr* Vn = ABm + 4096;
  float* GC = (float*)(smemc + 57344);
  float* EGC = GC + 64;
  float* EGE = EGC + 64;
  const int cp = tid & 31, og = tid >> 5;
  const int hd = h * 2 + d;
  const int colbase = hd < 4 ? hd * 64 : 512 + (hd - 4) * 64;
  const float Aexp = expf(p.in[10][l * 8 + d * 4 + h]);
  const float dtb = p.in[11][l * 8 + d * 4 + h];
  const bfr* gq = WSP(bfr, OFF_GQ);
  const bfr* oc = WSP(bfr, OFF_HN);
  const float* ab = WSP(float, OFF_AB);
  bfr* P = WSP(bfr, OFF_PGDN);
  f32x16 S[2];
#pragma unroll
  for (int m = 0; m < 2; ++m)
#pragma unroll
    for (int i = 0; i < 16; ++i) S[m][i] = 0.f;
  __builtin_amdgcn_s_setprio(3);
  unsigned rq[8], rk[8], rv[8], ra[8];
  float rga = 0.f;
#pragma unroll
  for (int j = 0; j < 8; ++j) {
    const size_t row = scan_row64(b, d, 0, 8 * og + j);
    const bfr* pr = gq + row * 768 + h * 64 + 2 * cp;
    rq[j] = *(const unsigned*)pr; rk[j] = *(const unsigned*)(pr + 256); rv[j] = *(const unsigned*)(pr + 512);
    ra[j] = *(const unsigned*)(oc + row * 1024 + colbase + 2 * cp);
  }
  if (tid < 64) rga = ab[scan_row64(b, d, 0, tid) * 16 + d * 4 + h];
#pragma unroll 1
  for (int ci = 0; ci < 68; ++ci) {
    __syncthreads();
    if (wave == 0) {
      const float g = rga;
      const float g63 = __shfl(g, 63);
      GC[lane] = g; EGC[lane] = __expf(g); EGE[lane] = __expf(g63 - g);
    }
    __syncthreads();
    {
      unsigned w0[4], w1[4];
#pragma unroll
      for (int j = 0; j < 8; ++j) {
        const int i = 8 * og + j;
        const float eg = EGC[i], ee = EGE[i];
        const int addr = i * 64 + ((((cp >> 2) ^ (i & 7))) << 3) + 2 * (cp & 3);
        const float q0 = __uint_as_float(rq[j] << 16), q1 = __uint_as_float(rq[j] & 0xffff0000u);
        const float k0 = __uint_as_float(rk[j] << 16), k1 = __uint_as_float(rk[j] & 0xffff0000u);
        *(unsigned*)(Qn + addr) = rq[j];
        *(unsigned*)(Kn + addr) = rk[j];
        *(unsigned*)(Vn + addr) = rv[j];
        *(unsigned*)(ABm + addr) = ra[j];
        *(unsigned*)(NKG + addr) = pk2(-k0 * eg, -k1 * eg);
        *(unsigned*)(QG + addr) = pk2(q0 * 0.125f * eg, q1 * 0.125f * eg);
        const unsigned e0 = f2bf(k0 * ee), e1 = f2bf(k1 * ee);
        if (j & 1) { w0[j >> 1] |= e0 << 16; w1[j >> 1] |= e1 << 16; } else { w0[j >> 1] = e0; w1[j >> 1] = e1; }
      }
      *(uint4*)sw_addr(KGET, 2 * cp, og) = (uint4){w0[0], w0[1], w0[2], w0[3]};
      *(uint4*)sw_addr(KGET, 2 * cp + 1, og) = (uint4){w1[0], w1[1], w1[2], w1[3]};
    }
    __syncthreads();
    if (ci + 1 < 68) {
#pragma unroll
      for (int j = 0; j < 8; ++j) {
        const size_t row = scan_row64(b, d, ci + 1, 8 * og + j);
        const bfr* pr = gq + row * 768 + h * 64 + 2 * cp;
        rq[j] = *(const unsigned*)pr; rk[j] = *(const unsigned*)(pr + 256); rv[j] = *(const unsigned*)(pr + 512);
        ra[j] = *(const unsigned*)(oc + row * 1024 + colbase + 2 * cp);
      }
      if (tid < 64) rga = ab[scan_row64(b, d, ci + 1, tid) * 16 + d * 4 + h];
    }
    f32x16 vn[2];
#pragma unroll
    for (int mt = 0; mt < 2; ++mt)
#pragma unroll
      for (int i = 0; i < 16; ++i) vn[mt][i] = 0.f;
#pragma unroll
    for (int m = 0; m < 2; ++m) {
      f32x16 rr;
#pragma unroll
      for (int reg = 0; reg < 16; ++reg) {
        const int i = 32 * m + crow_(reg, hf), v = 32 * vb + r;
        rr[reg] = bf2f(Vn[i * 64 + (((v >> 3) ^ (i & 7)) << 3) + (v & 7)]);
      }
#pragma unroll
      for (int mp = 0; mp < 2; ++mp)
#pragma unroll
        for (int st = 0; st < 2; ++st)
          rr = __builtin_amdgcn_mfma_f32_32x32x16_bf16(frag_krow(NKG, 32 * m + r, 4 * mp + 2 * st, hf), pack8(S[mp], st), rr, 0, 0, 0);
#pragma unroll
      for (int mt = 0; mt < 2; ++mt) {
        if (m <= mt) {
#pragma unroll
          for (int st = 0; st < 2; ++st)
            vn[mt] = __builtin_amdgcn_mfma_f32_32x32x16_bf16(frag_krow(ABm, 32 * mt + r, 4 * m + 2 * st, hf), pack8(rr, st), vn[mt], 0, 0, 0);
        }
      }
    }
    f32x16 o;
#pragma unroll
    for (int i = 0; i < 16; ++i) o[i] = 0.f;
#pragma unroll
    for (int mp = 0; mp < 2; ++mp)
#pragma unroll
      for (int st = 0; st < 2; ++st)
        o = __builtin_amdgcn_mfma_f32_32x32x16_bf16(frag_krow(QG, 32 * tb + r, 4 * mp + 2 * st, hf), pack8(S[mp], st), o, 0, 0, 0);
    const float gct = GC[32 * tb + r];
#pragma unroll
    for (int m = 0; m < 2; ++m) {
      if (m <= tb) {
        f32x16 AT;
#pragma unroll
        for (int i = 0; i < 16; ++i) AT[i] = 0.f;
#pragma unroll
        for (int kk = 0; kk < 4; ++kk)
          AT = __builtin_amdgcn_mfma_f32_32x32x16_bf16(frag_nat(Kn, 32 * m + r, kk, hf), frag_nat(Qn, 32 * tb + r, kk, hf), AT, 0, 0, 0);
#pragma unroll
        for (int g4i = 0; g4i < 4; ++g4i) {
          const float4 g4 = *(const float4*)(GC + 32 * m + 8 * g4i + 4 * hf);
          const float gs[4] = {g4.x, g4.y, g4.z, g4.w};
#pragma unroll
          for (int jj = 0; jj < 4; ++jj) {
            const int reg = 4 * g4i + jj;
            const bool keep = (m < tb) || (crow_(reg, hf) <= r);
            AT[reg] = keep ? AT[reg] * 0.125f * __expf(gct - gs[jj]) : 0.f;
          }
        }
#pragma unroll
        for (int st = 0; st < 2; ++st)
          o = __builtin_amdgcn_mfma_f32_32x32x16_bf16(pack8(AT, st), pack8(vn[m], st), o, 0, 0, 0);
      }
    }
    const float eg63 = EGC[63];
#pragma unroll
    for (int mp = 0; mp < 2; ++mp) {
#pragma unroll
      for (int i = 0; i < 16; ++i) S[mp][i] *= eg63;
#pragma unroll
      for (int m = 0; m < 2; ++m)
#pragma unroll
        for (int st = 0; st < 2; ++st)
          S[mp] = __builtin_amdgcn_mfma_f32_32x32x16_bf16(frag_krow(KGET, 32 * mp + r, 4 * m + 2 * st, hf), pack8(vn[m], st), S[mp], 0, 0, 0);
    }
#pragma unroll
    for (int i = 0; i < 16; ++i) {
      const int t = 32 * tb + crow_(i, hf);
      P[scan_row64(b, d, ci, t) * 1024 + d * 256 + h * 64 + 32 * vb + r] = f2bf(o[i]);
    }
  }
  __builtin_amdgcn_s_setprio(0);
}

__device__ __forceinline__ void gdn_scan(const Params& p, int l, int task, float* smem) {
  const int b = task >> 3, h = (task >> 1) & 3, d = task & 1;
  const int tid = tidx(), lane = tid & 63, wave = tid >> 6;
  const int kg = lane & 3, vv = wave * 16 + (lane >> 2);
  float* sq = smem;
  float* sk = smem + 2048;
  float* sv = smem + 4096;
  float* so = smem + 6144;
  float* seg_ = smem + 8192;
  float* sbt = smem + 8192 + 32;
  const bfr* gq = WSP(bfr, OFF_GQ);
  const float* ab = WSP(float, OFF_AB);
  bfr* P = WSP(bfr, OFF_PGDN);
  const float Aexp = expf(p.in[10][l * 8 + d * 4 + h]);
  const float dtb = p.in[11][l * 8 + d * 4 + h];
  const int ch = tid & 63, i0 = tid >> 6;
  v2f S2[8];
#pragma unroll
  for (int i = 0; i < 8; ++i) S2[i] = (v2f){0.f, 0.f};
  __builtin_amdgcn_s_setprio(3);
  bfr rq[8], rk[8], rv[8];
  float ra = 0.f, rb = 0.f;
#pragma unroll
  for (int j = 0; j < 8; ++j) {
    const bfr* pr = gq + scan_row(b, d, 0, i0 + 4 * j) * 768 + h * 64 + ch;
    rq[j] = pr[0]; rk[j] = pr[256]; rv[j] = pr[512];
  }
  if (tid < 32) { const float* ar = ab + scan_row(b, d, 0, tid) * 16; ra = ar[d * 4 + h]; rb = ar[8 + d * 4 + h]; }
  for (int ci = 0; ci < 136; ++ci) {
#pragma unroll
    for (int j = 0; j < 8; ++j) {
      const int e = (i0 + 4 * j) * 64 + ch;
      sq[e] = bf2f(rq[j]) * 0.125f;
      sk[e] = bf2f(rk[j]);
      sv[e] = bf2f(rv[j]);
    }
    if (tid < 32) {
      float x = ra + dtb;
      float sp = fmaxf(x, 0.f) + log1pf(expf(-fabsf(x)));
      seg_[tid] = expf(-Aexp * sp);
      sbt[tid] = sigmoidf_(rb);
    }
    __syncthreads();
    if (ci + 1 < 136) {
#pragma unroll
      for (int j = 0; j < 8; ++j) {
        const bfr* pr = gq + scan_row(b, d, ci + 1, i0 + 4 * j) * 768 + h * 64 + ch;
        rq[j] = pr[0]; rk[j] = pr[256]; rv[j] = pr[512];
      }
      if (tid < 32) { const float* ar = ab + scan_row(b, d, ci + 1, tid) * 16; ra = ar[d * 4 + h]; rb = ar[8 + d * 4 + h]; }
    }
#pragma unroll 4
    for (int i = 0; i < 32; ++i) {
      const float vcur = sv[i * 64 + vv];
      const float eg = seg_[i], bt = sbt[i];
      const float4* k4 = (const float4*)(sk + i * 64 + kg * 16);
      const float4* q4 = (const float4*)(sq + i * 64 + kg * 16);
      v2f kk[8], qq[8];
#pragma unroll
      for (int j = 0; j < 4; ++j) {
        float4 a = k4[j], c = q4[j];
        kk[2 * j] = (v2f){a.x, a.y}; kk[2 * j + 1] = (v2f){a.z, a.w};
        qq[2 * j] = (v2f){c.x, c.y}; qq[2 * j + 1] = (v2f){c.z, c.w};
      }
      v2f ka = {0.f, 0.f}, kb = {0.f, 0.f};
#pragma unroll
      for (int j = 0; j < 4; ++j) { ka += kk[2 * j] * S2[2 * j]; kb += kk[2 * j + 1] * S2[2 * j + 1]; }
      const float ks = quad_sum((ka.x + ka.y) + (kb.x + kb.y));
      const float cfac = bt * (vcur - eg * ks);
      const v2f eg2 = {eg, eg}, cf2 = {cfac, cfac};
      v2f pa = {0.f, 0.f}, pb = {0.f, 0.f};
#pragma unroll
      for (int j = 0; j < 4; ++j) {
        S2[2 * j] = kk[2 * j] * cf2 + eg2 * S2[2 * j];
        S2[2 * j + 1] = kk[2 * j + 1] * cf2 + eg2 * S2[2 * j + 1];
        pa += qq[2 * j] * S2[2 * j];
        pb += qq[2 * j + 1] * S2[2 * j + 1];
      }
      const float po = quad_sum((pa.x + pa.y) + (pb.x + pb.y));
      if (kg == 0) so[i * 64 + vv] = po;
    }
    __syncthreads();
#pragma unroll
    for (int j = 0; j < 8; ++j) {
      const int i = i0 + 4 * j;
      P[scan_row(b, d, ci, i) * 1024 + d * 256 + h * 64 + ch] = f2bf(so[i * 64 + ch]);
    }
  }
  __builtin_amdgcn_s_setprio(0);
}

__device__ __forceinline__ void hy_conv(const Params& p, int l, int stage, int task) {
  const int c = tidx();
  int n, t0;
  size_t rowbase;
  const float* G;
  { int tk = task; int b = tk >> 4; n = 256; t0 = (tk & 15) * 16; rowbase = (size_t)NLAT + b * 256; G = ((l & 1) ? WSP(float, OFF_GFC2) : WSP(float, OFF_GFC)) + (size_t)stage * 511 * 256; }
  const bfr* U = (stage == 0 ? WSP(bfr, OFF_HVC) : WSP(bfr, OFF_HZC)) - (size_t)NLAT * 256;
  float acc[16];
#pragma unroll
  for (int i = 0; i < 16; ++i) acc[i] = 0.f;
  for (int s0 = 0; s0 < n; s0 += 16) {
    float u[16], w[31];
#pragma unroll
    for (int j = 0; j < 16; ++j) u[j] = bf2f(U[(rowbase + s0 + j) * 256 + c]);
    const float* Gb = G + (size_t)(t0 - s0 - 15 + n - 1) * 256 + c;
#pragma unroll
    for (int m = 0; m < 31; ++m) w[m] = Gb[(size_t)m * 256];
#pragma unroll
    for (int i = 0; i < 16; ++i)
#pragma unroll
      for (int j = 0; j < 16; ++j) acc[i] += w[i - j + 15] * u[j];
  }
  const bfr* ph = WSP(bfr, OFF_PHY);
  const float* hw = p.in[13] + l * 3 * 768;
  const int xc = 256 + stage * 256 + c;
  float w0 = hw[xc], w1 = hw[768 + xc], w2 = hw[1536 + xc];
#pragma unroll
  for (int i = 0; i < 16; ++i) {
    int t = t0 + i;
    size_t row = rowbase + t;
    float xg = w1 * bf2f(ph[row * 768 + xc]);
    if (t > 0) xg += w0 * bf2f(ph[(row - 1) * 768 + xc]);
    if (t < n - 1) xg += w2 * bf2f(ph[(row + 1) * 768 + xc]);
    float val = xg * acc[i];
    if (stage == 0) (WSP(bfr, OFF_HZC) - (size_t)NLAT * 256)[row * 256 + c] = f2bf(val);
    else WSP(bfr, OFF_HN)[row * 1024 + 256 + c] = f2bf(val);
  }
}

__device__ __forceinline__ bf16x8 toep_frag(const unsigned* Rs, int e0) {
  const int dw = e0 >> 1;
  const unsigned sh = (unsigned)(e0 & 1) * 16u;
  unsigned d0 = Rs[dw], d1 = Rs[dw + 1], d2 = Rs[dw + 2], d3 = Rs[dw + 3], d4 = Rs[dw + 4];
  uint4 o;
  o.x = __builtin_amdgcn_alignbit(d1, d0, sh);
  o.y = __builtin_amdgcn_alignbit(d2, d1, sh);
  o.z = __builtin_amdgcn_alignbit(d3, d2, sh);
  o.w = __builtin_amdgcn_alignbit(d4, d3, sh);
  return __builtin_bit_cast(bf16x8, o);
}
__device__ __forceinline__ void hy_task(const Params& p, int l, int task, char* smemc) {
  const int tid = tidx(), lane = tid & 63, wave = tid >> 6, r = lane & 31, hf = lane >> 5;
  const int c = task >> 1, bh = task & 1;
  unsigned* Rs = (unsigned*)smemc;
  bfr* Us = (bfr*)(smemc + 16384 + 64);
  constexpr int USTR = 4104;
  const int bl = r & 3, t1l = r >> 2;
  f32x16 acc[2][2];
  __syncthreads();
  for (int i = tid; i < 2048; i += 256) {
    int b4 = i >> 9, c16 = i & 511;
    *(uint4*)(Us + b4 * USTR + c16 * 8) = *(const uint4*)(WSP(bfr, OFF_HVT) + ((size_t)(c * 8 + bh * 4 + b4)) * 4096 + c16 * 8);
  }
#pragma unroll 1
  for (int stage = 0; stage < 2; ++stage) {
    {
      const uint4* rsrc = (const uint4*)(WSP(bfr, OFF_RF) + (size_t)(l & 1) * (4 * MIB) + ((size_t)(stage * 256 + c)) * 8192);
      for (int i = tid; i < 1024; i += 256) ((uint4*)Rs)[i] = rsrc[i];
      if (tid < 8) Rs[4096 + tid] = 0u;
    }
    __syncthreads();
#pragma unroll
    for (int a = 0; a < 2; ++a)
#pragma unroll
      for (int m = 0; m < 2; ++m)
#pragma unroll
        for (int i = 0; i < 16; ++i) acc[a][m][i] = 0.f;
#pragma unroll 1
    for (int d1 = 16 * wave - 63; d1 <= 16 * wave + 15; ++d1) {
      const int eb = 4096 - 64 * d1 - r + 8 * hf;
      bf16x8 f0 = toep_frag(Rs, eb);
      bf16x8 f1 = toep_frag(Rs, eb + 16);
      bf16x8 f2 = toep_frag(Rs, eb + 32);
      bf16x8 f3 = toep_frag(Rs, eb + 48);
      bf16x8 f4 = toep_frag(Rs, eb - 32);
      bf16x8 f5 = toep_frag(Rs, eb - 16);
#pragma unroll
      for (int nt = 0; nt < 2; ++nt) {
        const int t1lo = 16 * wave + 8 * nt;
        if (t1lo + 7 - d1 < 0 || t1lo - d1 > 63) continue;
        const int s1 = t1lo + t1l - d1;
        const bool valid = (s1 >= 0) && (s1 < 64);
        const bfr* up = Us + bl * USTR + 64 * (valid ? s1 : 0) + 8 * hf;
        bf16x8 b0 = *(const bf16x8*)(up), b1 = *(const bf16x8*)(up + 16), b2 = *(const bf16x8*)(up + 32), b3 = *(const bf16x8*)(up + 48);
        if (!valid) {
#pragma unroll
          for (int i = 0; i < 8; ++i) { b0[i] = 0; b1[i] = 0; b2[i] = 0; b3[i] = 0; }
        }
        acc[nt][0] = __builtin_amdgcn_mfma_f32_32x32x16_bf16(f0, b0, acc[nt][0], 0, 0, 0);
        acc[nt][0] = __builtin_amdgcn_mfma_f32_32x32x16_bf16(f1, b1, acc[nt][0], 0, 0, 0);
        acc[nt][0] = __builtin_amdgcn_mfma_f32_32x32x16_bf16(f2, b2, acc[nt][0], 0, 0, 0);
        acc[nt][0] = __builtin_amdgcn_mfma_f32_32x32x16_bf16(f3, b3, acc[nt][0], 0, 0, 0);
        acc[nt][1] = __builtin_amdgcn_mfma_f32_32x32x16_bf16(f4, b0, acc[nt][1], 0, 0, 0);
        acc[nt][1] = __builtin_amdgcn_mfma_f32_32x32x16_bf16(f5, b1, acc[nt][1], 0, 0, 0);
        acc[nt][1] = __builtin_amdgcn_mfma_f32_32x32x16_bf16(f0, b2, acc[nt][1], 0, 0, 0);
        acc[nt][1] = __builtin_amdgcn_mfma_f32_32x32x16_bf16(f1, b3, acc[nt][1], 0, 0, 0);
      }
    }
    const bfr* gate = WSP(bfr, stage == 0 ? OFF_X1T : OFF_X2T) + ((size_t)(c * 8 + bh * 4 + bl)) * 4096;
    __syncthreads();
#pragma unroll
    for (int nt = 0; nt < 2; ++nt)
#pragma unroll
      for (int m = 0; m < 2; ++m)
#pragma unroll
        for (int g = 0; g < 4; ++g) {
          const int t = 64 * (16 * wave + 8 * nt + t1l) + 32 * m + 8 * g + 4 * hf;
          uint2 gw = *(const uint2*)(gate + t);
          float v0 = acc[nt][m][4 * g + 0] * __uint_as_float(gw.x << 16);
          float v1 = acc[nt][m][4 * g + 1] * __uint_as_float(gw.x & 0xffff0000u);
          float v2 = acc[nt][m][4 * g + 2] * __uint_as_float(gw.y << 16);
          float v3 = acc[nt][m][4 * g + 3] * __uint_as_float(gw.y & 0xffff0000u);
          uint2 o; o.x = pk2(v0, v1); o.y = pk2(v2, v3);
          *(uint2*)(Us + bl * USTR + t) = o;
        }
  }
  __syncthreads();
  for (int i = tid; i < 2048; i += 256) {
    int b4 = i >> 9, c16 = i & 511;
    *(uint4*)(WSP(bfr, OFF_HVT) + ((size_t)(c * 8 + bh * 4 + b4)) * 4096 + c16 * 8) = *(const uint4*)(Us + b4 * USTR + c16 * 8);
  }
}

__device__ __forceinline__ void attn_task(const Params& p, int l, int task, char* smemc) {
  const int tid = tidx(), lane = tid & 63, wave = tid >> 6, r = lane & 31, hf = lane >> 5;
  int b, h, q0, kbeg;
  size_t qrowbase;
  if (task < 1024) { b = task >> 7; h = (task >> 5) & 3; q0 = (task & 31) * 128; qrowbase = (size_t)b * 4096; kbeg = 0; }
  else { int tk = task - 1024; b = tk >> 3; h = (tk >> 1) & 3; q0 = (tk & 1) * 128; qrowbase = (size_t)NLAT + b * 256; kbeg = 4096; }
  bfr* Ks = (bfr*)smemc;
  bfr* Vs = Ks + 2 * 64 * 72;
  const bfr* pd = WSP(bfr, OFF_PDA);
  const bfr* vt = WSP(bfr, OFF_VT) + (size_t)((b * 4 + h) * 64) * 4352;
  const size_t qrow = qrowbase + q0 + wave * 32 + r;
  bf16x8 qf[2][2];
#pragma unroll
  for (int j = 0; j < 2; ++j)
#pragma unroll
    for (int s = 0; s < 2; ++s) qf[j][s] = *(const bf16x8*)(pd + qrow * 768 + h * 64 + j * 32 + 16 * s + 8 * hf);
  float mq = 0.f, mk = 0.f;
  for (int i = 0; i < 32; ++i) { mq = fmaxf(mq, fabsf(p.in[25][l * 32 + i])); mk = fmaxf(mk, fabsf(p.in[26][l * 32 + i])); }
  const float Mb = 5.6568542f * 1.03f * mq * mk * 1.44269504f;
  f32x16 O[2][2];
#pragma unroll
  for (int j = 0; j < 2; ++j)
#pragma unroll
    for (int d = 0; d < 2; ++d)
#pragma unroll
      for (int i = 0; i < 16; ++i) O[j][d][i] = 0.f;
  float ls[2] = {0.f, 0.f};
  const int nt = (4352 - kbeg) >> 6;
  const int lrow = tid >> 3, lpart = (tid & 7) * 8;
  uint4 rk0, rk1, rv0, rv1;
  auto kptr = [&](int k0, int rowi) -> const bfr* {
    int kidx = k0 + rowi;
    size_t krow = kidx < 4096 ? (size_t)b * 4096 + kidx : (size_t)NLAT + b * 256 + (kidx - 4096);
    return pd + krow * 768 + 256 + h * 64 + lpart;
  };
  rk0 = *(const uint4*)kptr(kbeg, lrow);
  rk1 = *(const uint4*)kptr(kbeg, lrow + 32);
  rv0 = *(const uint4*)(vt + (size_t)lrow * 4352 + kbeg + lpart);
  rv1 = *(const uint4*)(vt + (size_t)(lrow + 32) * 4352 + kbeg + lpart);
  __syncthreads();
  *(uint4*)(Ks + (lrow)*72 + lpart) = rk0;
  *(uint4*)(Ks + (lrow + 32) * 72 + lpart) = rk1;
  *(uint4*)(Vs + (lrow)*72 + lpart) = rv0;
  *(uint4*)(Vs + (lrow + 32) * 72 + lpart) = rv1;
  __syncthreads();
  for (int kt = 0; kt < nt; ++kt) {
    const int cur = kt & 1;
    if (kt + 1 < nt) {
      const int k0 = kbeg + (kt + 1) * 64;
      rk0 = *(const uint4*)kptr(k0, lrow);
      rk1 = *(const uint4*)kptr(k0, lrow + 32);
      rv0 = *(const uint4*)(vt + (size_t)lrow * 4352 + k0 + lpart);
      rv1 = *(const uint4*)(vt + (size_t)(lrow + 32) * 4352 + k0 + lpart);
    }
#pragma unroll
    for (int sub = 0; sub < 2; ++sub) {
      bf16x8 vf[2][2];
#pragma unroll
      for (int d = 0; d < 2; ++d)
#pragma unroll
        for (int s = 0; s < 2; ++s) vf[d][s] = *(const bf16x8*)(Vs + (cur * 64 + d * 32 + r) * 72 + sub * 32 + 16 * s + 8 * hf);
#pragma unroll
      for (int j = 0; j < 2; ++j) {
        bf16x8 kf0 = *(const bf16x8*)(Ks + (cur * 64 + sub * 32 + r) * 72 + j * 32 + 8 * hf);
        bf16x8 kf1 = *(const bf16x8*)(Ks + (cur * 64 + sub * 32 + r) * 72 + j * 32 + 16 + 8 * hf);
        f32x16 S;
#pragma unroll
        for (int i = 0; i < 16; ++i) S[i] = -Mb;
        __builtin_amdgcn_s_setprio(1);
        S = __builtin_amdgcn_mfma_f32_32x32x16_bf16(kf0, qf[j][0], S, 0, 0, 0);
        S = __builtin_amdgcn_mfma_f32_32x32x16_bf16(kf1, qf[j][1], S, 0, 0, 0);
        __builtin_amdgcn_s_setprio(0);
#pragma unroll
        for (int i = 0; i < 16; ++i) S[i] = __builtin_amdgcn_exp2f(S[i]);
        v2f ps2 = {0.f, 0.f};
#pragma unroll
        for (int i = 0; i < 8; ++i) ps2 += (v2f){S[2 * i], S[2 * i + 1]};
        ls[j] += ps2.x + ps2.y;
        unsigned pw[8];
#pragma unroll
        for (int i = 0; i < 8; ++i) pw[i] = pk2(S[2 * i], S[2 * i + 1]);
        bf16x8 pf0 = __builtin_bit_cast(bf16x8, (uint4){pw[0], pw[1], pw[2], pw[3]});
        bf16x8 pf1 = __builtin_bit_cast(bf16x8, (uint4){pw[4], pw[5], pw[6], pw[7]});
        __builtin_amdgcn_s_setprio(1);
#pragma unroll
        for (int d = 0; d < 2; ++d) {
          O[j][d] = __builtin_amdgcn_mfma_f32_32x32x16_bf16(vf[d][0], pf0, O[j][d], 0, 0, 0);
          O[j][d] = __builtin_amdgcn_mfma_f32_32x32x16_bf16(vf[d][1], pf1, O[j][d], 0, 0, 0);
        }
        __builtin_amdgcn_s_setprio(0);
      }
    }
    if (kt + 1 < nt) {
      const int nx = cur ^ 1;
      *(uint4*)(Ks + (nx * 64 + lrow) * 72 + lpart) = rk0;
      *(uint4*)(Ks + (nx * 64 + lrow + 32) * 72 + lpart) = rk1;
      *(uint4*)(Vs + (nx * 64 + lrow) * 72 + lpart) = rv0;
      *(uint4*)(Vs + (nx * 64 + lrow + 32) * 72 + lpart) = rv1;
    }
    __syncthreads();
  }
  ls[0] += __shfl_xor(ls[0], 32);
  ls[1] += __shfl_xor(ls[1], 32);
  const float* lp = p.in[27] + l * 128;
  float d01 = 0.f, d23 = 0.f;
  for (int i = 0; i < 32; ++i) { d01 += lp[i] * lp[32 + i]; d23 += lp[64 + i] * lp[96 + i]; }
  const float lam_init = 0.8f - 0.6f * expf(-0.3f * (float)l);
  const float lam = expf(d01) - expf(d23) + lam_init;
  const float i0 = 1.f / ls[0], i1 = lam / ls[1];
  float ss = 0.f;
#pragma unroll
  for (int d = 0; d < 2; ++d)
#pragma unroll
    for (int i = 0; i < 16; ++i) { float o = O[0][d][i] * i0 - O[1][d][i] * i1; O[0][d][i] = o; ss += o * o; }
  ss += __shfl_xor(ss, 32);
  const float rn = rsqrtf(ss * (1.f / 64.f) + 1e-6f) * (1.f - lam_init);
  const float* sw = p.in[28] + l * 64;
  bfr* op = WSP(bfr, OFF_HN) + qrow * 1024 + 768 + h * 64;
#pragma unroll
  for (int d = 0; d < 2; ++d)
#pragma unroll
    for (int g = 0; g < 4; ++g) {
      const int dv = d * 32 + 8 * g + 4 * hf;
      float4 w4 = *(const float4*)(sw + dv);
      uint2 o;
      o.x = pk2(O[0][d][4 * g + 0] * rn * w4.x, O[0][d][4 * g + 1] * rn * w4.y);
      o.y = pk2(O[0][d][4 * g + 2] * rn * w4.z, O[0][d][4 * g + 3] * rn * w4.w);
      *(uint2*)(op + dv) = o;
    }
}

__device__ __forceinline__ void finish_task(const Params& p, int l, int task  , char* smemc) {
  const int tid = tidx();
  if (task < 1024) {
    bfr* tile = (bfr*)smemc;
    const int row0 = task * 32, bb = row0 >> 12, t0 = row0 & 4095;
    const bfr* src = WSP(bfr, OFF_HVT) + ((size_t)(tid * 8 + bb)) * 4096 + t0;
#pragma unroll
    for (int i = 0; i < 4; ++i) *(uint4*)(tile + tid * 40 + 8 * i) = ((const uint4*)src)[i];
    __syncthreads();
    const int rr = tid >> 3, part = tid & 7;
    bfr* dst = WSP(bfr, OFF_HN) + (size_t)(row0 + rr) * 1024 + 256 + part * 32;
#pragma unroll
    for (int i = 0; i < 4; ++i) {
      unsigned w[4];
#pragma unroll
      for (int q = 0; q < 4; ++q) {
        const int c0 = part * 32 + i * 8 + q * 2;
        w[q] = (unsigned)tile[c0 * 40 + rr] | ((unsigned)tile[(c0 + 1) * 40 + rr] << 16);
      }
      ((uint4*)dst)[i] = (uint4){w[0], w[1], w[2], w[3]};
    }
    __syncthreads();
  }
  const int rr = tid >> 3, hd = tid & 7;
  const size_t row = (size_t)task * 32 + rr;
  const bfr *pf, *pb, *pgt;
  const float* nw;
  bfr* dst;
  if (hd < 4) {
    const bfr* r = WSP(bfr, OFF_PGDN) + row * 1024;
    pf = r + hd * 64; pb = r + 256 + hd * 64; pgt = r + 768 + hd * 64;
    nw = p.in[12] + l * 64; dst = WSP(bfr, OFF_HN) + row * 1024 + hd * 64;
  } else {
    const int hh = hd - 4;
    const bfr* r = WSP(bfr, OFF_PHG) + row * 1280;
    pf = r + 512 + hh * 64; pb = r + 768 + hh * 64; pgt = r + 1024 + hh * 64;
    nw = p.in[24] + l * 64; dst = WSP(bfr, OFF_HN) + row * 1024 + 512 + hh * 64;
  }
  uint4 vf[8], vb[8], vg[8];
#pragma unroll
  for (int i = 0; i < 8; ++i) { vf[i] = ((const uint4*)pf)[i]; vb[i] = ((const uint4*)pb)[i]; vg[i] = ((const uint4*)pgt)[i]; }
  float o[64];
  float ss = 0.f;
#pragma unroll
  for (int i = 0; i < 8; ++i) {
    const unsigned a[4] = {vf[i].x, vf[i].y, vf[i].z, vf[i].w};
    const unsigned c[4] = {vb[i].x, vb[i].y, vb[i].z, vb[i].w};
#pragma unroll
    for (int q = 0; q < 4; ++q) {
      float lo = __uint_as_float(a[q] << 16) + __uint_as_float(c[q] << 16);
      float hi = __uint_as_float(a[q] & 0xffff0000u) + __uint_as_float(c[q] & 0xffff0000u);
      o[8 * i + 2 * q] = lo; o[8 * i + 2 * q + 1] = hi;
      ss += lo * lo + hi * hi;
    }
  }
  const float rn = rsqrtf(ss * (1.f / 64.f) + 1e-6f);
#pragma unroll
  for (int i = 0; i < 8; ++i) {
    const unsigned g[4] = {vg[i].x, vg[i].y, vg[i].z, vg[i].w};
    unsigned w[4];
#pragma unroll
    for (int q = 0; q < 4; ++q) {
      float g0 = __uint_as_float(g[q] << 16), g1 = __uint_as_float(g[q] & 0xffff0000u);
      float y0 = o[8 * i + 2 * q] * rn * nw[8 * i + 2 * q] * siluf_(g0);
      float y1 = o[8 * i + 2 * q + 1] * rn * nw[8 * i + 2 * q + 1] * siluf_(g1);
      w[q] = pk2(y0, y1);
    }
    ((uint4*)dst)[i] = (uint4){w[0], w[1], w[2], w[3]};
  }
}

__global__ void __launch_bounds__(256, 2) mega(Params p) {
  extern __shared__ __attribute__((aligned(1024))) char smemc[];
  __shared__ int s_task;
  float* smem = (float*)smemc;
  cg::grid_group grid = cg::this_grid();
  unsigned* ctr = WSP(unsigned, OFF_CTR);
  const int G = gridDim.x, bid = blockIdx.x;

  __shared__ uint4 xb_words;
  if (threadIdx.x == 0) xb_words = make_uint4(0u, 0u, 0u, 0u);
  __syncthreads();
  XcdBarrier xb = xcd_barrier_post(WSP(unsigned, OFF_CTR) + 1024, (volatile LAS unsigned*)&xb_words);
  phase_mod(p, smem);
  for (int task = G - 1 - bid; task < 272; task += G) { int l0 = 0; asm volatile("" : "+s"(l0)); filt_task(p, l0, task, smem); }
  grid.sync();

  for (int l = 0; l < 4; ++l) {
    const bool want_ctx = l < 3;
    for (int task = bid; task < 3296 + 1088; task += G) {
      int lq = l; asm volatile("" : "+s"(lq));
      if (task < 3296) wconv_tile(p, lq, task, smem);
      else norm_rows(p, lq, 0, task - 3296);
    }
    xcd_barrier(xb);
    { int lq = l; asm volatile("" : "+s"(lq));
    gemm_phase<0>(p, lq, WSP(bfr, OFF_HN), 1024, WSP(bfr, OFF_WIN), 1024, 136, 31, smemc); }
    xcd_barrier(xb);
    while (true) {
      __syncthreads();
      if (threadIdx.x == 0) s_task = (int)atomicAdd(&ctr[64 + l], 1u);
      __syncthreads();
      const int task = s_task;
      if (task >= 1088 + 2176) break;
      int lq = l; asm volatile("" : "+s"(lq));
      if (task < 1088) prep_task(p, lq, task, smemc);
      else gdn_solve_task(p, lq, task - 1088, smemc);
    }
    xcd_barrier(xb);
    {
      const int nhy = want_ctx ? 640 : 512, nat = want_ctx ? 1088 : 1024;
      const int nflt = want_ctx ? 272 : 0;
      const int total = 128 + nhy + nat + nflt;
      while (true) {
        __syncthreads();
        if (threadIdx.x == 0) s_task = (int)atomicAdd(&ctr[l * 2], 1u);
        __syncthreads();
        int task = s_task;
        if (task >= total) break;
        int lq = l; asm volatile("" : "+s"(lq));
        if (task < 64) gdn_chunked(p, lq, task, smemc);
        else if (task < 128) hgrn_chunked(p, lq, task - 64, smemc);
        else if (task < 128 + 512) hy_task(p, lq, task - 128, smemc);
        else if (task < 128 + nhy) hy_conv(p, lq, 0, task - 640);
        else if (task < 128 + nhy + nat) attn_task(p, lq, task - 128 - nhy, smemc);
        else filt_task(p, lq + 1, task - 128 - nhy - nat, smem);
      }
    }
    xcd_barrier(xb);
    {
      const int nhy = want_ctx ? 128 : 0, nfin = want_ctx ? 1088 : 1024;
      const int total = nhy + nfin;
      while (true) {
        __syncthreads();
        if (threadIdx.x == 0) s_task = (int)atomicAdd(&ctr[l * 2 + 1], 1u);
        __syncthreads();
        int task = s_task;
        if (task >= total) break;
        int lq = l; asm volatile("" : "+s"(lq));
        if (task < nhy) hy_conv(p, lq, 1, task);
        else finish_task(p, lq, task - nhy, smemc);
      }
    }
    xcd_barrier(xb);
    const int mt = want_ctx ? 136 : 128;
    { int lq = l; asm volatile("" : "+s"(lq));
    gemm_phase<1>(p, lq, WSP(bfr, OFF_HN), 1024, WSP(bfr, OFF_WOUT), 1024, mt, 8, smemc); }
    xcd_barrier(xb);
    for (int task = bid; task < mt * 8; task += G) { int lq = l; asm volatile("" : "+s"(lq)); norm_rows(p, lq, 1, task); }
    xcd_barrier(xb);
    { int lq = l; asm volatile("" : "+s"(lq));
    gemm_phase<2>(p, lq, WSP(bfr, OFF_HN), 1024, WSP(bfr, OFF_W1), 1024, mt, 32, smemc); }
    xcd_barrier(xb);
    { int lq = l; asm volatile("" : "+s"(lq));
    gemm_phase<3>(p, lq, WSP(bfr, OFF_HID), 4096, WSP(bfr, OFF_W2), 4096, mt, 8, smemc); }
    if (l < 3) xcd_barrier(xb);
  }
}

extern "C" void kernel_launch(void* const* d_in, const int* in_sizes, int n_in, void* d_out, int out_size, void* d_ws, size_t ws_size,
                              hipStream_t stream) {
  static int grid_blocks = 0;
  if (!grid_blocks) {
    int dev = 0, cus = 0, per_cu = 0;
    hipGetDevice(&dev);
    hipDeviceGetAttribute(&cus, hipDeviceAttributeMultiprocessorCount, dev);
    (void)hipFuncSetAttribute((const void*)mega, hipFuncAttributeMaxDynamicSharedMemorySize, LDS_BYTES);
    hipOccupancyMaxActiveBlocksPerMultiprocessor(&per_cu, mega, 256, LDS_BYTES);
    if (per_cu < 1) per_cu = 1;
    if (per_cu > 2) per_cu = 2;
    grid_blocks = cus * per_cu;
    if (ws_size < WS_NEED) fprintf(stderr, "kernel_launch: workspace too small: %zu < %zu\n", ws_size, (size_t)WS_NEED);
  }
  Params p{};
  for (int i = 0; i < 32; ++i) p.in[i] = (const float*)d_in[i];
  p.out = (float*)d_out;
  p.ws = (unsigned char*)d_ws;
  hipMemsetAsync(d_ws, 0, 32768, stream);
  void* args[] = {&p};
  hipError_t e = hipLaunchCooperativeKernel((void*)mega, dim3(grid_blocks), dim3(256), args, LDS_BYTES, stream);
  if (e != hipSuccess) fprintf(stderr, "cooperative launch failed: %s (grid %d)\n", hipGetErrorString(e), grid_blocks);
}
```

```cpp
#include <hip/hip_runtime.h>
#include <hip/hip_bf16.h>
#include <hip/hip_cooperative_groups.h>
#include <cstdio>
#include <cstdint>
namespace cg = cooperative_groups;

typedef unsigned short bfr;
using bf16x8 = __attribute__((ext_vector_type(8))) short;
using f32x4 = __attribute__((ext_vector_type(4))) float;

#define NLAT 32768
#define NCTX 2048
#define NTOK 34816
#define MIB ((size_t)1 << 20)
#define OFF_CTR 0
#define OFF_MOD (1 * MIB)
#define OFF_LB (OFF_MOD + 884736)
#define OFF_ROPE (OFF_LB + 4096)
#define OFF_XC (2 * MIB)
#define OFF_WIN (10 * MIB)
#define OFF_WOUT (OFF_WIN + 8126464)
#define OFF_W1 (OFF_WOUT + 2 * MIB)
#define OFF_W2 (OFF_W1 + 8 * MIB)
#define OFF_HN (36 * MIB)
#define OFF_AB (104 * MIB)
#define OFF_PGDN (107 * MIB)
#define OFF_PHY (175 * MIB)
#define OFF_PHG (226 * MIB)
#define OFF_PDA (311 * MIB)
#define OFF_GQ (362 * MIB)
#define OFF_HVT (413 * MIB)
#define OFF_HVC (429 * MIB)
#define OFF_X1T (430 * MIB)
#define OFF_HZC (446 * MIB)
#define OFF_RF (447 * MIB)
#define OFF_GFC (463 * MIB)
#define OFF_VT (464 * MIB)
#define OFF_X2T (482 * MIB)
#define OFF_SLAB (379 * MIB)
#define OFF_HID OFF_PGDN
#define OFF_GFC2 (498 * MIB)
#define WS_NEED (499 * MIB)
#define LDS_BYTES 73728

struct Params {
  const float* in[32];
  float* out;
  unsigned char* ws;
};

__device__ __forceinline__ float bf2f(bfr v) { return __uint_as_float(((unsigned)v) << 16); }
typedef __attribute__((ext_vector_type(2))) __bf16 bf2v_t;
typedef __attribute__((ext_vector_type(2))) float f2v_t;
using f32x16 = __attribute__((ext_vector_type(16))) float;
__device__ __forceinline__ unsigned pk2(float lo, float hi) {
  f2v_t f = {lo, hi};
  return __builtin_bit_cast(unsigned, __builtin_convertvector(f, bf2v_t));
}
__device__ __forceinline__ bfr f2bf(float f) { return (bfr)(pk2(f, 0.f) & 0xffffu); }
__device__ __forceinline__ float sigmoidf_(float x) { return 1.f / (1.f + expf(-x)); }
__device__ __forceinline__ float siluf_(float x) { return x / (1.f + expf(-x)); }
__device__ __forceinline__ float fsigmoid(float x) { return __builtin_amdgcn_rcpf(1.f + __expf(-x)); }
__device__ __forceinline__ float wave_sum(float v) {
#pragma unroll
  for (int o = 32; o >= 1; o >>= 1) v += __shfl_xor(v, o);
  return v;
}
__device__ __forceinline__ float quad_sum(float v) {
  v += __int_as_float(__builtin_amdgcn_mov_dpp(__float_as_int(v), 0xB1, 0xF, 0xF, true));
  v += __int_as_float(__builtin_amdgcn_mov_dpp(__float_as_int(v), 0x4E, 0xF, 0xF, true));
  return v;
}
typedef float v2f __attribute__((ext_vector_type(2)));

__device__ __forceinline__ int tidx() { int t = threadIdx.x; asm volatile("" : "+v"(t)); return t; }
#define WSP(T, off) ((T*)(p.ws + (off)))


#define XB_TMO      128
#define XB_XCNT(j)  (256  + 64 * (j))
#define XB_XSUB(j)  (1280 + 64 * (j))
#define XB_XGEN(j)  (2304 + 64 * (j))
#define XB_TOP      3328
#define XB_TOPGEN   3392
#define XCD_BAR_WORDS 3456
#define XB_SPIN_CAP (1u << 24)
#define LAS __attribute__((address_space(3)))
__device__ __forceinline__ unsigned xb_ld(unsigned* p) { return __hip_atomic_load(p, __ATOMIC_RELAXED, __HIP_MEMORY_SCOPE_AGENT); }
__device__ __forceinline__ unsigned xb_add(unsigned* p, unsigned v) { return __hip_atomic_fetch_add(p, v, __ATOMIC_RELAXED, __HIP_MEMORY_SCOPE_AGENT); }
__device__ __forceinline__ unsigned xb_xcc_id() { return (unsigned)__builtin_amdgcn_s_getreg((3 << 11) | 20) & 0xFu; }
#define XB_SPIN(cond, bar) do { unsigned _sp = 0; while (cond) { __builtin_amdgcn_s_sleep(1); \
    if ((++_sp & 255u) == 0u) { if (xb_ld(&(bar)[XB_TMO])) break; if (_sp > XB_SPIN_CAP) { atomicAdd(&(bar)[XB_TMO], 1u); break; } } } } while (0)
struct XcdBarrier { unsigned* bar; unsigned x; volatile LAS unsigned* st; };
__device__ __forceinline__ XcdBarrier xcd_barrier_post(unsigned* bar, volatile LAS unsigned* st) {
  XcdBarrier b; b.bar = bar; b.x = xb_xcc_id(); b.st = st;
  if (threadIdx.x == 0) (void)xb_add(&bar[XB_XCNT(b.x)], 1u);
  return b;
}
__device__ __forceinline__ void xcd_barrier_complete(unsigned* bar, unsigned x, unsigned& nloc, unsigned& nx) {
  const unsigned G = gridDim.x * gridDim.y * gridDim.z;
  unsigned sum, cnt, mine, sp = 0u;
  for (;;) {
    sum = 0u; cnt = 0u; mine = 0u;
#pragma unroll
    for (unsigned j = 0; j < 16; ++j) { const unsigned c = xb_ld(&bar[XB_XCNT(j)]); sum += c; cnt += (c > 0u) ? 1u : 0u; mine = (j == x) ? c : mine; }
    if (sum == G) break;
    __builtin_amdgcn_s_sleep(1);
    if ((++sp & 255u) == 0u) { if (xb_ld(&bar[XB_TMO])) break; if (sp > XB_SPIN_CAP) { atomicAdd(&bar[XB_TMO], 1u); break; } }
  }
  nloc = mine > 0u ? mine : 1u; nx = cnt > 0u ? cnt : 1u;
}
__device__ __forceinline__ void xcd_barrier(const XcdBarrier& b) {
  asm volatile("s_waitcnt vmcnt(0)" ::: "memory");
  __syncthreads();
  if (threadIdx.x == 0) {
    unsigned* bar = b.bar;
    __builtin_amdgcn_s_waitcnt(0);
    unsigned nloc = b.st[0], nx = b.st[1];
    if (nloc == 0u) { xcd_barrier_complete(bar, b.x, nloc, nx); b.st[0] = nloc; b.st[1] = nx; }
    const unsigned old = xb_add(&bar[XB_XSUB(b.x)], 1u);
    const unsigned gen = old / nloc;
    if (old + 1u == (gen + 1u) * nloc) {
      __builtin_amdgcn_fence(__ATOMIC_RELEASE, "agent");
      asm volatile("s_waitcnt vmcnt(0)" ::: "memory");
      const unsigned og = xb_add(&bar[XB_TOP], 1u);
      const unsigned tg = og / nx;
      if (og + 1u == (tg + 1u) * nx) xb_add(&bar[XB_TOPGEN], 1u);
      else XB_SPIN(xb_ld(&bar[XB_TOPGEN]) == tg, bar);
      __builtin_amdgcn_fence(__ATOMIC_ACQUIRE, "agent");
      xb_add(&bar[XB_XGEN(b.x)], 1u);
      asm volatile("s_waitcnt vmcnt(0)" ::: "memory");
    } else {
      XB_SPIN(xb_ld(&bar[XB_XGEN(b.x)]) == gen, bar);
      __builtin_amdgcn_fence(__ATOMIC_ACQUIRE, "agent");
      asm volatile("s_waitcnt vmcnt(0)" ::: "memory");
    }
  }
  __syncthreads();
}

__device__ __forceinline__ void phase_mod(const Params& p, float* smem) {
  const int tid = tidx();
  float* sc = smem;
  float* red = smem + 9 * 1024;
  float* mod = WSP(float, OFF_MOD);
  bool loaded = false;
  for (int task = blockIdx.x; task < 4 * 96; task += gridDim.x) {
    if (!loaded) {
      for (int i = tid; i < 9 * 1024; i += 256) {
        int m = i >> 10, k = i & 1023;
        float v = m < 8 ? p.in[1][m * 1024 + k] : p.in[3][k];
        sc[i] = siluf_(v);
      }
      __syncthreads();
      loaded = true;
    }
    int l = task / 96, cgp = task % 96;
    int col = cgp * 64 + (tid & 63), ks = tid >> 6;
    const float* w = p.in[4] + (size_t)l * 1024 * 6144 + col;
    float acc[9];
#pragma unroll
    for (int m = 0; m < 9; ++m) acc[m] = 0.f;
#pragma unroll 8
    for (int k = ks * 256; k < ks * 256 + 256; ++k) {
      float wv = w[(size_t)k * 6144];
#pragma unroll
      for (int m = 0; m < 9; ++m) acc[m] += sc[m * 1024 + k] * wv;
    }
#pragma unroll
    for (int m = 0; m < 9; ++m) red[(ks * 9 + m) * 64 + (tid & 63)] = acc[m];
    __syncthreads();
    if (tid < 64) {
#pragma unroll
      for (int m = 0; m < 9; ++m) {
        float s = red[(0 * 9 + m) * 64 + tid] + red[(1 * 9 + m) * 64 + tid] + red[(2 * 9 + m) * 64 + tid] + red[(3 * 9 + m) * 64 + tid];
        mod[(size_t)(l * 9 + m) * 6144 + col] = s + p.in[5][l * 6144 + col];
      }
    }
    __syncthreads();
  }
  if (blockIdx.x == gridDim.x - 2) {
    float* rope = WSP(float, OFF_ROPE);
    for (int e = tid; e < 512; e += 256) {
      const int pos = e >> 3, i = e & 7;
      const float inv = powf(10000.f, -(float)i / 8.f);
      float sn, cs;
      sincosf((float)pos * inv, &sn, &cs);
      rope[pos * 16 + i] = cs;
      rope[pos * 16 + 8 + i] = sn;
    }
  }
  if (blockIdx.x == gridDim.x - 1) {
    int c = tid;
    const float* raw = p.in[23];
    float r0 = raw[c], r1 = raw[256 + c], r2 = raw[512 + c], r3 = raw[768 + c];
    float mx = fmaxf(fmaxf(r0, r1), fmaxf(r2, r3));
    float e0 = expf(r0 - mx), e1 = expf(r1 - mx), e2 = expf(r2 - mx), e3 = expf(r3 - mx);
    float inv = 1.f / (e0 + e1 + e2 + e3);
    float* lb = WSP(float, OFF_LB);
    lb[c] = 0.f;
    lb[256 + c] = e1 * inv;
    lb[512 + c] = (e1 + e2) * inv;
    lb[768 + c] = (e1 + e2 + e3) * inv;
  }
}

__device__ __forceinline__ const float* xin_row(const Params& p, int l, int row) {
  if (row < NLAT) return (l == 0 ? p.in[0] : (const float*)p.out) + (size_t)row * 1024;
  return (l == 0 ? p.in[2] : (const float*)WSP(float, OFF_XC)) + (size_t)(row - NLAT) * 1024;
}
__device__ __forceinline__ float* xout_row(const Params& p, int row) {
  if (row < NLAT) return p.out + (size_t)row * 1024;
  return WSP(float, OFF_XC) + (size_t)(row - NLAT) * 1024;
}
__device__ __forceinline__ int mod_idx(int row) { return row < NLAT ? (row >> 12) : 8; }

__device__ __forceinline__ void norm_rows(const Params& p, int l, int which, int task  ) {
  const int tid = tidx(), lane = tid & 63, wave = tid >> 6;
  const float* lnw = p.in[which == 0 ? 6 : 7] + l * 1024;
  bfr* hn = WSP(bfr, OFF_HN);
  const int row0 = task * 32;
  const float* mv = WSP(float, OFF_MOD) + (size_t)(l * 9 + mod_idx(row0)) * 6144 + (which == 0 ? 0 : 3072);
  const bool fold = (which == 0) && (l >= 1) && (row0 >= NLAT);
#pragma unroll 1
  for (int g = 0; g < 2; ++g) {
    float4 v[4][4];
#pragma unroll
    for (int j = 0; j < 4; ++j) {
      const int row = row0 + wave + 4 * (g * 4 + j);
      const float* xr = which == 0 ? xin_row(p, l, row) : (const float*)xout_row(p, row);
#pragma unroll
      for (int i = 0; i < 4; ++i) v[j][i] = ((const float4*)xr)[lane + 64 * i];
    }
    if (fold) {
#pragma unroll
      for (int j = 0; j < 4; ++j) {
        const int row = row0 + wave + 4 * (g * 4 + j), rc = row - NLAT;
#pragma unroll
        for (int i = 0; i < 4; ++i) {
          const int col = 4 * (lane + 64 * i);
          const float* sl = WSP(float, OFF_SLAB) + (size_t)(((rc >> 8) * 8 + (col >> 7)) * 8) * 32768 + (size_t)(rc & 255) * 128 + (col & 127);
          float4 sm = *(const float4*)sl;
#pragma unroll
          for (int ks = 1; ks < 8; ++ks) { const float4 t = *(const float4*)(sl + (size_t)ks * 32768); sm.x += t.x; sm.y += t.y; sm.z += t.z; sm.w += t.w; }
          const float4 g4 = *(const float4*)(WSP(float, OFF_MOD) + (size_t)((l - 1) * 9 + 8) * 6144 + 5120 + col);
          v[j][i].x += g4.x * sm.x; v[j][i].y += g4.y * sm.y; v[j][i].z += g4.z * sm.z; v[j][i].w += g4.w * sm.w;
          ((float4*)xout_row(p, row))[lane + 64 * i] = v[j][i];
        }
      }
    }
    float rj[4];
#pragma unroll
    for (int j = 0; j < 4; ++j) {
      float ss = 0.f;
#pragma unroll
      for (int i = 0; i < 4; ++i) ss += v[j][i].x * v[j][i].x + v[j][i].y * v[j][i].y + v[j][i].z * v[j][i].z + v[j][i].w * v[j][i].w;
      ss = wave_sum(ss);
      rj[j] = rsqrtf(ss * (1.f / 1024.f) + 1e-6f);
    }
#pragma unroll
    for (int i = 0; i < 4; ++i) {
      const int c = 4 * (lane + 64 * i);
      const float4 w = *(const float4*)(lnw + c);
      const float4 sh = *(const float4*)(mv + c);
      const float4 sc = *(const float4*)(mv + 1024 + c);
      const float m0 = w.x * (1.f + sc.x), m1 = w.y * (1.f + sc.y), m2 = w.z * (1.f + sc.z), m3 = w.w * (1.f + sc.w);
#pragma unroll
      for (int j = 0; j < 4; ++j) {
        const int row = row0 + wave + 4 * (g * 4 + j);
        const float r = rj[j];
        ushort4 o;
        o.x = f2bf(v[j][i].x * r * m0 + sh.x);
        o.y = f2bf(v[j][i].y * r * m1 + sh.y);
        o.z = f2bf(v[j][i].z * r * m2 + sh.z);
        o.w = f2bf(v[j][i].w * r * m3 + sh.w);
        *(ushort4*)(hn + (size_t)row * 1024 + c) = o;
      }
    }
  }
}

__device__ __forceinline__ void wconv_tile(const Params& p, int l, int task, float* smem) {
  const int tid = tidx();
  const float* src;
  bfr* dst;
  int K, N, kt, nt, mode = 0;
  if (task < 992) { src = p.in[8] + (size_t)l * 1024 * 3856; dst = WSP(bfr, OFF_WIN); K = 1024; N = 3856; kt = task / 62; nt = task % 62; mode = 1; }
  else if (task < 992 + 256) { int t = task - 992; src = p.in[29] + (size_t)l * 1024 * 1024; dst = WSP(bfr, OFF_WOUT); K = 1024; N = 1024; kt = t / 16; nt = t % 16; }
  else if (task < 992 + 256 + 1024) { int t = task - 1248; src = p.in[30] + (size_t)l * 1024 * 4096; dst = WSP(bfr, OFF_W1); K = 1024; N = 4096; kt = t / 64; nt = t % 64; }
  else { int t = task - 2272; src = p.in[31] + (size_t)l * 4096 * 1024; dst = WSP(bfr, OFF_W2); K = 4096; N = 1024; kt = t / 16; nt = t % 16; }
  float* tile = smem;
  {
    int nl = tid & 63;
    int np = nt * 64 + nl;
    int sc = np;
    if (mode == 1) sc = np < 1024 ? np : (np < 3840 ? np + 16 : (np < 3856 ? np - 3840 + 1024 : -1));
#pragma unroll
    for (int i = 0; i < 16; ++i) {
      int kl = (tid >> 6) + 4 * i;
      tile[kl * 65 + nl] = sc >= 0 ? src[(size_t)(kt * 64 + kl) * N + sc] : 0.f;
    }
  }
  __syncthreads();
  {
    int kl = tid & 63;
#pragma unroll
    for (int i = 0; i < 16; ++i) {
      int nl = (tid >> 6) + 4 * i;
      dst[(size_t)(nt * 64 + nl) * K + kt * 64 + kl] = f2bf(tile[kl * 65 + nl]);
    }
  }
  __syncthreads();
}

__device__ __forceinline__ void filt_task(const Params& p, int l, int task, float* smem) {
  const int tid = tidx();
  int n, pos0;
  float* G;
  if (task < 256) { n = 4096; pos0 = task * 16; G = nullptr; }
  else { n = 256; pos0 = (task - 256) * 16; G = (l & 1) ? WSP(float, OFF_GFC2) : WSP(float, OFF_GFC); }
  float* zs = smem;
  float* h1s = smem + 16 * 36;
  float* h2t = h1s + 16 * 64;
  const float* w1 = p.in[14] + l * 33 * 64;
  const float* b1 = p.in[15] + l * 64;
  const float* f1 = p.in[16] + l * 64;
  const float* w2 = p.in[17] + l * 64 * 64;
  const float* b2 = p.in[18] + l * 64;
  const float* f2 = p.in[19] + l * 64;
  const float* w3 = p.in[20] + (size_t)l * 64 * 1024;
  const float* dec = p.in[21] + l * 512;
  const float* skp = p.in[22] + l * 512;
  const float inv_nm1 = (n == 4096) ? (1.f / 4095.f) : (1.f / 255.f);
  const float twopi_n = (n == 4096) ? (6.283185307179586f / 4096.f) : (6.283185307179586f / 256.f);
  for (int i = tid; i < 16 * 33; i += 256) {
    int pp = i / 33, e = i % 33;
    float pos = (float)(pos0 + pp);
    float zv;
    if (e == 0) zv = pos * inv_nm1;
    else {
      int bi = (e - 1) & 15;
      float band = 1e-4f + (float)bi * ((15.f - 1e-4f) / 15.f);
      float ang = twopi_n * pos * band;
      zv = (e <= 16) ? cosf(ang) : -sinf(ang);
    }
    zs[pp * 36 + e] = zv;
  }
  __syncthreads();
  for (int i = tid; i < 16 * 64; i += 256) {
    int pp = i >> 6, j = i & 63;
    float a = b1[j];
    for (int e = 0; e < 33; ++e) a += zs[pp * 36 + e] * w1[e * 64 + j];
    h1s[pp * 64 + j] = sinf(f1[j] * a);
  }
  __syncthreads();
  for (int i = tid; i < 16 * 64; i += 256) {
    int pp = i >> 6, j = i & 63;
    float a = b2[j];
    for (int k = 0; k < 64; ++k) a += h1s[pp * 64 + k] * w2[k * 64 + j];
    h2t[j * 16 + pp] = sinf(f2[j] * a);
  }
  __syncthreads();
#pragma unroll 1
  for (int jj = 0; jj < 4; ++jj) {
    int col = tid + 256 * jj;
    float acc[16];
#pragma unroll
    for (int i = 0; i < 16; ++i) acc[i] = 0.f;
#pragma unroll 8
    for (int k = 0; k < 64; ++k) {
      float wv = w3[k * 1024 + col];
      const float4* h4 = (const float4*)(h2t + k * 16);
#pragma unroll
      for (int q = 0; q < 4; ++q) {
        float4 hv = h4[q];
        acc[4 * q + 0] += hv.x * wv; acc[4 * q + 1] += hv.y * wv; acc[4 * q + 2] += hv.z * wv; acc[4 * q + 3] += hv.w * wv;
      }
    }
    int side = col >> 9, f = (col >> 8) & 1, ch = col & 255;
    float dc = fabsf(dec[f * 256 + ch]);
    if (G) {
      float* Gf = G + (size_t)f * (2 * n - 1) * 256;
#pragma unroll
      for (int i = 0; i < 16; ++i) {
        int pos = pos0 + i;
        float val = acc[i] * expf(-(float)pos * inv_nm1 * dc);
        if (side == 0) {
          if (pos == 0) val += skp[f * 256 + ch];
          Gf[(size_t)(pos + n - 1) * 256 + ch] = val;
        } else if (pos >= 1) {
          Gf[(size_t)(n - 1 - pos) * 256 + ch] = val;
        }
      }
    } else {
      bfr* R = WSP(bfr, OFF_RF) + (size_t)(l & 1) * (4 * MIB) + ((size_t)(f * 256 + ch)) * 8192;
#pragma unroll
      for (int i = 0; i < 16; ++i) {
        int pos = pos0 + i;
        float val = acc[i] * expf(-(float)pos * inv_nm1 * dc);
        if (side == 0) {
          if (pos == 0) { val += skp[f * 256 + ch]; R[0] = 0; }
          R[4096 - pos] = f2bf(val);
        } else if (pos >= 1) {
          R[4096 + pos] = f2bf(val);
        }
      }
    }
  }
  __syncthreads();
}

template <bool RELU2>
__device__ __forceinline__ void store_tile_bf16(const f32x4 (&acc)[8][4], bfr* dst, int ld, int row_base, int col_base, bfr* wbuf, int lane) {
  const int fr = lane & 15, fq = lane >> 4;
#pragma unroll
  for (int pass = 0; pass < 2; ++pass) {
#pragma unroll
    for (int mm = 0; mm < 4; ++mm)
#pragma unroll
      for (int n = 0; n < 4; ++n) {
        f32x4 a = acc[4 * pass + mm][n];
        if (RELU2) {
          a[0] = fmaxf(a[0], 0.f); a[1] = fmaxf(a[1], 0.f); a[2] = fmaxf(a[2], 0.f); a[3] = fmaxf(a[3], 0.f);
          a[0] *= a[0]; a[1] *= a[1]; a[2] *= a[2]; a[3] *= a[3];
        }
        uint2 o; o.x = pk2(a[0], a[1]); o.y = pk2(a[2], a[3]);
        *(uint2*)(wbuf + (mm * 16 + fr) * 72 + n * 16 + fq * 4) = o;
      }
#pragma unroll
    for (int q = 0; q < 8; ++q) {
      const int chunk = lane + 64 * q, rowl = chunk >> 3, c16 = chunk & 7;
      const uint4 v = *(const uint4*)(wbuf + rowl * 72 + c16 * 8);
      *(uint4*)(dst + (size_t)(row_base + pass * 64 + rowl) * ld + col_base + c16 * 8) = v;
    }
  }
}

template <int EPI>
__device__ __forceinline__ void gemm_phase(const Params& p, int l, const bfr* A, int lda, const bfr* Bt, int K, int Mtiles, int Ntiles, char* smemc) {
  bfr* sA = (bfr*)smemc;
  bfr* sB = sA + 2 * 256 * 40;
  const int tid = tidx(), wave = __builtin_amdgcn_readfirstlane(tid >> 6), lane = tid & 63;
  const int wr = wave >> 1, wc = wave & 1, fr = lane & 15, fq = lane >> 4;
  const int ntiles = Mtiles * Ntiles;
  const int nk = K / 32;
  const int gsb = lane * 16, gsw = gsb ^ (((gsb >> 9) & 1) << 5);
  const int grl = gsw >> 6, gcl = (gsw & 63) >> 1;
  const int flo = (fr * 64 + fq * 16) ^ ((fr >> 3) << 5);
  const int xcd = blockIdx.x & 7, xidx = blockIdx.x >> 3, xnb = gridDim.x >> 3;
  const int SN = (Ntiles + 7) >> 3, nsup = (Mtiles >> 3) * SN;
  (void)ntiles;
  const int qper = (64 + xnb - 1) / xnb;
  const bool splitctx = (EPI == 3) && (Mtiles == 136);
  const int nsupm = splitctx ? 16 * SN : nsup;
  const int nmain = ((nsupm + 7) >> 3) * qper;
  const int nextra = splitctx ? (512 + (int)gridDim.x - 1) / (int)gridDim.x : 0;
  for (int it = 0; it < nmain + nextra; ++it) {
    int tm, tn, kt0 = 0, nkk = nk, item = -1;
    if (it < nmain) {
      const int sup = xcd + 8 * (it / qper), q = xidx + xnb * (it % qper);
      if (sup >= nsupm || q >= 64) continue;
      tm = (sup / SN) * 8 + (q >> 3); tn = (sup % SN) * 8 + (q & 7);
      if (tn >= Ntiles) continue;
    } else {
      item = blockIdx.x + gridDim.x * (it - nmain);
      if (item >= 512) continue;
      const int tl = item >> 3;
      tm = 128 + (tl >> 3); tn = tl & 7; nkk = nk >> 3; kt0 = (item & 7) * nkk;
    }
    const bfr* Ab = A + (size_t)tm * 256 * lda + (size_t)(wave * 16 + grl) * lda + gcl + kt0 * 32;
    const bfr* Bb = Bt + (size_t)tn * 128 * K + (size_t)(wave * 16 + grl) * K + gcl + kt0 * 32;
    f32x4 acc[8][4];
#pragma unroll
    for (int m = 0; m < 8; ++m)
#pragma unroll
      for (int n = 0; n < 4; ++n) acc[m][n] = (f32x4){0.f, 0.f, 0.f, 0.f};
#define GLDS_STAGE(BUF, K0) { char* la = smemc + (BUF) * 24576 + wave * 1024; \
      __builtin_amdgcn_global_load_lds((const unsigned*)(Ab + (K0)), (unsigned*)(la), 16, 0, 0); \
      __builtin_amdgcn_global_load_lds((const unsigned*)(Ab + (size_t)64 * lda + (K0)), (unsigned*)(la + 4096), 16, 0, 0); \
      __builtin_amdgcn_global_load_lds((const unsigned*)(Ab + (size_t)128 * lda + (K0)), (unsigned*)(la + 8192), 16, 0, 0); \
      __builtin_amdgcn_global_load_lds((const unsigned*)(Ab + (size_t)192 * lda + (K0)), (unsigned*)(la + 12288), 16, 0, 0); \
      __builtin_amdgcn_global_load_lds((const unsigned*)(Bb + (K0)), (unsigned*)(la + 16384), 16, 0, 0); \
      __builtin_amdgcn_global_load_lds((const unsigned*)(Bb + (size_t)64 * K + (K0)), (unsigned*)(la + 16384 + 4096), 16, 0, 0); }
#define MM4(M, AF) { acc[M][0] = __builtin_amdgcn_mfma_f32_16x16x32_bf16(bg0, AF, acc[M][0], 0, 0, 0); \
      acc[M][1] = __builtin_amdgcn_mfma_f32_16x16x32_bf16(bg1, AF, acc[M][1], 0, 0, 0); \
      acc[M][2] = __builtin_amdgcn_mfma_f32_16x16x32_bf16(bg2, AF, acc[M][2], 0, 0, 0); \
      acc[M][3] = __builtin_amdgcn_mfma_f32_16x16x32_bf16(bg3, AF, acc[M][3], 0, 0, 0); }
#define AFR(M) (*(const bf16x8*)(rap + (M) * 1024))
    __syncthreads();
    GLDS_STAGE(0, 0);
    GLDS_STAGE(1, 32);
    asm volatile("s_waitcnt vmcnt(6)" ::: "memory");
    asm volatile("s_waitcnt lgkmcnt(0)" ::: "memory");
    __builtin_amdgcn_s_barrier();
    int cur = 0, nx2 = 2;
    for (int kt = 0; kt < nkk; ++kt) {
      if (kt + 2 < nkk) GLDS_STAGE(nx2, (kt + 2) * 32);
      const char* rbp = smemc + cur * 24576 + 16384 + (wc * 4) * 1024 + flo;
      const char* rap = smemc + cur * 24576 + (wr * 8) * 1024 + flo;
      bf16x8 bg0 = *(const bf16x8*)(rbp), bg1 = *(const bf16x8*)(rbp + 1024), bg2 = *(const bf16x8*)(rbp + 2048), bg3 = *(const bf16x8*)(rbp + 3072);
      bf16x8 a0 = AFR(0), a1 = AFR(1), a2 = AFR(2);
      MM4(0, a0); a0 = AFR(3);
      MM4(1, a1); a1 = AFR(4);
      MM4(2, a2); a2 = AFR(5);
      MM4(3, a0); a0 = AFR(6);
      MM4(4, a1); a1 = AFR(7);
      MM4(5, a2);
      MM4(6, a0);
      MM4(7, a1);
      __builtin_amdgcn_sched_group_barrier(0x100, 7, 0);
      __builtin_amdgcn_sched_group_barrier(0x008, 4, 0);
      __builtin_amdgcn_sched_group_barrier(0x100, 1, 0);
      __builtin_amdgcn_sched_group_barrier(0x008, 4, 0);
      __builtin_amdgcn_sched_group_barrier(0x100, 1, 0);
      __builtin_amdgcn_sched_group_barrier(0x008, 4, 0);
      __builtin_amdgcn_sched_group_barrier(0x100, 1, 0);
      __builtin_amdgcn_sched_group_barrier(0x008, 4, 0);
      __builtin_amdgcn_sched_group_barrier(0x100, 1, 0);
      __builtin_amdgcn_sched_group_barrier(0x008, 4, 0);
      __builtin_amdgcn_sched_group_barrier(0x100, 1, 0);
      __builtin_amdgcn_sched_group_barrier(0x008, 12, 0);
      __builtin_amdgcn_sched_barrier(0);
      if (kt + 2 < nkk) asm volatile("s_waitcnt vmcnt(6)" ::: "memory");
      else asm volatile("s_waitcnt vmcnt(0)" ::: "memory");
      asm volatile("s_waitcnt lgkmcnt(0)" ::: "memory");
      __builtin_amdgcn_s_barrier();
      cur = (cur == 2) ? 0 : cur + 1;
      nx2 = (nx2 == 2) ? 0 : nx2 + 1;
    }
#undef GLDS_STAGE
#undef MM4
#undef AFR
    if (EPI == 0) {
      bfr* dst; int ld, c0;
      if (tn < 8) { dst = WSP(bfr, OFF_PGDN); ld = 1024; c0 = tn * 128; }
      else if (tn < 14) { dst = WSP(bfr, OFF_PHY); ld = 768; c0 = (tn - 8) * 128; }
      else if (tn < 24) { dst = WSP(bfr, OFF_PHG); ld = 1280; c0 = (tn - 14) * 128; }
      else if (tn < 30) { dst = WSP(bfr, OFF_PDA); ld = 768; c0 = (tn - 24) * 128; }
      else { dst = nullptr; ld = 0; c0 = 0; }
      if (dst) {
        store_tile_bf16<false>(acc, dst, ld, tm * 256 + wr * 128, c0 + wc * 64, (bfr*)smemc + wave * (64 * 72), lane);
      } else if (wc == 0) {
        float* ab = WSP(float, OFF_AB);
#pragma unroll
        for (int m = 0; m < 8; ++m) {
          int row = tm * 256 + wr * 128 + m * 16 + fr;
          *(float4*)(ab + (size_t)row * 16 + fq * 4) = (float4){acc[m][0][0], acc[m][0][1], acc[m][0][2], acc[m][0][3]};
        }
      }
    } else if (EPI == 2) {
      store_tile_bf16<true>(acc, WSP(bfr, OFF_HID), 4096, tm * 256 + wr * 128, tn * 128 + wc * 64, (bfr*)smemc + wave * (64 * 72), lane);
    } else {
      const int midx = tm < 128 ? (tm >> 4) : 8;
      const float* gv = WSP(float, OFF_MOD) + (size_t)(l * 9 + midx) * 6144 + (EPI == 1 ? 2048 : 5120);
      float* wbuf = (float*)smemc + wave * (32 * 68);
      const int colw = tn * 128 + wc * 64;
      if (item >= 0) {
        float* slb = WSP(float, OFF_SLAB) + (size_t)item * 32768 + (size_t)(wr * 128) * 128 + wc * 64;
#pragma unroll
        for (int pass = 0; pass < 4; ++pass) {
#pragma unroll
          for (int mm = 0; mm < 2; ++mm)
#pragma unroll
            for (int n = 0; n < 4; ++n)
              *(f32x4*)(wbuf + (mm * 16 + fr) * 68 + n * 16 + fq * 4) = acc[2 * pass + mm][n];
#pragma unroll
          for (int q = 0; q < 8; ++q) {
            const int chunk = lane + 64 * q, rowl = chunk >> 4, c16 = chunk & 15;
            *(f32x4*)(slb + (size_t)(pass * 32 + rowl) * 128 + c16 * 4) = *(const f32x4*)(wbuf + rowl * 68 + c16 * 4);
          }
        }
      } else {
#pragma unroll
        for (int pass = 0; pass < 4; ++pass) {
#pragma unroll
          for (int mm = 0; mm < 2; ++mm)
#pragma unroll
            for (int n = 0; n < 4; ++n)
              *(f32x4*)(wbuf + (mm * 16 + fr) * 68 + n * 16 + fq * 4) = acc[2 * pass + mm][n];
#pragma unroll
          for (int q = 0; q < 8; ++q) {
            const int chunk = lane + 64 * q, rowl = chunk >> 4, c16 = chunk & 15;
            const int row = tm * 256 + wr * 128 + pass * 32 + rowl, col = colw + c16 * 4;
            const f32x4 a = *(const f32x4*)(wbuf + rowl * 68 + c16 * 4);
            const float* xi = (EPI == 1) ? xin_row(p, l, row) : (const float*)xout_row(p, row);
            float* xo = xout_row(p, row);
            float4 xv = *(const float4*)(xi + col);
            const float4 g4 = *(const float4*)(gv + col);
            xv.x += g4.x * a[0]; xv.y += g4.y * a[1]; xv.z += g4.z * a[2]; xv.w += g4.w * a[3];
            *(float4*)(xo + col) = xv;
          }
        }
      }
    }
  }
}

__device__ __forceinline__ void prep_task(const Params& p, int l, int task  , char* smemc) {
  const int tid = tidx();
  const bfr* pg = WSP(bfr, OFF_PGDN);
  const bfr* ph = WSP(bfr, OFF_PHY);
  bfr* gq = WSP(bfr, OFF_GQ);
  bfr* hv = WSP(bfr, OFF_HVC) - (size_t)NLAT * 256;
  const float* gw = p.in[9] + l * 3 * 768;
  const float* hw = p.in[13] + l * 3 * 768;
  float gw0[3], gw1[3], gw2[3], hw0[3];
#pragma unroll
  for (int i = 0; i < 3; ++i) {
    gw0[i] = gw[i * 768 + tid]; gw1[i] = gw[i * 768 + 256 + tid]; gw2[i] = gw[i * 768 + 512 + tid]; hw0[i] = hw[i * 768 + tid];
  }
  {
    const int row0 = task * 32;
    int t0, n;
    if (row0 < NLAT) { t0 = row0 & 4095; n = 4096; } else { t0 = (row0 - NLAT) & 255; n = 256; }
    const bool isctx = row0 >= NLAT;
#pragma unroll 1
    for (int rb = 0; rb < 32; rb += 8) {
      float xq[10], xk[10], xv[10], xh[10];
#pragma unroll
      for (int j = 0; j < 10; ++j) {
        const int tt = t0 + rb - 1 + j;
        const bool ok = tt >= 0 && tt < n;
        const bfr* r = pg + (size_t)(row0 + rb - 1 + j) * 1024;
        xq[j] = ok ? bf2f(r[tid]) : 0.f;
        xk[j] = ok ? bf2f(r[256 + tid]) : 0.f;
        xv[j] = ok ? bf2f(r[512 + tid]) : 0.f;
        xh[j] = (ok && isctx) ? bf2f(ph[(size_t)(row0 + rb - 1 + j) * 768 + tid]) : 0.f;
      }
#pragma unroll
      for (int r8 = 0; r8 < 8; ++r8) {
        const int row = row0 + rb + r8;
        float aq = gw0[0] * xq[r8] + gw0[1] * xq[r8 + 1] + gw0[2] * xq[r8 + 2];
        float ak = gw1[0] * xk[r8] + gw1[1] * xk[r8 + 1] + gw1[2] * xk[r8 + 2];
        float av = gw2[0] * xv[r8] + gw2[1] * xv[r8 + 1] + gw2[2] * xv[r8 + 2];
        aq *= fsigmoid(aq); ak *= fsigmoid(ak); av *= fsigmoid(av);
        float sq = wave_sum(aq * aq), sk = wave_sum(ak * ak);
        aq *= rsqrtf(sq + 1e-6f); ak *= rsqrtf(sk + 1e-6f);
        gq[(size_t)row * 768 + tid] = f2bf(aq);
        gq[(size_t)row * 768 + 256 + tid] = f2bf(ak);
        gq[(size_t)row * 768 + 512 + tid] = f2bf(av);
        if (isctx) hv[(size_t)row * 256 + tid] = f2bf(hw0[0] * xh[r8] + hw0[1] * xh[r8 + 1] + hw0[2] * xh[r8 + 2]);
      }
    }
  }
  bfr* pd = WSP(bfr, OFF_PDA);
  for (int gi = tid; gi < 512; gi += 256) {
    int rr = gi >> 4, g = gi & 15;
    int row = task * 32 + rr;
    int qk = g >> 3;
    bfr* ptr = pd + (size_t)row * 768 + g * 32;
    const float* nw = p.in[qk == 0 ? 25 : 26] + l * 32;
    float x[32];
    uint4 raw[4];
#pragma unroll
    for (int i = 0; i < 4; ++i) raw[i] = ((const uint4*)ptr)[i];
#pragma unroll
    for (int i = 0; i < 4; ++i) {
      unsigned w0 = raw[i].x, w1 = raw[i].y, w2 = raw[i].z, w3 = raw[i].w;
      x[8 * i + 0] = __uint_as_float(w0 << 16); x[8 * i + 1] = __uint_as_float(w0 & 0xffff0000u);
      x[8 * i + 2] = __uint_as_float(w1 << 16); x[8 * i + 3] = __uint_as_float(w1 & 0xffff0000u);
      x[8 * i + 4] = __uint_as_float(w2 << 16); x[8 * i + 5] = __uint_as_float(w2 & 0xffff0000u);
      x[8 * i + 6] = __uint_as_float(w3 << 16); x[8 * i + 7] = __uint_as_float(w3 & 0xffff0000u);
    }
    float ss = 0.f;
#pragma unroll
    for (int i = 0; i < 32; ++i) ss += x[i] * x[i];
    float r = rsqrtf(ss * (1.f / 32.f) + 1e-6f);
    if (qk == 0) r *= 0.25503486f;
#pragma unroll
    for (int i = 0; i < 32; ++i) x[i] = x[i] * r * nw[i];
    if (row < NLAT) {
      int t = row & 4095;
      const float* rr_ = WSP(float, OFF_ROPE) + (t >> 6) * 16;
      const float* rc_ = WSP(float, OFF_ROPE) + (t & 63) * 16;
      float crv[8], srv[8], ccv[8], scv[8];
#pragma unroll
      for (int i = 0; i < 2; ++i) {
        float4 a4 = ((const float4*)rr_)[i], b4 = ((const float4*)rr_)[2 + i], c4 = ((const float4*)rc_)[i], d4 = ((const float4*)rc_)[2 + i];
        crv[4 * i] = a4.x; crv[4 * i + 1] = a4.y; crv[4 * i + 2] = a4.z; crv[4 * i + 3] = a4.w;
        srv[4 * i] = b4.x; srv[4 * i + 1] = b4.y; srv[4 * i + 2] = b4.z; srv[4 * i + 3] = b4.w;
        ccv[4 * i] = c4.x; ccv[4 * i + 1] = c4.y; ccv[4 * i + 2] = c4.z; ccv[4 * i + 3] = c4.w;
        scv[4 * i] = d4.x; scv[4 * i + 1] = d4.y; scv[4 * i + 2] = d4.z; scv[4 * i + 3] = d4.w;
      }
#pragma unroll
      for (int i = 0; i < 8; ++i) {
        const float sr = srv[i], cr = crv[i], scn = scv[i], cc = ccv[i];
        float a = x[i], b = x[8 + i];
        x[i] = a * cr - b * sr; x[8 + i] = b * cr + a * sr;
        float c = x[16 + i], d = x[24 + i];
        x[16 + i] = c * cc - d * scn; x[24 + i] = d * cc + c * scn;
      }
    }
#pragma unroll
    for (int i = 0; i < 4; ++i) {
      uint4 o;
      o.x = (unsigned)f2bf(x[8 * i + 0]) | ((unsigned)f2bf(x[8 * i + 1]) << 16);
      o.y = (unsigned)f2bf(x[8 * i + 2]) | ((unsigned)f2bf(x[8 * i + 3]) << 16);
      o.z = (unsigned)f2bf(x[8 * i + 4]) | ((unsigned)f2bf(x[8 * i + 5]) << 16);
      o.w = (unsigned)f2bf(x[8 * i + 6]) | ((unsigned)f2bf(x[8 * i + 7]) << 16);
      ((uint4*)ptr)[i] = o;
    }
  }
  if (task < 1024) {
    bfr* tile = (bfr*)smemc;
    const int row0 = task * 32;
    const int bb = row0 >> 12, t0 = row0 & 4095;
#pragma unroll 1
    for (int k = 0; k < 3; ++k) {
      const int ch = k * 256 + tid;
      const float w0 = hw[ch], w1 = hw[768 + ch], w2 = hw[1536 + ch];
      bfr xr[34];
#pragma unroll
      for (int j = 0; j < 34; ++j) {
        const int tt = t0 - 1 + j;
        xr[j] = (tt >= 0 && tt < 4096) ? ph[(size_t)(row0 - 1 + j) * 768 + ch] : (bfr)0;
      }
#pragma unroll
      for (int rr = 0; rr < 32; rr += 2) {
        const float y0 = w0 * bf2f(xr[rr]) + w1 * bf2f(xr[rr + 1]) + w2 * bf2f(xr[rr + 2]);
        const float y1 = w0 * bf2f(xr[rr + 1]) + w1 * bf2f(xr[rr + 2]) + w2 * bf2f(xr[rr + 3]);
        *(unsigned*)(tile + tid * 40 + rr) = pk2(y0, y1);
      }
      __syncthreads();
      bfr* dst = WSP(bfr, k == 0 ? OFF_HVT : (k == 1 ? OFF_X1T : OFF_X2T)) + ((size_t)(tid * 8 + bb)) * 4096 + t0;
#pragma unroll
      for (int i = 0; i < 4; ++i) ((uint4*)dst)[i] = *(const uint4*)(tile + tid * 40 + 8 * i);
      __syncthreads();
    }
  }
  {
    bfr* tile = (bfr*)smemc;
    const int row0 = task * 32;
    bfr vr[32];
#pragma unroll
    for (int rr = 0; rr < 32; ++rr) vr[rr] = pd[(size_t)(row0 + rr) * 768 + 512 + tid];
#pragma unroll
    for (int rr = 0; rr < 32; ++rr) {
      int pp = rr & 15;
      int g = pp >> 2;
      g = (g == 1) ? 2 : (g == 2 ? 1 : g);
      int pos = (rr & 16) | (g << 2) | (pp & 3);
      tile[tid * 40 + pos] = vr[rr];
    }
    __syncthreads();
    int bb, kbase;
    if (row0 < NLAT) { bb = row0 >> 12; kbase = row0 & 4095; } else { bb = (row0 - NLAT) >> 8; kbase = 4096 + ((row0 - NLAT) & 255); }
    bfr* vt = WSP(bfr, OFF_VT) + ((size_t)(bb * 256 + tid)) * 4352 + kbase;
#pragma unroll
    for (int i = 0; i < 4; ++i) ((uint4*)vt)[i] = *(const uint4*)(tile + tid * 40 + 8 * i);
    __syncthreads();
  }
}

__device__ __forceinline__ size_t scan_row(int b, int d, int ci, int i) {
  if (ci < 8) { int c0 = ci * 32; int t = d == 0 ? c0 + i : 255 - c0 - i; return (size_t)NLAT + b * 256 + t; }
  int c0 = (ci - 8) * 32; int t = d == 0 ? c0 + i : 4095 - c0 - i; return (size_t)b * 4096 + t;
}

__device__ __forceinline__ void hgrn_scan(const Params& p, int l, int task, float* smem) {
  const int b = task >> 3, h = (task >> 1) & 3, d = task & 1;
  const int tid = tidx(), lane = tid & 63, wave = tid >> 6;
  const int kg = lane & 3, vv = wave * 16 + (lane >> 2);
  float* sq = smem;
  float* sf = smem + 2048;
  float* sv = smem + 4096;
  float* so = smem + 6144;
  bfr* P = WSP(bfr, OFF_PHG);
  const int ch = tid & 63, i0 = tid >> 6;
  const float lbv = WSP(float, OFF_LB)[l * 256 + h * 64 + ch];
  v2f S2[8];
#pragma unroll
  for (int i = 0; i < 8; ++i) S2[i] = (v2f){0.f, 0.f};
  __builtin_amdgcn_s_setprio(3);
  bfr rq[8], ri[8], rf[8];
#pragma unroll
  for (int j = 0; j < 8; ++j) {
    const bfr* pr = P + scan_row(b, d, 0, i0 + 4 * j) * 1280 + h * 64 + ch;
    rq[j] = pr[0]; ri[j] = pr[256]; rf[j] = pr[512 + d * 256];
  }
  for (int ci = 0; ci < 136; ++ci) {
#pragma unroll
    for (int j = 0; j < 8; ++j) {
      const int e = (i0 + 4 * j) * 64 + ch;
      sq[e] = siluf_(bf2f(rq[j]));
      sf[e] = lbv + (1.f - lbv) * sigmoidf_(bf2f(rf[j]));
      sv[e] = bf2f(ri[j]);
    }
    __syncthreads();
    if (ci + 1 < 136) {
#pragma unroll
      for (int j = 0; j < 8; ++j) {
        const bfr* pr = P + scan_row(b, d, ci + 1, i0 + 4 * j) * 1280 + h * 64 + ch;
        rq[j] = pr[0]; ri[j] = pr[256]; rf[j] = pr[512 + d * 256];
      }
    }
#pragma unroll 4
    for (int i = 0; i < 32; ++i) {
      const float vcur = sv[i * 64 + vv];
      const v2f vc2 = {vcur, vcur};
      const float4* f4 = (const float4*)(sf + i * 64 + kg * 16);
      const float4* q4 = (const float4*)(sq + i * 64 + kg * 16);
      v2f pa = {0.f, 0.f}, pb = {0.f, 0.f};
#pragma unroll
      for (int j = 0; j < 4; ++j) {
        float4 f = f4[j], q = q4[j];
        v2f fa = {f.x, f.y}, fb = {f.z, f.w}, qa = {q.x, q.y}, qb = {q.z, q.w};
        S2[2 * j] = fa * (S2[2 * j] - vc2) + vc2;
        S2[2 * j + 1] = fb * (S2[2 * j + 1] - vc2) + vc2;
        pa += S2[2 * j] * qa;
        pb += S2[2 * j + 1] * qb;
      }
      float po = quad_sum((pa.x + pa.y) + (pb.x + pb.y));
      if (kg == 0) so[i * 64 + vv] = po;
    }
    __syncthreads();
#pragma unroll
    for (int j = 0; j < 8; ++j) {
      const int i = i0 + 4 * j;
      P[scan_row(b, d, ci, i) * 1280 + 512 + d * 256 + h * 64 + ch] = f2bf(so[i * 64 + ch]);
    }
  }
  __builtin_amdgcn_s_setprio(0);
}

__device__ __forceinline__ bfr* sw_addr(bfr* base, int R, int chunk) { return base + R * 64 + ((chunk ^ (R & 7)) << 3); }
__device__ __forceinline__ bf16x8 frag_nat(bfr* base, int R, int kk, int hf) { return *(const bf16x8*)sw_addr(base, R, 2 * kk + hf); }
__device__ __forceinline__ bf16x8 frag_krow(bfr* base, int R, int c0, int hf) {
  uint2 lo = *(const uint2*)(sw_addr(base, R, c0) + 4 * hf);
  uint2 hi = *(const uint2*)(sw_addr(base, R, c0 + 1) + 4 * hf);
  return __builtin_bit_cast(bf16x8, (uint4){lo.x, lo.y, hi.x, hi.y});
}
__device__ __forceinline__ bf16x8 pack8(const f32x16& x, int st) {
  return __builtin_bit_cast(bf16x8, (uint4){pk2(x[8 * st + 0], x[8 * st + 1]), pk2(x[8 * st + 2], x[8 * st + 3]),
                                            pk2(x[8 * st + 4], x[8 * st + 5]), pk2(x[8 * st + 6], x[8 * st + 7])});
}
__device__ __forceinline__ int crow_(int reg, int hf) { return (reg & 3) + 8 * (reg >> 2) + 4 * hf; }
__device__ __forceinline__ size_t scan_row64(int b, int d, int ci, int i) {
  if (ci < 4) { int c0 = ci * 64; int t = d == 0 ? c0 + i : 255 - c0 - i; return (size_t)NLAT + b * 256 + t; }
  int c0 = (ci - 4) * 64; int t = d == 0 ? c0 + i : 4095 - c0 - i; return (size_t)b * 4096 + t;
}

__device__ __forceinline__ void hgrn_chunked(const Params& p, int l, int task, char* smemc) {
  const int b = task >> 3, h = (task >> 1) & 3, d = task & 1;
  const int tid = tidx(), lane = tid & 63, wave = tid >> 6, r = lane & 31, hf = lane >> 5;
  const int tb = wave >> 1, vb = wave & 1;
  bfr* QG = (bfr*)smemc;
  bfr* QT = QG + 4096;
  bfr* KT = QT + 4096;
  bfr* KET = KT + 4096;
  bfr* VT = KET + 4096;
  float* TOT = (float*)(smemc + 40960);
  float* EG = TOT + 256;
  bfr* P = WSP(bfr, OFF_PHG);
  const int c = tid & 63, qd = tid >> 6;
  const float lbv = WSP(float, OFF_LB)[l * 256 + h * 64 + c];
  f32x16 S[2];
#pragma unroll
  for (int m = 0; m < 2; ++m)
#pragma unroll
    for (int i = 0; i < 16; ++i) S[m][i] = 0.f;
  __builtin_amdgcn_s_setprio(3);
  bfr rq[16], ri[16], rf[16];
#pragma unroll
  for (int j = 0; j < 16; ++j) {
    const bfr* pr = P + scan_row64(b, d, 0, 16 * qd + j) * 1280 + h * 64 + c;
    rq[j] = pr[0]; ri[j] = pr[256]; rf[j] = pr[512 + d * 256];
  }
#pragma unroll 1
  for (int ci = 0; ci < 68; ++ci) {
    float g[16], ky[16], qh[16];
    float run = 0.f;
#pragma unroll
    for (int j = 0; j < 16; ++j) {
      float f = lbv + (1.f - lbv) * fsigmoid(bf2f(rf[j]));
      run += __logf(f);
      const float qv = bf2f(rq[j]);
      g[j] = run; ky[j] = 1.f - f; qh[j] = qv * fsigmoid(qv);
    }
    __syncthreads();
    TOT[qd * 64 + c] = run;
    __syncthreads();
    const float t0 = TOT[c], t1 = TOT[64 + c], t2 = TOT[128 + c], t3 = TOT[192 + c];
    const float off = (qd > 0 ? t0 : 0.f) + (qd > 1 ? t1 : 0.f) + (qd > 2 ? t2 : 0.f);
    const float gm = t0 + t1, g63 = (t0 + t1) + (t2 + t3);
    const float egm = __expf(gm), e6m = __expf(g63 - gm);
    unsigned wke[8], wvt[8];
#pragma unroll
    for (int j = 0; j < 16; ++j) {
      const int i = 16 * qd + j;
      const float gi = g[j] + off;
      const float e1 = __expf(fminf(fmaxf(gi - gm, -80.f), 80.f));
      const float e2 = __builtin_amdgcn_rcpf(e1);
      const float eg = e1 * egm;
      const float e3 = e2 * e6m;
      const int sw = ((c >> 3) ^ (i & 7)) * 8 + (c & 7);
      QG[i * 64 + sw] = f2bf(qh[j] * eg);
      QT[i * 64 + sw] = f2bf(qh[j] * e1);
      KT[i * 64 + sw] = f2bf(ky[j] * e2);
      const float ke = ky[j] * e3, vv = bf2f(ri[j]);
      if (j & 1) { wke[j >> 1] |= ((unsigned)f2bf(ke)) << 16; wvt[j >> 1] |= ((unsigned)ri[j]) << 16; }
      else { wke[j >> 1] = f2bf(ke); wvt[j >> 1] = ri[j]; }
      (void)vv;
    }
    *(uint4*)sw_addr(KET, c, 2 * qd) = (uint4){wke[0], wke[1], wke[2], wke[3]};
    *(uint4*)sw_addr(KET, c, 2 * qd + 1) = (uint4){wke[4], wke[5], wke[6], wke[7]};
    *(uint4*)sw_addr(VT, c, 2 * qd) = (uint4){wvt[0], wvt[1], wvt[2], wvt[3]};
    *(uint4*)sw_addr(VT, c, 2 * qd + 1) = (uint4){wvt[4], wvt[5], wvt[6], wvt[7]};
    if (qd == 0) EG[c] = __expf(g63);
    __syncthreads();
    if (ci + 1 < 68) {
#pragma unroll
      for (int j = 0; j < 16; ++j) {
        const bfr* pr = P + scan_row64(b, d, ci + 1, 16 * qd + j) * 1280 + h * 64 + c;
        rq[j] = pr[0]; ri[j] = pr[256]; rf[j] = pr[512 + d * 256];
      }
    }
    f32x16 AT[2];
#pragma unroll
    for (int m = 0; m < 2; ++m) {
#pragma unroll
      for (int i = 0; i < 16; ++i) AT[m][i] = 0.f;
      if (m <= tb) {
#pragma unroll
        for (int kk = 0; kk < 4; ++kk)
          AT[m] = __builtin_amdgcn_mfma_f32_32x32x16_bf16(frag_nat(KT, 32 * m + r, kk, hf), frag_nat(QT, 32 * tb + r, kk, hf), AT[m], 0, 0, 0);
        if (m == tb) {
#pragma unroll
          for (int i = 0; i < 16; ++i) if (crow_(i, hf) > r) AT[m][i] = 0.f;
        }
      }
    }
    f32x16 o;
#pragma unroll
    for (int i = 0; i < 16; ++i) o[i] = 0.f;
#pragma unroll
    for (int m = 0; m < 2; ++m)
#pragma unroll
      for (int st = 0; st < 2; ++st)
        o = __builtin_amdgcn_mfma_f32_32x32x16_bf16(frag_krow(QG, 32 * tb + r, 4 * m + 2 * st, hf), pack8(S[m], st), o, 0, 0, 0);
#pragma unroll
    for (int m = 0; m < 2; ++m) {
      if (m <= tb) {
#pragma unroll
        for (int st = 0; st < 2; ++st)
          o = __builtin_amdgcn_mfma_f32_32x32x16_bf16(pack8(AT[m], st), frag_krow(VT, 32 * vb + r, 4 * m + 2 * st, hf), o, 0, 0, 0);
      }
    }
#pragma unroll
    for (int m = 0; m < 2; ++m) {
#pragma unroll
      for (int gq = 0; gq < 4; ++gq) {
        float4 e4 = *(const float4*)(EG + 32 * m + 8 * gq + 4 * hf);
        S[m][4 * gq + 0] *= e4.x; S[m][4 * gq + 1] *= e4.y; S[m][4 * gq + 2] *= e4.z; S[m][4 * gq + 3] *= e4.w;
      }
#pragma unroll
      for (int kk = 0; kk < 4; ++kk)
        S[m] = __builtin_amdgcn_mfma_f32_32x32x16_bf16(frag_nat(KET, 32 * m + r, kk, hf), frag_nat(VT, 32 * vb + r, kk, hf), S[m], 0, 0, 0);
    }
#pragma unroll
    for (int i = 0; i < 16; ++i) {
      const int t = 32 * tb + crow_(i, hf);
      P[scan_row64(b, d, ci, t) * 1280 + 512 + d * 256 + h * 64 + 32 * vb + r] = f2bf(o[i]);
    }
  }
  __builtin_amdgcn_s_setprio(0);
}

__device__ __forceinline__ void gdn_solve_task(const Params& p, int l, int task, char* smemc) {
  const int tid = tidx(), lane = tid & 63, wave = __builtin_amdgcn_readfirstlane(tid >> 6), r = lane & 31, hf = lane >> 5;
  const int chunk = task >> 2, h = task & 3;
  const int row0 = chunk * 64;
  int t0, n;
  if (row0 < NLAT) { t0 = row0 & 4095; n = 4096; } else { t0 = (row0 - NLAT) & 255; n = 256; }
  bfr* Kt = (bfr*)smemc;
  float* T0 = (float*)(smemc + 8192);
  float* T1 = T0 + 4096;
  float* GC = T1 + 4096;
  float* BT = GC + 128;
  {
    const int c = lane, qd = wave;
    const int ch = 256 + h * 64 + c;
    const float* gw = p.in[9] + l * 3 * 768;
    const float w0 = gw[ch], w1 = gw[768 + ch], w2 = gw[1536 + ch];
    const bfr* pg = WSP(bfr, OFF_PGDN);
    float x[18];
#pragma unroll
    for (int j = 0; j < 18; ++j) {
      const int tt = t0 + 16 * qd - 1 + j;
      x[j] = (tt >= 0 && tt < n) ? bf2f(pg[(size_t)(row0 + 16 * qd - 1 + j) * 1024 + ch]) : 0.f;
    }
#pragma unroll
    for (int j = 0; j < 16; ++j) {
      float a = w0 * x[j] + w1 * x[j + 1] + w2 * x[j + 2];
      a *= fsigmoid(a);
      float ss = wave_sum(a * a);
      a *= rsqrtf(ss + 1e-6f);
      const int i = 16 * qd + j;
      Kt[i * 64 + (((c >> 3) ^ (i & 7)) << 3) + (c & 7)] = f2bf(a);
    }
  }
  if (wave < 2) {
    const int d = wave, i = lane;
    const int tok = d == 0 ? i : 63 - i;
    const float* ar = WSP(float, OFF_AB) + (size_t)(row0 + tok) * 16;
    const float x = ar[d * 4 + h] + p.in[11][l * 8 + d * 4 + h];
    const float sp = fmaxf(x, 0.f) + log1pf(expf(-fabsf(x)));
    float g = -expf(p.in[10][l * 8 + d * 4 + h]) * sp;
#pragma unroll
    for (int off = 1; off < 64; off <<= 1) { float t = __shfl_up(g, off); if (lane >= off) g += t; }
    GC[d * 64 + i] = g;
    BT[d * 64 + i] = sigmoidf_(ar[8 + d * 4 + h]);
    (WSP(float, OFF_AB) + (size_t)(row0 + tok) * 16)[d * 4 + h] = g;
  }
  __syncthreads();
  {
    const int mi = wave >> 1, nj = wave & 1;
    f32x16 acc;
#pragma unroll
    for (int i = 0; i < 16; ++i) acc[i] = 0.f;
#pragma unroll
    for (int kk = 0; kk < 4; ++kk)
      acc = __builtin_amdgcn_mfma_f32_32x32x16_bf16(frag_nat(Kt, 32 * mi + r, kk, hf), frag_nat(Kt, 32 * nj + r, kk, hf), acc, 0, 0, 0);
    const int tj = 32 * nj + r;
#pragma unroll
    for (int reg = 0; reg < 16; ++reg) {
      const int ti = 32 * mi + crow_(reg, hf);
      if (tj < ti) T0[ti * 64 + tj] = BT[ti] * acc[reg] * __expf(GC[ti] - GC[tj]);
      else if (tj > ti) { const int i = 63 - ti, j = 63 - tj; T1[i * 64 + j] = BT[64 + i] * acc[reg] * __expf(GC[64 + i] - GC[64 + j]); }
    }
  }
  __syncthreads();
  if (wave < 2) {
    const int d = wave, c = lane;
    const float* T = T0 + d * 4096;
    float X[64];
#pragma unroll
    for (int i = 0; i < 64; ++i) {
      float a0 = (i == c) ? 1.f : 0.f, a1 = 0.f, a2 = 0.f, a3 = 0.f;
#pragma unroll
      for (int j = 0; j < i; ++j) {
        const float tx = T[i * 64 + j] * X[j];
        if ((j & 3) == 0) a0 -= tx; else if ((j & 3) == 1) a1 -= tx; else if ((j & 3) == 2) a2 -= tx; else a3 -= tx;
      }
      X[i] = (a0 + a1) + (a2 + a3);
    }
    const float bc = BT[d * 64 + c];
    const int hd = h * 2 + d;
    const int colbase = hd < 4 ? hd * 64 : 512 + (hd - 4) * 64;
    bfr* oc = WSP(bfr, OFF_HN) + (size_t)row0 * 1024 + colbase + c;
#pragma unroll
    for (int i = 0; i < 64; ++i) {
      const int tok = d == 0 ? i : 63 - i;
      oc[(size_t)tok * 1024] = f2bf(X[i] * bc);
    }
  }
  __syncthreads();
}

__device__ __forceinline__ void gdn_chunked(const Params& p, int l, int task, char* smemc) {
  const int b = task >> 3, h = (task >> 1) & 3, d = task & 1;
  const int tid = tidx(), lane = tid & 63, wave = tid >> 6, r = lane & 31, hf = lane >> 5;
  const int tb = wave >> 1, vb = wave & 1;
  bfr* Qn = (bfr*)smemc;
  bfr* Kn = Qn + 4096;
  bfr* NKG = Kn + 4096;
  bfr* QG = NKG + 4096;
  bfr* KGET = QG + 4096;
  bfr* ABm = KGET + 4096;
  bfr* Vn = ABm + 4096;
  float* GC = (float*)(smemc + 57344);
  float* EGC = GC + 64;
  float* EGE = EGC + 64;
  const int cp = tid & 31, og = tid >> 5;
  const int hd = h * 2 + d;
  const int colbase = hd < 4 ? hd * 64 : 512 + (hd - 4) * 64;
  const float Aexp = expf(p.in[10][l * 8 + d * 4 + h]);
  const float dtb = p.in[11][l * 8 + d * 4 + h];
  const bfr* gq = WSP(bfr, OFF_GQ);
  const bfr* oc = WSP(bfr, OFF_HN);
  const float* ab = WSP(float, OFF_AB);
  bfr* P = WSP(bfr, OFF_PGDN);
  f32x16 S[2];
#pragma unroll
  for (int m = 0; m < 2; ++m)
#pragma unroll
    for (int i = 0; i < 16; ++i) S[m][i] = 0.f;
  __builtin_amdgcn_s_setprio(3);
  unsigned rq[8], rk[8], rv[8], ra[8];
  float rga = 0.f;
#pragma unroll
  for (int j = 0; j < 8; ++j) {
    const size_t row = scan_row64(b, d, 0, 8 * og + j);
    const bfr* pr = gq + row * 768 + h * 64 + 2 * cp;
    rq[j] = *(const unsigned*)pr; rk[j] = *(const unsigned*)(pr + 256); rv[j] = *(const unsigned*)(pr + 512);
    ra[j] = *(const unsigned*)(oc + row * 1024 + colbase + 2 * cp);
  }
  if (tid < 64) rga = ab[scan_row64(b, d, 0, tid) * 16 + d * 4 + h];
#pragma unroll 1
  for (int ci = 0; ci < 68; ++ci) {
    __syncthreads();
    if (wave == 0) {
      const float g = rga;
      const float g63 = __shfl(g, 63);
      GC[lane] = g; EGC[lane] = __expf(g); EGE[lane] = __expf(g63 - g);
    }
    __syncthreads();
    {
      unsigned w0[4], w1[4];
#pragma unroll
      for (int j = 0; j < 8; ++j) {
        const int i = 8 * og + j;
        const float eg = EGC[i], ee = EGE[i];
        const int addr = i * 64 + ((((cp >> 2) ^ (i & 7))) << 3) + 2 * (cp & 3);
        const float q0 = __uint_as_float(rq[j] << 16), q1 = __uint_as_float(rq[j] & 0xffff0000u);
        const float k0 = __uint_as_float(rk[j] << 16), k1 = __uint_as_float(rk[j] & 0xffff0000u);
        *(unsigned*)(Qn + addr) = rq[j];
        *(unsigned*)(Kn + addr) = rk[j];
        *(unsigned*)(Vn + addr) = rv[j];
        *(unsigned*)(ABm + addr) = ra[j];
        *(unsigned*)(NKG + addr) = pk2(-k0 * eg, -k1 * eg);
        *(unsigned*)(QG + addr) = pk2(q0 * 0.125f * eg, q1 * 0.125f * eg);
        const unsigned e0 = f2bf(k0 * ee), e1 = f2bf(k1 * ee);
        if (j & 1) { w0[j >> 1] |= e0 << 16; w1[j >> 1] |= e1 << 16; } else { w0[j >> 1] = e0; w1[j >> 1] = e1; }
      }
      *(uint4*)sw_addr(KGET, 2 * cp, og) = (uint4){w0[0], w0[1], w0[2], w0[3]};
      *(uint4*)sw_addr(KGET, 2 * cp + 1, og) = (uint4){w1[0], w1[1], w1[2], w1[3]};
    }
    __syncthreads();
    if (ci + 1 < 68) {
#pragma unroll
      for (int j = 0; j < 8; ++j) {
        const size_t row = scan_row64(b, d, ci + 1, 8 * og + j);
        const bfr* pr = gq + row * 768 + h * 64 + 2 * cp;
        rq[j] = *(const unsigned*)pr; rk[j] = *(const unsigned*)(pr + 256); rv[j] = *(const unsigned*)(pr + 512);
        ra[j] = *(const unsigned*)(oc + row * 1024 + colbase + 2 * cp);
      }
      if (tid < 64) rga = ab[scan_row64(b, d, ci + 1, tid) * 16 + d * 4 + h];
    }
    f32x16 vn[2];
#pragma unroll
    for (int mt = 0; mt < 2; ++mt)
#pragma unroll
      for (int i = 0; i < 16; ++i) vn[mt][i] = 0.f;
#pragma unroll
    for (int m = 0; m < 2; ++m) {
      f32x16 rr;
#pragma unroll
      for (int reg = 0; reg < 16; ++reg) {
        const int i = 32 * m + crow_(reg, hf), v = 32 * vb + r;
        rr[reg] = bf2f(Vn[i * 64 + (((v >> 3) ^ (i & 7)) << 3) + (v & 7)]);
      }
#pragma unroll
      for (int mp = 0; mp < 2; ++mp)
#pragma unroll
        for (int st = 0; st < 2; ++st)
          rr = __builtin_amdgcn_mfma_f32_32x32x16_bf16(frag_krow(NKG, 32 * m + r, 4 * mp + 2 * st, hf), pack8(S[mp], st), rr, 0, 0, 0);
#pragma unroll
      for (int mt = 0; mt < 2; ++mt) {
        if (m <= mt) {
#pragma unroll
          for (int st = 0; st < 2; ++st)
            vn[mt] = __builtin_amdgcn_mfma_f32_32x32x16_bf16(frag_krow(ABm, 32 * mt + r, 4 * m + 2 * st, hf), pack8(rr, st), vn[mt], 0, 0, 0);
        }
      }
    }
    f32x16 o;
#pragma unroll
    for (int i = 0; i < 16; ++i) o[i] = 0.f;
#pragma unroll
    for (int mp = 0; mp < 2; ++mp)
#pragma unroll
      for (int st = 0; st < 2; ++st)
        o = __builtin_amdgcn_mfma_f32_32x32x16_bf16(frag_krow(QG, 32 * tb + r, 4 * mp + 2 * st, hf), pack8(S[mp], st), o, 0, 0, 0);
    const float gct = GC[32 * tb + r];
#pragma unroll
    for (int m = 0; m < 2; ++m) {
      if (m <= tb) {
        f32x16 AT;
#pragma unroll
        for (int i = 0; i < 16; ++i) AT[i] = 0.f;
#pragma unroll
        for (int kk = 0; kk < 4; ++kk)
          AT = __builtin_amdgcn_mfma_f32_32x32x16_bf16(frag_nat(Kn, 32 * m + r, kk, hf), frag_nat(Qn, 32 * tb + r, kk, hf), AT, 0, 0, 0);
#pragma unroll
        for (int g4i = 0; g4i < 4; ++g4i) {
          const float4 g4 = *(const float4*)(GC + 32 * m + 8 * g4i + 4 * hf);
          const float gs[4] = {g4.x, g4.y, g4.z, g4.w};
#pragma unroll
          for (int jj = 0; jj < 4; ++jj) {
            const int reg = 4 * g4i + jj;
            const bool keep = (m < tb) || (crow_(reg, hf) <= r);
            AT[reg] = keep ? AT[reg] * 0.125f * __expf(gct - gs[jj]) : 0.f;
          }
        }
#pragma unroll
        for (int st = 0; st < 2; ++st)
          o = __builtin_amdgcn_mfma_f32_32x32x16_bf16(pack8(AT, st), pack8(vn[m], st), o, 0, 0, 0);
      }
    }
    const float eg63 = EGC[63];
#pragma unroll
    for (int mp = 0; mp < 2; ++mp) {
#pragma unroll
      for (int i = 0; i < 16; ++i) S[mp][i] *= eg63;
#pragma unroll
      for (int m = 0; m < 2; ++m)
#pragma unroll
        for (int st = 0; st < 2; ++st)
          S[mp] = __builtin_amdgcn_mfma_f32_32x32x16_bf16(frag_krow(KGET, 32 * mp + r, 4 * m + 2 * st, hf), pack8(vn[m], st), S[mp], 0, 0, 0);
    }
#pragma unroll
    for (int i = 0; i < 16; ++i) {
      const int t = 32 * tb + crow_(i, hf);
      P[scan_row64(b, d, ci, t) * 1024 + d * 256 + h * 64 + 32 * vb + r] = f2bf(o[i]);
    }
  }
  __builtin_amdgcn_s_setprio(0);
}

__device__ __forceinline__ void gdn_scan(const Params& p, int l, int task, float* smem) {
  const int b = task >> 3, h = (task >> 1) & 3, d = task & 1;
  const int tid = tidx(), lane = tid & 63, wave = tid >> 6;
  const int kg = lane & 3, vv = wave * 16 + (lane >> 2);
  float* sq = smem;
  float* sk = smem + 2048;
  float* sv = smem + 4096;
  float* so = smem + 6144;
  float* seg_ = smem + 8192;
  float* sbt = smem + 8192 + 32;
  const bfr* gq = WSP(bfr, OFF_GQ);
  const float* ab = WSP(float, OFF_AB);
  bfr* P = WSP(bfr, OFF_PGDN);
  const float Aexp = expf(p.in[10][l * 8 + d * 4 + h]);
  const float dtb = p.in[11][l * 8 + d * 4 + h];
  const int ch = tid & 63, i0 = tid >> 6;
  v2f S2[8];
#pragma unroll
  for (int i = 0; i < 8; ++i) S2[i] = (v2f){0.f, 0.f};
  __builtin_amdgcn_s_setprio(3);
  bfr rq[8], rk[8], rv[8];
  float ra = 0.f, rb = 0.f;
#pragma unroll
  for (int j = 0; j < 8; ++j) {
    const bfr* pr = gq + scan_row(b, d, 0, i0 + 4 * j) * 768 + h * 64 + ch;
    rq[j] = pr[0]; rk[j] = pr[256]; rv[j] = pr[512];
  }
  if (tid < 32) { const float* ar = ab + scan_row(b, d, 0, tid) * 16; ra = ar[d * 4 + h]; rb = ar[8 + d * 4 + h]; }
  for (int ci = 0; ci < 136; ++ci) {
#pragma unroll
    for (int j = 0; j < 8; ++j) {
      const int e = (i0 + 4 * j) * 64 + ch;
      sq[e] = bf2f(rq[j]) * 0.125f;
      sk[e] = bf2f(rk[j]);
      sv[e] = bf2f(rv[j]);
    }
    if (tid < 32) {
      float x = ra + dtb;
      float sp = fmaxf(x, 0.f) + log1pf(expf(-fabsf(x)));
      seg_[tid] = expf(-Aexp * sp);
      sbt[tid] = sigmoidf_(rb);
    }
    __syncthreads();
    if (ci + 1 < 136) {
#pragma unroll
      for (int j = 0; j < 8; ++j) {
        const bfr* pr = gq + scan_row(b, d, ci + 1, i0 + 4 * j) * 768 + h * 64 + ch;
        rq[j] = pr[0]; rk[j] = pr[256]; rv[j] = pr[512];
      }
      if (tid < 32) { const float* ar = ab + scan_row(b, d, ci + 1, tid) * 16; ra = ar[d * 4 + h]; rb = ar[8 + d * 4 + h]; }
    }
#pragma unroll 4
    for (int i = 0; i < 32; ++i) {
      const float vcur = sv[i * 64 + vv];
      const float eg = seg_[i], bt = sbt[i];
      const float4* k4 = (const float4*)(sk + i * 64 + kg * 16);
      const float4* q4 = (const float4*)(sq + i * 64 + kg * 16);
      v2f kk[8], qq[8];
#pragma unroll
      for (int j = 0; j < 4; ++j) {
        float4 a = k4[j], c = q4[j];
        kk[2 * j] = (v2f){a.x, a.y}; kk[2 * j + 1] = (v2f){a.z, a.w};
        qq[2 * j] = (v2f){c.x, c.y}; qq[2 * j + 1] = (v2f){c.z, c.w};
      }
      v2f ka = {0.f, 0.f}, kb = {0.f, 0.f};
#pragma unroll
      for (int j = 0; j < 4; ++j) { ka += kk[2 * j] * S2[2 * j]; kb += kk[2 * j + 1] * S2[2 * j + 1]; }
      const float ks = quad_sum((ka.x + ka.y) + (kb.x + kb.y));
      const float cfac = bt * (vcur - eg * ks);
      const v2f eg2 = {eg, eg}, cf2 = {cfac, cfac};
      v2f pa = {0.f, 0.f}, pb = {0.f, 0.f};
#pragma unroll
      for (int j = 0; j < 4; ++j) {
        S2[2 * j] = kk[2 * j] * cf2 + eg2 * S2[2 * j];
        S2[2 * j + 1] = kk[2 * j + 1] * cf2 + eg2 * S2[2 * j + 1];
        pa += qq[2 * j] * S2[2 * j];
        pb += qq[2 * j + 1] * S2[2 * j + 1];
      }
      const float po = quad_sum((pa.x + pa.y) + (pb.x + pb.y));
      if (kg == 0) so[i * 64 + vv] = po;
    }
    __syncthreads();
#pragma unroll
    for (int j = 0; j < 8; ++j) {
      const int i = i0 + 4 * j;
      P[scan_row(b, d, ci, i) * 1024 + d * 256 + h * 64 + ch] = f2bf(so[i * 64 + ch]);
    }
  }
  __builtin_amdgcn_s_setprio(0);
}

__device__ __forceinline__ void hy_conv(const Params& p, int l, int stage, int task) {
  const int c = tidx();
  int n, t0;
  size_t rowbase;
  const float* G;
  { int tk = task; int b = tk >> 4; n = 256; t0 = (tk & 15) * 16; rowbase = (size_t)NLAT + b * 256; G = ((l & 1) ? WSP(float, OFF_GFC2) : WSP(float, OFF_GFC)) + (size_t)stage * 511 * 256; }
  const bfr* U = (stage == 0 ? WSP(bfr, OFF_HVC) : WSP(bfr, OFF_HZC)) - (size_t)NLAT * 256;
  float acc[16];
#pragma unroll
  for (int i = 0; i < 16; ++i) acc[i] = 0.f;
  for (int s0 = 0; s0 < n; s0 += 16) {
    float u[16], w[31];
#pragma unroll
    for (int j = 0; j < 16; ++j) u[j] = bf2f(U[(rowbase + s0 + j) * 256 + c]);
    const float* Gb = G + (size_t)(t0 - s0 - 15 + n - 1) * 256 + c;
#pragma unroll
    for (int m = 0; m < 31; ++m) w[m] = Gb[(size_t)m * 256];
#pragma unroll
    for (int i = 0; i < 16; ++i)
#pragma unroll
      for (int j = 0; j < 16; ++j) acc[i] += w[i - j + 15] * u[j];
  }
  const bfr* ph = WSP(bfr, OFF_PHY);
  const float* hw = p.in[13] + l * 3 * 768;
  const int xc = 256 + stage * 256 + c;
  float w0 = hw[xc], w1 = hw[768 + xc], w2 = hw[1536 + xc];
#pragma unroll
  for (int i = 0; i < 16; ++i) {
    int t = t0 + i;
    size_t row = rowbase + t;
    float xg = w1 * bf2f(ph[row * 768 + xc]);
    if (t > 0) xg += w0 * bf2f(ph[(row - 1) * 768 + xc]);
    if (t < n - 1) xg += w2 * bf2f(ph[(row + 1) * 768 + xc]);
    float val = xg * acc[i];
    if (stage == 0) (WSP(bfr, OFF_HZC) - (size_t)NLAT * 256)[row * 256 + c] = f2bf(val);
    else WSP(bfr, OFF_HN)[row * 1024 + 256 + c] = f2bf(val);
  }
}

__device__ __forceinline__ bf16x8 toep_frag(const unsigned* Rs, int e0) {
  const int dw = e0 >> 1;
  const unsigned sh = (unsigned)(e0 & 1) * 16u;
  unsigned d0 = Rs[dw], d1 = Rs[dw + 1], d2 = Rs[dw + 2], d3 = Rs[dw + 3], d4 = Rs[dw + 4];
  uint4 o;
  o.x = __builtin_amdgcn_alignbit(d1, d0, sh);
  o.y = __builtin_amdgcn_alignbit(d2, d1, sh);
  o.z = __builtin_amdgcn_alignbit(d3, d2, sh);
  o.w = __builtin_amdgcn_alignbit(d4, d3, sh);
  return __builtin_bit_cast(bf16x8, o);
}
__device__ __forceinline__ void hy_task(const Params& p, int l, int task, char* smemc) {
  const int tid = tidx(), lane = tid & 63, wave = tid >> 6, r = lane & 31, hf = lane >> 5;
  const int c = task >> 1, bh = task & 1;
  unsigned* Rs = (unsigned*)smemc;
  bfr* Us = (bfr*)(smemc + 16384 + 64);
  constexpr int USTR = 4104;
  const int bl = r & 3, t1l = r >> 2;
  f32x16 acc[2][2];
  __syncthreads();
  for (int i = tid; i < 2048; i += 256) {
    int b4 = i >> 9, c16 = i & 511;
    *(uint4*)(Us + b4 * USTR + c16 * 8) = *(const uint4*)(WSP(bfr, OFF_HVT) + ((size_t)(c * 8 + bh * 4 + b4)) * 4096 + c16 * 8);
  }
#pragma unroll 1
  for (int stage = 0; stage < 2; ++stage) {
    {
      const uint4* rsrc = (const uint4*)(WSP(bfr, OFF_RF) + (size_t)(l & 1) * (4 * MIB) + ((size_t)(stage * 256 + c)) * 8192);
      for (int i = tid; i < 1024; i += 256) ((uint4*)Rs)[i] = rsrc[i];
      if (tid < 8) Rs[4096 + tid] = 0u;
    }
    __syncthreads();
#pragma unroll
    for (int a = 0; a < 2; ++a)
#pragma unroll
      for (int m = 0; m < 2; ++m)
#pragma unroll
        for (int i = 0; i < 16; ++i) acc[a][m][i] = 0.f;
#pragma unroll 1
    for (int d1 = 16 * wave - 63; d1 <= 16 * wave + 15; ++d1) {
      const int eb = 4096 - 64 * d1 - r + 8 * hf;
      bf16x8 f0 = toep_frag(Rs, eb);
      bf16x8 f1 = toep_frag(Rs, eb + 16);
      bf16x8 f2 = toep_frag(Rs, eb + 32);
      bf16x8 f3 = toep_frag(Rs, eb + 48);
      bf16x8 f4 = toep_frag(Rs, eb - 32);
      bf16x8 f5 = toep_frag(Rs, eb - 16);
#pragma unroll
      for (int nt = 0; nt < 2; ++nt) {
        const int t1lo = 16 * wave + 8 * nt;
        if (t1lo + 7 - d1 < 0 || t1lo - d1 > 63) continue;
        const int s1 = t1lo + t1l - d1;
        const bool valid = (s1 >= 0) && (s1 < 64);
        const bfr* up = Us + bl * USTR + 64 * (valid ? s1 : 0) + 8 * hf;
        bf16x8 b0 = *(const bf16x8*)(up), b1 = *(const bf16x8*)(up + 16), b2 = *(const bf16x8*)(up + 32), b3 = *(const bf16x8*)(up + 48);
        if (!valid) {
#pragma unroll
          for (int i = 0; i < 8; ++i) { b0[i] = 0; b1[i] = 0; b2[i] = 0; b3[i] = 0; }
        }
        acc[nt][0] = __builtin_amdgcn_mfma_f32_32x32x16_bf16(f0, b0, acc[nt][0], 0, 0, 0);
        acc[nt][0] = __builtin_amdgcn_mfma_f32_32x32x16_bf16(f1, b1, acc[nt][0], 0, 0, 0);
        acc[nt][0] = __builtin_amdgcn_mfma_f32_32x32x16_bf16(f2, b2, acc[nt][0], 0, 0, 0);
        acc[nt][0] = __builtin_amdgcn_mfma_f32_32x32x16_bf16(f3, b3, acc[nt][0], 0, 0, 0);
        acc[nt][1] = __builtin_amdgcn_mfma_f32_32x32x16_bf16(f4, b0, acc[nt][1], 0, 0, 0);
        acc[nt][1] = __builtin_amdgcn_mfma_f32_32x32x16_bf16(f5, b1, acc[nt][1], 0, 0, 0);
        acc[nt][1] = __builtin_amdgcn_mfma_f32_32x32x16_bf16(f0, b2, acc[nt][1], 0, 0, 0);
        acc[nt][1] = __builtin_amdgcn_mfma_f32_32x32x16_bf16(f1, b3, acc[nt][1], 0, 0, 0);
      }
    }
    const bfr* gate = WSP(bfr, stage == 0 ? OFF_X1T : OFF_X2T) + ((size_t)(c * 8 + bh * 4 + bl)) * 4096;
    __syncthreads();
#pragma unroll
    for (int nt = 0; nt < 2; ++nt)
#pragma unroll
      for (int m = 0; m < 2; ++m)
#pragma unroll
        for (int g = 0; g < 4; ++g) {
          const int t = 64 * (16 * wave + 8 * nt + t1l) + 32 * m + 8 * g + 4 * hf;
          uint2 gw = *(const uint2*)(gate + t);
          float v0 = acc[nt][m][4 * g + 0] * __uint_as_float(gw.x << 16);
          float v1 = acc[nt][m][4 * g + 1] * __uint_as_float(gw.x & 0xffff0000u);
          float v2 = acc[nt][m][4 * g + 2] * __uint_as_float(gw.y << 16);
          float v3 = acc[nt][m][4 * g + 3] * __uint_as_float(gw.y & 0xffff0000u);
          uint2 o; o.x = pk2(v0, v1); o.y = pk2(v2, v3);
          *(uint2*)(Us + bl * USTR + t) = o;
        }
  }
  __syncthreads();
  for (int i = tid; i < 2048; i += 256) {
    int b4 = i >> 9, c16 = i & 511;
    *(uint4*)(WSP(bfr, OFF_HVT) + ((size_t)(c * 8 + bh * 4 + b4)) * 4096 + c16 * 8) = *(const uint4*)(Us + b4 * USTR + c16 * 8);
  }
}

__device__ __forceinline__ void attn_task(const Params& p, int l, int task, char* smemc) {
  const int tid = tidx(), lane = tid & 63, wave = tid >> 6, r = lane & 31, hf = lane >> 5;
  int b, h, q0, kbeg;
  size_t qrowbase;
  if (task < 1024) { b = task >> 7; h = (task >> 5) & 3; q0 = (task & 31) * 128; qrowbase = (size_t)b * 4096; kbeg = 0; }
  else { int tk = task - 1024; b = tk >> 3; h = (tk >> 1) & 3; q0 = (tk & 1) * 128; qrowbase = (size_t)NLAT + b * 256; kbeg = 4096; }
  bfr* Ks = (bfr*)smemc;
  bfr* Vs = Ks + 2 * 64 * 72;
  const bfr* pd = WSP(bfr, OFF_PDA);
  const bfr* vt = WSP(bfr, OFF_VT) + (size_t)((b * 4 + h) * 64) * 4352;
  const size_t qrow = qrowbase + q0 + wave * 32 + r;
  bf16x8 qf[2][2];
#pragma unroll
  for (int j = 0; j < 2; ++j)
#pragma unroll
    for (int s = 0; s < 2; ++s) qf[j][s] = *(const bf16x8*)(pd + qrow * 768 + h * 64 + j * 32 + 16 * s + 8 * hf);
  float mq = 0.f, mk = 0.f;
  for (int i = 0; i < 32; ++i) { mq = fmaxf(mq, fabsf(p.in[25][l * 32 + i])); mk = fmaxf(mk, fabsf(p.in[26][l * 32 + i])); }
  const float Mb = 5.6568542f * 1.03f * mq * mk * 1.44269504f;
  f32x16 O[2][2];
#pragma unroll
  for (int j = 0; j < 2; ++j)
#pragma unroll
    for (int d = 0; d < 2; ++d)
#pragma unroll
      for (int i = 0; i < 16; ++i) O[j][d][i] = 0.f;
  float ls[2] = {0.f, 0.f};
  const int nt = (4352 - kbeg) >> 6;
  const int lrow = tid >> 3, lpart = (tid & 7) * 8;
  uint4 rk0, rk1, rv0, rv1;
  auto kptr = [&](int k0, int rowi) -> const bfr* {
    int kidx = k0 + rowi;
    size_t krow = kidx < 4096 ? (size_t)b * 4096 + kidx : (size_t)NLAT + b * 256 + (kidx - 4096);
    return pd + krow * 768 + 256 + h * 64 + lpart;
  };
  rk0 = *(const uint4*)kptr(kbeg, lrow);
  rk1 = *(const uint4*)kptr(kbeg, lrow + 32);
  rv0 = *(const uint4*)(vt + (size_t)lrow * 4352 + kbeg + lpart);
  rv1 = *(const uint4*)(vt + (size_t)(lrow + 32) * 4352 + kbeg + lpart);
  __syncthreads();
  *(uint4*)(Ks + (lrow)*72 + lpart) = rk0;
  *(uint4*)(Ks + (lrow + 32) * 72 + lpart) = rk1;
  *(uint4*)(Vs + (lrow)*72 + lpart) = rv0;
  *(uint4*)(Vs + (lrow + 32) * 72 + lpart) = rv1;
  __syncthreads();
  for (int kt = 0; kt < nt; ++kt) {
    const int cur = kt & 1;
    if (kt + 1 < nt) {
      const int k0 = kbeg + (kt + 1) * 64;
      rk0 = *(const uint4*)kptr(k0, lrow);
      rk1 = *(const uint4*)kptr(k0, lrow + 32);
      rv0 = *(const uint4*)(vt + (size_t)lrow * 4352 + k0 + lpart);
      rv1 = *(const uint4*)(vt + (size_t)(lrow + 32) * 4352 + k0 + lpart);
    }
#pragma unroll
    for (int sub = 0; sub < 2; ++sub) {
      bf16x8 vf[2][2];
#pragma unroll
      for (int d = 0; d < 2; ++d)
#pragma unroll
        for (int s = 0; s < 2; ++s) vf[d][s] = *(const bf16x8*)(Vs + (cur * 64 + d * 32 + r) * 72 + sub * 32 + 16 * s + 8 * hf);
#pragma unroll
      for (int j = 0; j < 2; ++j) {
        bf16x8 kf0 = *(const bf16x8*)(Ks + (cur * 64 + sub * 32 + r) * 72 + j * 32 + 8 * hf);
        bf16x8 kf1 = *(const bf16x8*)(Ks + (cur * 64 + sub * 32 + r) * 72 + j * 32 + 16 + 8 * hf);
        f32x16 S;
#pragma unroll
        for (int i = 0; i < 16; ++i) S[i] = -Mb;
        __builtin_amdgcn_s_setprio(1);
        S = __builtin_amdgcn_mfma_f32_32x32x16_bf16(kf0, qf[j][0], S, 0, 0, 0);
        S = __builtin_amdgcn_mfma_f32_32x32x16_bf16(kf1, qf[j][1], S, 0, 0, 0);
        __builtin_amdgcn_s_setprio(0);
#pragma unroll
        for (int i = 0; i < 16; ++i) S[i] = __builtin_amdgcn_exp2f(S[i]);
        v2f ps2 = {0.f, 0.f};
#pragma unroll
        for (int i = 0; i < 8; ++i) ps2 += (v2f){S[2 * i], S[2 * i + 1]};
        ls[j] += ps2.x + ps2.y;
        unsigned pw[8];
#pragma unroll
        for (int i = 0; i < 8; ++i) pw[i] = pk2(S[2 * i], S[2 * i + 1]);
        bf16x8 pf0 = __builtin_bit_cast(bf16x8, (uint4){pw[0], pw[1], pw[2], pw[3]});
        bf16x8 pf1 = __builtin_bit_cast(bf16x8, (uint4){pw[4], pw[5], pw[6], pw[7]});
        __builtin_amdgcn_s_setprio(1);
#pragma unroll
        for (int d = 0; d < 2; ++d) {
          O[j][d] = __builtin_amdgcn_mfma_f32_32x32x16_bf16(vf[d][0], pf0, O[j][d], 0, 0, 0);
          O[j][d] = __builtin_amdgcn_mfma_f32_32x32x16_bf16(vf[d][1], pf1, O[j][d], 0, 0, 0);
        }
        __builtin_amdgcn_s_setprio(0);
      }
    }
    if (kt + 1 < nt) {
      const int nx = cur ^ 1;
      *(uint4*)(Ks + (nx * 64 + lrow) * 72 + lpart) = rk0;
      *(uint4*)(Ks + (nx * 64 + lrow + 32) * 72 + lpart) = rk1;
      *(uint4*)(Vs + (nx * 64 + lrow) * 72 + lpart) = rv0;
      *(uint4*)(Vs + (nx * 64 + lrow + 32) * 72 + lpart) = rv1;
    }
    __syncthreads();
  }
  ls[0] += __shfl_xor(ls[0], 32);
  ls[1] += __shfl_xor(ls[1], 32);
  const float* lp = p.in[27] + l * 128;
  float d01 = 0.f, d23 = 0.f;
  for (int i = 0; i < 32; ++i) { d01 += lp[i] * lp[32 + i]; d23 += lp[64 + i] * lp[96 + i]; }
  const float lam_init = 0.8f - 0.6f * expf(-0.3f * (float)l);
  const float lam = expf(d01) - expf(d23) + lam_init;
  const float i0 = 1.f / ls[0], i1 = lam / ls[1];
  float ss = 0.f;
#pragma unroll
  for (int d = 0; d < 2; ++d)
#pragma unroll
    for (int i = 0; i < 16; ++i) { float o = O[0][d][i] * i0 - O[1][d][i] * i1; O[0][d][i] = o; ss += o * o; }
  ss += __shfl_xor(ss, 32);
  const float rn = rsqrtf(ss * (1.f / 64.f) + 1e-6f) * (1.f - lam_init);
  const float* sw = p.in[28] + l * 64;
  bfr* op = WSP(bfr, OFF_HN) + qrow * 1024 + 768 + h * 64;
#pragma unroll
  for (int d = 0; d < 2; ++d)
#pragma unroll
    for (int g = 0; g < 4; ++g) {
      const int dv = d * 32 + 8 * g + 4 * hf;
      float4 w4 = *(const float4*)(sw + dv);
      uint2 o;
      o.x = pk2(O[0][d][4 * g + 0] * rn * w4.x, O[0][d][4 * g + 1] * rn * w4.y);
      o.y = pk2(O[0][d][4 * g + 2] * rn * w4.z, O[0][d][4 * g + 3] * rn * w4.w);
      *(uint2*)(op + dv) = o;
    }
}

__device__ __forceinline__ void finish_task(const Params& p, int l, int task  , char* smemc) {
  const int tid = tidx();
  if (task < 1024) {
    bfr* tile = (bfr*)smemc;
    const int row0 = task * 32, bb = row0 >> 12, t0 = row0 & 4095;
    const bfr* src = WSP(bfr, OFF_HVT) + ((size_t)(tid * 8 + bb)) * 4096 + t0;
#pragma unroll
    for (int i = 0; i < 4; ++i) *(uint4*)(tile + tid * 40 + 8 * i) = ((const uint4*)src)[i];
    __syncthreads();
    const int rr = tid >> 3, part = tid & 7;
    bfr* dst = WSP(bfr, OFF_HN) + (size_t)(row0 + rr) * 1024 + 256 + part * 32;
#pragma unroll
    for (int i = 0; i < 4; ++i) {
      unsigned w[4];
#pragma unroll
      for (int q = 0; q < 4; ++q) {
        const int c0 = part * 32 + i * 8 + q * 2;
        w[q] = (unsigned)tile[c0 * 40 + rr] | ((unsigned)tile[(c0 + 1) * 40 + rr] << 16);
      }
      ((uint4*)dst)[i] = (uint4){w[0], w[1], w[2], w[3]};
    }
    __syncthreads();
  }
  const int rr = tid >> 3, hd = tid & 7;
  const size_t row = (size_t)task * 32 + rr;
  const bfr *pf, *pb, *pgt;
  const float* nw;
  bfr* dst;
  if (hd < 4) {
    const bfr* r = WSP(bfr, OFF_PGDN) + row * 1024;
    pf = r + hd * 64; pb = r + 256 + hd * 64; pgt = r + 768 + hd * 64;
    nw = p.in[12] + l * 64; dst = WSP(bfr, OFF_HN) + row * 1024 + hd * 64;
  } else {
    const int hh = hd - 4;
    const bfr* r = WSP(bfr, OFF_PHG) + row * 1280;
    pf = r + 512 + hh * 64; pb = r + 768 + hh * 64; pgt = r + 1024 + hh * 64;
    nw = p.in[24] + l * 64; dst = WSP(bfr, OFF_HN) + row * 1024 + 512 + hh * 64;
  }
  uint4 vf[8], vb[8], vg[8];
#pragma unroll
  for (int i = 0; i < 8; ++i) { vf[i] = ((const uint4*)pf)[i]; vb[i] = ((const uint4*)pb)[i]; vg[i] = ((const uint4*)pgt)[i]; }
  float o[64];
  float ss = 0.f;
#pragma unroll
  for (int i = 0; i < 8; ++i) {
    const unsigned a[4] = {vf[i].x, vf[i].y, vf[i].z, vf[i].w};
    const unsigned c[4] = {vb[i].x, vb[i].y, vb[i].z, vb[i].w};
#pragma unroll
    for (int q = 0; q < 4; ++q) {
      float lo = __uint_as_float(a[q] << 16) + __uint_as_float(c[q] << 16);
      float hi = __uint_as_float(a[q] & 0xffff0000u) + __uint_as_float(c[q] & 0xffff0000u);
      o[8 * i + 2 * q] = lo; o[8 * i + 2 * q + 1] = hi;
      ss += lo * lo + hi * hi;
    }
  }
  const float rn = rsqrtf(ss * (1.f / 64.f) + 1e-6f);
#pragma unroll
  for (int i = 0; i < 8; ++i) {
    const unsigned g[4] = {vg[i].x, vg[i].y, vg[i].z, vg[i].w};
    unsigned w[4];
#pragma unroll
    for (int q = 0; q < 4; ++q) {
      float g0 = __uint_as_float(g[q] << 16), g1 = __uint_as_float(g[q] & 0xffff0000u);
      float y0 = o[8 * i + 2 * q] * rn * nw[8 * i + 2 * q] * siluf_(g0);
      float y1 = o[8 * i + 2 * q + 1] * rn * nw[8 * i + 2 * q + 1] * siluf_(g1);
      w[q] = pk2(y0, y1);
    }
    ((uint4*)dst)[i] = (uint4){w[0], w[1], w[2], w[3]};
  }
}

__global__ void __launch_bounds__(256, 2) mega(Params p) {
  extern __shared__ __attribute__((aligned(1024))) char smemc[];
  __shared__ int s_task;
  float* smem = (float*)smemc;
  cg::grid_group grid = cg::this_grid();
  unsigned* ctr = WSP(unsigned, OFF_CTR);
  const int G = gridDim.x, bid = blockIdx.x;

  __shared__ uint4 xb_words;
  if (threadIdx.x == 0) xb_words = make_uint4(0u, 0u, 0u, 0u);
  __syncthreads();
  XcdBarrier xb = xcd_barrier_post(WSP(unsigned, OFF_CTR) + 1024, (volatile LAS unsigned*)&xb_words);
  phase_mod(p, smem);
  for (int task = G - 1 - bid; task < 272; task += G) { int l0 = 0; asm volatile("" : "+s"(l0)); filt_task(p, l0, task, smem); }
  grid.sync();

  for (int l = 0; l < 4; ++l) {
    const bool want_ctx = l < 3;
    for (int task = bid; task < 3296 + 1088; task += G) {
      int lq = l; asm volatile("" : "+s"(lq));
      if (task < 3296) wconv_tile(p, lq, task, smem);
      else norm_rows(p, lq, 0, task - 3296);
    }
    xcd_barrier(xb);
    { int lq = l; asm volatile("" : "+s"(lq));
    gemm_phase<0>(p, lq, WSP(bfr, OFF_HN), 1024, WSP(bfr, OFF_WIN), 1024, 136, 31, smemc); }
    xcd_barrier(xb);
    for (int task = bid; task < 1088 + 2176; task += G) {
      int lq = l; asm volatile("" : "+s"(lq));
      if (task < 2176) gdn_solve_task(p, lq, task, smemc);
      else prep_task(p, lq, task - 2176, smemc);
    }
    xcd_barrier(xb);
    {
      const int nhy = want_ctx ? 640 : 512, nat = want_ctx ? 1088 : 1024;
      const int nflt = want_ctx ? 272 : 0;
      const int total = 128 + nhy + nat + nflt;
      while (true) {
        __syncthreads();
        if (threadIdx.x == 0) s_task = (int)atomicAdd(&ctr[l * 2], 1u);
        __syncthreads();
        int task = s_task;
        if (task >= total) break;
        int lq = l; asm volatile("" : "+s"(lq));
        if (task < 64) gdn_chunked(p, lq, task, smemc);
        else if (task < 128) hgrn_chunked(p, lq, task - 64, smemc);
        else if (task < 128 + 512) hy_task(p, lq, task - 128, smemc);
        else if (task < 128 + nhy) hy_conv(p, lq, 0, task - 640);
        else if (task < 128 + nhy + nat) attn_task(p, lq, task - 128 - nhy, smemc);
        else filt_task(p, lq + 1, task - 128 - nhy - nat, smem);
      }
    }
    xcd_barrier(xb);
    {
      const int nhy = want_ctx ? 128 : 0, nfin = want_ctx ? 1088 : 1024;
      const int total = nhy + nfin;
      while (true) {
        __syncthreads();
        if (threadIdx.x == 0) s_task = (int)atomicAdd(&ctr[l * 2 + 1], 1u);
        __syncthreads();
        int task = s_task;
        if (task >= total) break;
        int lq = l; asm volatile("" : "+s"(lq));
        if (task < nhy) hy_conv(p, lq, 1, task);
        else finish_task(p, lq, task - nhy, smemc);
      }
    }
    xcd_barrier(xb);
    const int mt = want_ctx ? 136 : 128;
    { int lq = l; asm volatile("" : "+s"(lq));
    gemm_phase<1>(p, lq, WSP(bfr, OFF_HN), 1024, WSP(bfr, OFF_WOUT), 1024, mt, 8, smemc); }
    xcd_barrier(xb);
    for (int task = bid; task < mt * 8; task += G) { int lq = l; asm volatile("" : "+s"(lq)); norm_rows(p, lq, 1, task); }
    xcd_barrier(xb);
    { int lq = l; asm volatile("" : "+s"(lq));
    gemm_phase<2>(p, lq, WSP(bfr, OFF_HN), 1024, WSP(bfr, OFF_W1), 1024, mt, 32, smemc); }
    xcd_barrier(xb);
    { int lq = l; asm volatile("" : "+s"(lq));
    gemm_phase<3>(p, lq, WSP(bfr, OFF_HID), 4096, WSP(bfr, OFF_W2), 4096, mt, 8, smemc); }
    if (l < 3) xcd_barrier(xb);
  }
}

extern "C" void kernel_launch(void* const* d_in, const int* in_sizes, int n_in, void* d_out, int out_size, void* d_ws, size_t ws_size,
                              hipStream_t stream) {
  static int grid_blocks = 0;
  if (!grid_blocks) {
    int dev = 0, cus = 0, per_cu = 0;
    hipGetDevice(&dev);
    hipDeviceGetAttribute(&cus, hipDeviceAttributeMultiprocessorCount, dev);
    (void)hipFuncSetAttribute((const void*)mega, hipFuncAttributeMaxDynamicSharedMemorySize, LDS_BYTES);
    hipOccupancyMaxActiveBlocksPerMultiprocessor(&per_cu, mega, 256, LDS_BYTES);
    if (per_cu < 1) per_cu = 1;
    if (per_cu > 2) per_cu = 2;
    grid_blocks = cus * per_cu;
    if (ws_size < WS_NEED) fprintf(stderr, "kernel_launch: workspace too small: %zu < %zu\n", ws_size, (size_t)WS_NEED);
  }
  Params p{};
  for (int i = 0; i < 32; ++i) p.in[i] = (const float*)d_in[i];
  p.out = (float*)d_out;
  p.ws = (unsigned char*)d_ws;
  hipMemsetAsync(d_ws, 0, 32768, stream);
  void* args[] = {&p};
  hipError_t e = hipLaunchCooperativeKernel((void*)mega, dim3(grid_blocks), dim3(256), args, LDS_BYTES, stream);
  if (e != hipSuccess) fprintf(stderr, "cooperative launch failed: %s (grid %d)\n", hipGetErrorString(e), grid_blocks);
}
```

```cpp
#include <hip/hip_runtime.h>
#include <hip/hip_bf16.h>
#include <hip/hip_cooperative_groups.h>
#include <cstdio>
#include <cstdint>
namespace cg = cooperative_groups;

typedef unsigned short bfr;
using bf16x8 = __attribute__((ext_vector_type(8))) short;
using f32x4 = __attribute__((ext_vector_type(4))) float;

#define NLAT 32768
#define NCTX 2048
#define NTOK 34816
#define MIB ((size_t)1 << 20)
#define OFF_CTR 0
#define OFF_MOD (1 * MIB)
#define OFF_LB (OFF_MOD + 884736)
#define OFF_ROPE (OFF_LB + 4096)
#define OFF_XC (2 * MIB)
#define OFF_WIN (10 * MIB)
#define OFF_WOUT (OFF_WIN + 8126464)
#define OFF_W1 (OFF_WOUT + 2 * MIB)
#define OFF_W2 (OFF_W1 + 8 * MIB)
#define OFF_HN (36 * MIB)
#define OFF_AB (104 * MIB)
#define OFF_PGDN (107 * MIB)
#define OFF_PHY (175 * MIB)
#define OFF_PHG (226 * MIB)
#define OFF_PDA (311 * MIB)
#define OFF_GQ (362 * MIB)
#define OFF_HVT (413 * MIB)
#define OFF_HVC (429 * MIB)
#define OFF_X1T (430 * MIB)
#define OFF_HZC (446 * MIB)
#define OFF_RF (447 * MIB)
#define OFF_GFC (463 * MIB)
#define OFF_VT (464 * MIB)
#define OFF_X2T (482 * MIB)
#define OFF_SLAB (379 * MIB)
#define OFF_HID OFF_PGDN
#define OFF_GFC2 (498 * MIB)
#define WS_NEED (499 * MIB)
#define LDS_BYTES 73728

struct Params {
  const float* in[32];
  float* out;
  unsigned char* ws;
};

__device__ __forceinline__ float bf2f(bfr v) { return __uint_as_float(((unsigned)v) << 16); }
typedef __attribute__((ext_vector_type(2))) __bf16 bf2v_t;
typedef __attribute__((ext_vector_type(2))) float f2v_t;
using f32x16 = __attribute__((ext_vector_type(16))) float;
__device__ __forceinline__ unsigned pk2(float lo, float hi) {
  f2v_t f = {lo, hi};
  return __builtin_bit_cast(unsigned, __builtin_convertvector(f, bf2v_t));
}
__device__ __forceinline__ bfr f2bf(float f) { return (bfr)(pk2(f, 0.f) & 0xffffu); }
__device__ __forceinline__ float sigmoidf_(float x) { return 1.f / (1.f + expf(-x)); }
__device__ __forceinline__ float siluf_(float x) { return x / (1.f + expf(-x)); }
__device__ __forceinline__ float fsigmoid(float x) { return __builtin_amdgcn_rcpf(1.f + __expf(-x)); }
__device__ __forceinline__ float wave_sum(float v) {
#pragma unroll
  for (int o = 32; o >= 1; o >>= 1) v += __shfl_xor(v, o);
  return v;
}
__device__ __forceinline__ float quad_sum(float v) {
  v += __int_as_float(__builtin_amdgcn_mov_dpp(__float_as_int(v), 0xB1, 0xF, 0xF, true));
  v += __int_as_float(__builtin_amdgcn_mov_dpp(__float_as_int(v), 0x4E, 0xF, 0xF, true));
  return v;
}
typedef float v2f __attribute__((ext_vector_type(2)));

__device__ __forceinline__ int tidx() { int t = threadIdx.x; asm volatile("" : "+v"(t)); return t; }
#define WSP(T, off) ((T*)(p.ws + (off)))


#define XB_TMO      128
#define XB_XCNT(j)  (256  + 64 * (j))
#define XB_XSUB(j)  (1280 + 64 * (j))
#define XB_XGEN(j)  (2304 + 64 * (j))
#define XB_TOP      3328
#define XB_TOPGEN   3392
#define XCD_BAR_WORDS 3456
#define XB_SPIN_CAP (1u << 24)
#define LAS __attribute__((address_space(3)))
__device__ __forceinline__ unsigned xb_ld(unsigned* p) { return __hip_atomic_load(p, __ATOMIC_RELAXED, __HIP_MEMORY_SCOPE_AGENT); }
__device__ __forceinline__ unsigned xb_add(unsigned* p, unsigned v) { return __hip_atomic_fetch_add(p, v, __ATOMIC_RELAXED, __HIP_MEMORY_SCOPE_AGENT); }
__device__ __forceinline__ unsigned xb_xcc_id() { return (unsigned)__builtin_amdgcn_s_getreg((3 << 11) | 20) & 0xFu; }
#define XB_SPIN(cond, bar) do { unsigned _sp = 0; while (cond) { __builtin_amdgcn_s_sleep(1); \
    if ((++_sp & 255u) == 0u) { if (xb_ld(&(bar)[XB_TMO])) break; if (_sp > XB_SPIN_CAP) { atomicAdd(&(bar)[XB_TMO], 1u); break; } } } } while (0)
struct XcdBarrier { unsigned* bar; unsigned x; volatile LAS unsigned* st; };
__device__ __forceinline__ XcdBarrier xcd_barrier_post(unsigned* bar, volatile LAS unsigned* st) {
  XcdBarrier b; b.bar = bar; b.x = xb_xcc_id(); b.st = st;
  if (threadIdx.x == 0) (void)xb_add(&bar[XB_XCNT(b.x)], 1u);
  return b;
}
__device__ __forceinline__ void xcd_barrier_complete(unsigned* bar, unsigned x, unsigned& nloc, unsigned& nx) {
  const unsigned G = gridDim.x * gridDim.y * gridDim.z;
  unsigned sum, cnt, mine, sp = 0u;
  for (;;) {
    sum = 0u; cnt = 0u; mine = 0u;
#pragma unroll
    for (unsigned j = 0; j < 16; ++j) { const unsigned c = xb_ld(&bar[XB_XCNT(j)]); sum += c; cnt += (c > 0u) ? 1u : 0u; mine = (j == x) ? c : mine; }
    if (sum == G) break;
    __builtin_amdgcn_s_sleep(1);
    if ((++sp & 255u) == 0u) { if (xb_ld(&bar[XB_TMO])) break; if (sp > XB_SPIN_CAP) { atomicAdd(&bar[XB_TMO], 1u); break; } }
  }
  nloc = mine > 0u ? mine : 1u; nx = cnt > 0u ? cnt : 1u;
}
__device__ __forceinline__ void xcd_barrier(const XcdBarrier& b) {
  asm volatile("s_waitcnt vmcnt(0)" ::: "memory");
  __syncthreads();
  if (threadIdx.x == 0) {
    unsigned* bar = b.bar;
    __builtin_amdgcn_s_waitcnt(0);
    unsigned nloc = b.st[0], nx = b.st[1];
    if (nloc == 0u) { xcd_barrier_complete(bar, b.x, nloc, nx); b.st[0] = nloc; b.st[1] = nx; }
    const unsigned old = xb_add(&bar[XB_XSUB(b.x)], 1u);
    const unsigned gen = old / nloc;
    if (old + 1u == (gen + 1u) * nloc) {
      __builtin_amdgcn_fence(__ATOMIC_RELEASE, "agent");
      asm volatile("s_waitcnt vmcnt(0)" ::: "memory");
      const unsigned og = xb_add(&bar[XB_TOP], 1u);
      const unsigned tg = og / nx;
      if (og + 1u == (tg + 1u) * nx) xb_add(&bar[XB_TOPGEN], 1u);
      else XB_SPIN(xb_ld(&bar[XB_TOPGEN]) == tg, bar);
      __builtin_amdgcn_fence(__ATOMIC_ACQUIRE, "agent");
      xb_add(&bar[XB_XGEN(b.x)], 1u);
      asm volatile("s_waitcnt vmcnt(0)" ::: "memory");
    } else {
      XB_SPIN(xb_ld(&bar[XB_XGEN(b.x)]) == gen, bar);
      __builtin_amdgcn_fence(__ATOMIC_ACQUIRE, "agent");
      asm volatile("s_waitcnt vmcnt(0)" ::: "memory");
    }
  }
  __syncthreads();
}

__device__ __forceinline__ void phase_mod(const Params& p, float* smem) {
  const int tid = tidx();
  float* sc = smem;
  float* red = smem + 9 * 1024;
  float* mod = WSP(float, OFF_MOD);
  bool loaded = false;
  for (int task = blockIdx.x; task < 4 * 96; task += gridDim.x) {
    if (!loaded) {
      for (int i = tid; i < 9 * 1024; i += 256) {
        int m = i >> 10, k = i & 1023;
        float v = m < 8 ? p.in[1][m * 1024 + k] : p.in[3][k];
        sc[i] = siluf_(v);
      }
      __syncthreads();
      loaded = true;
    }
    int l = task / 96, cgp = task % 96;
    int col = cgp * 64 + (tid & 63), ks = tid >> 6;
    const float* w = p.in[4] + (size_t)l * 1024 * 6144 + col;
    float acc[9];
#pragma unroll
    for (int m = 0; m < 9; ++m) acc[m] = 0.f;
#pragma unroll 8
    for (int k = ks * 256; k < ks * 256 + 256; ++k) {
      float wv = w[(size_t)k * 6144];
#pragma unroll
      for (int m = 0; m < 9; ++m) acc[m] += sc[m * 1024 + k] * wv;
    }
#pragma unroll
    for (int m = 0; m < 9; ++m) red[(ks * 9 + m) * 64 + (tid & 63)] = acc[m];
    __syncthreads();
    if (tid < 64) {
#pragma unroll
      for (int m = 0; m < 9; ++m) {
        float s = red[(0 * 9 + m) * 64 + tid] + red[(1 * 9 + m) * 64 + tid] + red[(2 * 9 + m) * 64 + tid] + red[(3 * 9 + m) * 64 + tid];
        mod[(size_t)(l * 9 + m) * 6144 + col] = s + p.in[5][l * 6144 + col];
      }
    }
    __syncthreads();
  }
  if (blockIdx.x == gridDim.x - 2) {
    float* rope = WSP(float, OFF_ROPE);
    for (int e = tid; e < 512; e += 256) {
      const int pos = e >> 3, i = e & 7;
      const float inv = powf(10000.f, -(float)i / 8.f);
      float sn, cs;
      sincosf((float)pos * inv, &sn, &cs);
      rope[pos * 16 + i] = cs;
      rope[pos * 16 + 8 + i] = sn;
    }
  }
  if (blockIdx.x == gridDim.x - 1) {
    int c = tid;
    const float* raw = p.in[23];
    float r0 = raw[c], r1 = raw[256 + c], r2 = raw[512 + c], r3 = raw[768 + c];
    float mx = fmaxf(fmaxf(r0, r1), fmaxf(r2, r3));
    float e0 = expf(r0 - mx), e1 = expf(r1 - mx), e2 = expf(r2 - mx), e3 = expf(r3 - mx);
    float inv = 1.f / (e0 + e1 + e2 + e3);
    float* lb = WSP(float, OFF_LB);
    lb[c] = 0.f;
    lb[256 + c] = e1 * inv;
    lb[512 + c] = (e1 + e2) * inv;
    lb[768 + c] = (e1 + e2 + e3) * inv;
  }
}

__device__ __forceinline__ const float* xin_row(const Params& p, int l, int row) {
  if (row < NLAT) return (l == 0 ? p.in[0] : (const float*)p.out) + (size_t)row * 1024;
  return (l == 0 ? p.in[2] : (const float*)WSP(float, OFF_XC)) + (size_t)(row - NLAT) * 1024;
}
__device__ __forceinline__ float* xout_row(const Params& p, int row) {
  if (row < NLAT) return p.out + (size_t)row * 1024;
  return WSP(float, OFF_XC) + (size_t)(row - NLAT) * 1024;
}
__device__ __forceinline__ int mod_idx(int row) { return row < NLAT ? (row >> 12) : 8; }

__device__ __forceinline__ void norm_rows(const Params& p, int l, int which, int task  ) {
  const int tid = tidx(), lane = tid & 63, wave = tid >> 6;
  const float* lnw = p.in[which == 0 ? 6 : 7] + l * 1024;
  bfr* hn = WSP(bfr, OFF_HN);
  const int row0 = task * 32;
  const float* mv = WSP(float, OFF_MOD) + (size_t)(l * 9 + mod_idx(row0)) * 6144 + (which == 0 ? 0 : 3072);
  const bool fold = (which == 0) && (l >= 1) && (row0 >= NLAT);
  {
    constexpr int g = 0;
    float4 v[8][4];
#pragma unroll
    for (int j = 0; j < 8; ++j) {
      const int row = row0 + wave + 4 * (g * 4 + j);
      const float* xr = which == 0 ? xin_row(p, l, row) : (const float*)xout_row(p, row);
#pragma unroll
      for (int i = 0; i < 4; ++i) v[j][i] = ((const float4*)xr)[lane + 64 * i];
    }
    if (fold) {
#pragma unroll
      for (int j = 0; j < 8; ++j) {
        const int row = row0 + wave + 4 * (g * 4 + j), rc = row - NLAT;
#pragma unroll
        for (int i = 0; i < 4; ++i) {
          const int col = 4 * (lane + 64 * i);
          const float* sl = WSP(float, OFF_SLAB) + (size_t)(((rc >> 8) * 8 + (col >> 7)) * 8) * 32768 + (size_t)(rc & 255) * 128 + (col & 127);
          float4 sm = *(const float4*)sl;
#pragma unroll
          for (int ks = 1; ks < 8; ++ks) { const float4 t = *(const float4*)(sl + (size_t)ks * 32768); sm.x += t.x; sm.y += t.y; sm.z += t.z; sm.w += t.w; }
          const float4 g4 = *(const float4*)(WSP(float, OFF_MOD) + (size_t)((l - 1) * 9 + 8) * 6144 + 5120 + col);
          v[j][i].x += g4.x * sm.x; v[j][i].y += g4.y * sm.y; v[j][i].z += g4.z * sm.z; v[j][i].w += g4.w * sm.w;
          ((float4*)xout_row(p, row))[lane + 64 * i] = v[j][i];
        }
      }
    }
    float rj[8];
#pragma unroll
    for (int j = 0; j < 8; ++j) {
      float ss = 0.f;
#pragma unroll
      for (int i = 0; i < 4; ++i) ss += v[j][i].x * v[j][i].x + v[j][i].y * v[j][i].y + v[j][i].z * v[j][i].z + v[j][i].w * v[j][i].w;
      ss = wave_sum(ss);
      rj[j] = rsqrtf(ss * (1.f / 1024.f) + 1e-6f);
    }
#pragma unroll
    for (int i = 0; i < 4; ++i) {
      const int c = 4 * (lane + 64 * i);
      const float4 w = *(const float4*)(lnw + c);
      const float4 sh = *(const float4*)(mv + c);
      const float4 sc = *(const float4*)(mv + 1024 + c);
      const float m0 = w.x * (1.f + sc.x), m1 = w.y * (1.f + sc.y), m2 = w.z * (1.f + sc.z), m3 = w.w * (1.f + sc.w);
#pragma unroll
      for (int j = 0; j < 8; ++j) {
        const int row = row0 + wave + 4 * (g * 4 + j);
        const float r = rj[j];
        ushort4 o;
        o.x = f2bf(v[j][i].x * r * m0 + sh.x);
        o.y = f2bf(v[j][i].y * r * m1 + sh.y);
        o.z = f2bf(v[j][i].z * r * m2 + sh.z);
        o.w = f2bf(v[j][i].w * r * m3 + sh.w);
        *(ushort4*)(hn + (size_t)row * 1024 + c) = o;
      }
    }
  }
}

__device__ __forceinline__ void wconv_tile(const Params& p, int l, int task, float* smem) {
  const int tid = tidx();
  const float* src;
  bfr* dst;
  int K, N, kt, nt, mode = 0;
  if (task < 992) { src = p.in[8] + (size_t)l * 1024 * 3856; dst = WSP(bfr, OFF_WIN); K = 1024; N = 3856; kt = task / 62; nt = task % 62; mode = 1; }
  else if (task < 992 + 256) { int t = task - 992; src = p.in[29] + (size_t)l * 1024 * 1024; dst = WSP(bfr, OFF_WOUT); K = 1024; N = 1024; kt = t / 16; nt = t % 16; }
  else if (task < 992 + 256 + 1024) { int t = task - 1248; src = p.in[30] + (size_t)l * 1024 * 4096; dst = WSP(bfr, OFF_W1); K = 1024; N = 4096; kt = t / 64; nt = t % 64; }
  else { int t = task - 2272; src = p.in[31] + (size_t)l * 4096 * 1024; dst = WSP(bfr, OFF_W2); K = 4096; N = 1024; kt = t / 16; nt = t % 16; }
  float* tile = smem;
  {
    int nl = tid & 63;
    int np = nt * 64 + nl;
    int sc = np;
    if (mode == 1) sc = np < 1024 ? np : (np < 3840 ? np + 16 : (np < 3856 ? np - 3840 + 1024 : -1));
#pragma unroll
    for (int i = 0; i < 16; ++i) {
      int kl = (tid >> 6) + 4 * i;
      tile[kl * 65 + nl] = sc >= 0 ? src[(size_t)(kt * 64 + kl) * N + sc] : 0.f;
    }
  }
  __syncthreads();
  {
    int kl = tid & 63;
#pragma unroll
    for (int i = 0; i < 16; ++i) {
      int nl = (tid >> 6) + 4 * i;
      dst[(size_t)(nt * 64 + nl) * K + kt * 64 + kl] = f2bf(tile[kl * 65 + nl]);
    }
  }
  __syncthreads();
}

__device__ __forceinline__ void filt_task(const Params& p, int l, int task, float* smem) {
  const int tid = tidx();
  int n, pos0;
  float* G;
  if (task < 256) { n = 4096; pos0 = task * 16; G = nullptr; }
  else { n = 256; pos0 = (task - 256) * 16; G = (l & 1) ? WSP(float, OFF_GFC2) : WSP(float, OFF_GFC); }
  float* zs = smem;
  float* h1s = smem + 16 * 36;
  float* h2t = h1s + 16 * 64;
  const float* w1 = p.in[14] + l * 33 * 64;
  const float* b1 = p.in[15] + l * 64;
  const float* f1 = p.in[16] + l * 64;
  const float* w2 = p.in[17] + l * 64 * 64;
  const float* b2 = p.in[18] + l * 64;
  const float* f2 = p.in[19] + l * 64;
  const float* w3 = p.in[20] + (size_t)l * 64 * 1024;
  const float* dec = p.in[21] + l * 512;
  const float* skp = p.in[22] + l * 512;
  const float inv_nm1 = (n == 4096) ? (1.f / 4095.f) : (1.f / 255.f);
  const float twopi_n = (n == 4096) ? (6.283185307179586f / 4096.f) : (6.283185307179586f / 256.f);
  for (int i = tid; i < 16 * 33; i += 256) {
    int pp = i / 33, e = i % 33;
    float pos = (float)(pos0 + pp);
    float zv;
    if (e == 0) zv = pos * inv_nm1;
    else {
      int bi = (e - 1) & 15;
      float band = 1e-4f + (float)bi * ((15.f - 1e-4f) / 15.f);
      float ang = twopi_n * pos * band;
      zv = (e <= 16) ? cosf(ang) : -sinf(ang);
    }
    zs[pp * 36 + e] = zv;
  }
  __syncthreads();
  for (int i = tid; i < 16 * 64; i += 256) {
    int pp = i >> 6, j = i & 63;
    float a = b1[j];
    for (int e = 0; e < 33; ++e) a += zs[pp * 36 + e] * w1[e * 64 + j];
    h1s[pp * 64 + j] = sinf(f1[j] * a);
  }
  __syncthreads();
  for (int i = tid; i < 16 * 64; i += 256) {
    int pp = i >> 6, j = i & 63;
    float a = b2[j];
    for (int k = 0; k < 64; ++k) a += h1s[pp * 64 + k] * w2[k * 64 + j];
    h2t[j * 16 + pp] = sinf(f2[j] * a);
  }
  __syncthreads();
#pragma unroll 1
  for (int jj = 0; jj < 4; ++jj) {
    int col = tid + 256 * jj;
    float acc[16];
#pragma unroll
    for (int i = 0; i < 16; ++i) acc[i] = 0.f;
#pragma unroll 8
    for (int k = 0; k < 64; ++k) {
      float wv = w3[k * 1024 + col];
      const float4* h4 = (const float4*)(h2t + k * 16);
#pragma unroll
      for (int q = 0; q < 4; ++q) {
        float4 hv = h4[q];
        acc[4 * q + 0] += hv.x * wv; acc[4 * q + 1] += hv.y * wv; acc[4 * q + 2] += hv.z * wv; acc[4 * q + 3] += hv.w * wv;
      }
    }
    int side = col >> 9, f = (col >> 8) & 1, ch = col & 255;
    float dc = fabsf(dec[f * 256 + ch]);
    if (G) {
      float* Gf = G + (size_t)f * (2 * n - 1) * 256;
#pragma unroll
      for (int i = 0; i < 16; ++i) {
        int pos = pos0 + i;
        float val = acc[i] * expf(-(float)pos * inv_nm1 * dc);
        if (side == 0) {
          if (pos == 0) val += skp[f * 256 + ch];
          Gf[(size_t)(pos + n - 1) * 256 + ch] = val;
        } else if (pos >= 1) {
          Gf[(size_t)(n - 1 - pos) * 256 + ch] = val;
        }
      }
    } else {
      bfr* R = WSP(bfr, OFF_RF) + (size_t)(l & 1) * (4 * MIB) + ((size_t)(f * 256 + ch)) * 8192;
#pragma unroll
      for (int i = 0; i < 16; ++i) {
        int pos = pos0 + i;
        float val = acc[i] * expf(-(float)pos * inv_nm1 * dc);
        if (side == 0) {
          if (pos == 0) { val += skp[f * 256 + ch]; R[0] = 0; }
          R[4096 - pos] = f2bf(val);
        } else if (pos >= 1) {
          R[4096 + pos] = f2bf(val);
        }
      }
    }
  }
  __syncthreads();
}

template <bool RELU2>
__device__ __forceinline__ void store_tile_bf16(const f32x4 (&acc)[8][4], bfr* dst, int ld, int row_base, int col_base, bfr* wbuf, int lane) {
  const int fr = lane & 15, fq = lane >> 4;
#pragma unroll
  for (int pass = 0; pass < 2; ++pass) {
#pragma unroll
    for (int mm = 0; mm < 4; ++mm)
#pragma unroll
      for (int n = 0; n < 4; ++n) {
        f32x4 a = acc[4 * pass + mm][n];
        if (RELU2) {
          a[0] = fmaxf(a[0], 0.f); a[1] = fmaxf(a[1], 0.f); a[2] = fmaxf(a[2], 0.f); a[3] = fmaxf(a[3], 0.f);
          a[0] *= a[0]; a[1] *= a[1]; a[2] *= a[2]; a[3] *= a[3];
        }
        uint2 o; o.x = pk2(a[0], a[1]); o.y = pk2(a[2], a[3]);
        *(uint2*)(wbuf + (mm * 16 + fr) * 72 + n * 16 + fq * 4) = o;
      }
#pragma unroll
    for (int q = 0; q < 8; ++q) {
      const int chunk = lane + 64 * q, rowl = chunk >> 3, c16 = chunk & 7;
      const uint4 v = *(const uint4*)(wbuf + rowl * 72 + c16 * 8);
      *(uint4*)(dst + (size_t)(row_base + pass * 64 + rowl) * ld + col_base + c16 * 8) = v;
    }
  }
}

template <int EPI>
__device__ __forceinline__ void gemm_phase(const Params& p, int l, const bfr* A, int lda, const bfr* Bt, int K, int Mtiles, int Ntiles, char* smemc) {
  bfr* sA = (bfr*)smemc;
  bfr* sB = sA + 2 * 256 * 40;
  const int tid = tidx(), wave = __builtin_amdgcn_readfirstlane(tid >> 6), lane = tid & 63;
  const int wr = wave >> 1, wc = wave & 1, fr = lane & 15, fq = lane >> 4;
  const int ntiles = Mtiles * Ntiles;
  const int nk = K / 32;
  const int gsb = lane * 16, gsw = gsb ^ (((gsb >> 9) & 1) << 5);
  const int grl = gsw >> 6, gcl = (gsw & 63) >> 1;
  const int flo = (fr * 64 + fq * 16) ^ ((fr >> 3) << 5);
  const int xcd = blockIdx.x & 7, xidx = blockIdx.x >> 3, xnb = gridDim.x >> 3;
  const int SN = (Ntiles + 7) >> 3, nsup = (Mtiles >> 3) * SN;
  (void)ntiles;
  const int qper = (64 + xnb - 1) / xnb;
  const bool splitctx = (EPI == 3) && (Mtiles == 136);
  const int nsupm = splitctx ? 16 * SN : nsup;
  const int nmain = ((nsupm + 7) >> 3) * qper;
  const int nextra = splitctx ? (512 + (int)gridDim.x - 1) / (int)gridDim.x : 0;
  for (int it = 0; it < nmain + nextra; ++it) {
    int tm, tn, kt0 = 0, nkk = nk, item = -1;
    if (it < nmain) {
      const int sup = xcd + 8 * (it / qper), q = xidx + xnb * (it % qper);
      if (sup >= nsupm || q >= 64) continue;
      tm = (sup / SN) * 8 + (q >> 3); tn = (sup % SN) * 8 + (q & 7);
      if (tn >= Ntiles) continue;
    } else {
      item = blockIdx.x + gridDim.x * (it - nmain);
      if (item >= 512) continue;
      const int tl = item >> 3;
      tm = 128 + (tl >> 3); tn = tl & 7; nkk = nk >> 3; kt0 = (item & 7) * nkk;
    }
    const bfr* Ab = A + (size_t)tm * 256 * lda + (size_t)(wave * 16 + grl) * lda + gcl + kt0 * 32;
    const bfr* Bb = Bt + (size_t)tn * 128 * K + (size_t)(wave * 16 + grl) * K + gcl + kt0 * 32;
    f32x4 acc[8][4];
#pragma unroll
    for (int m = 0; m < 8; ++m)
#pragma unroll
      for (int n = 0; n < 4; ++n) acc[m][n] = (f32x4){0.f, 0.f, 0.f, 0.f};
#define GLDS_STAGE(BUF, K0) { char* la = smemc + (BUF) * 24576 + wave * 1024; \
      __builtin_amdgcn_global_load_lds((const unsigned*)(Ab + (K0)), (unsigned*)(la), 16, 0, 0); \
      __builtin_amdgcn_global_load_lds((const unsigned*)(Ab + (size_t)64 * lda + (K0)), (unsigned*)(la + 4096), 16, 0, 0); \
      __builtin_amdgcn_global_load_lds((const unsigned*)(Ab + (size_t)128 * lda + (K0)), (unsigned*)(la + 8192), 16, 0, 0); \
      __builtin_amdgcn_global_load_lds((const unsigned*)(Ab + (size_t)192 * lda + (K0)), (unsigned*)(la + 12288), 16, 0, 0); \
      __builtin_amdgcn_global_load_lds((const unsigned*)(Bb + (K0)), (unsigned*)(la + 16384), 16, 0, 0); \
      __builtin_amdgcn_global_load_lds((const unsigned*)(Bb + (size_t)64 * K + (K0)), (unsigned*)(la + 16384 + 4096), 16, 0, 0); }
#define MM4(M, AF) { acc[M][0] = __builtin_amdgcn_mfma_f32_16x16x32_bf16(bg0, AF, acc[M][0], 0, 0, 0); \
      acc[M][1] = __builtin_amdgcn_mfma_f32_16x16x32_bf16(bg1, AF, acc[M][1], 0, 0, 0); \
      acc[M][2] = __builtin_amdgcn_mfma_f32_16x16x32_bf16(bg2, AF, acc[M][2], 0, 0, 0); \
      acc[M][3] = __builtin_amdgcn_mfma_f32_16x16x32_bf16(bg3, AF, acc[M][3], 0, 0, 0); }
#define AFR(M) (*(const bf16x8*)(rap + (M) * 1024))
    __syncthreads();
    GLDS_STAGE(0, 0);
    GLDS_STAGE(1, 32);
    asm volatile("s_waitcnt vmcnt(6)" ::: "memory");
    asm volatile("s_waitcnt lgkmcnt(0)" ::: "memory");
    __builtin_amdgcn_s_barrier();
    int cur = 0, nx2 = 2;
    for (int kt = 0; kt < nkk; ++kt) {
      if (kt + 2 < nkk) GLDS_STAGE(nx2, (kt + 2) * 32);
      const char* rbp = smemc + cur * 24576 + 16384 + (wc * 4) * 1024 + flo;
      const char* rap = smemc + cur * 24576 + (wr * 8) * 1024 + flo;
      bf16x8 bg0 = *(const bf16x8*)(rbp), bg1 = *(const bf16x8*)(rbp + 1024), bg2 = *(const bf16x8*)(rbp + 2048), bg3 = *(const bf16x8*)(rbp + 3072);
      bf16x8 a0 = AFR(0), a1 = AFR(1), a2 = AFR(2);
      MM4(0, a0); a0 = AFR(3);
      MM4(1, a1); a1 = AFR(4);
      MM4(2, a2); a2 = AFR(5);
      MM4(3, a0); a0 = AFR(6);
      MM4(4, a1); a1 = AFR(7);
      MM4(5, a2);
      MM4(6, a0);
      MM4(7, a1);
      __builtin_amdgcn_sched_group_barrier(0x100, 7, 0);
      __builtin_amdgcn_sched_group_barrier(0x008, 4, 0);
      __builtin_amdgcn_sched_group_barrier(0x100, 1, 0);
      __builtin_amdgcn_sched_group_barrier(0x008, 4, 0);
      __builtin_amdgcn_sched_group_barrier(0x100, 1, 0);
      __builtin_amdgcn_sched_group_barrier(0x008, 4, 0);
      __builtin_amdgcn_sched_group_barrier(0x100, 1, 0);
      __builtin_amdgcn_sched_group_barrier(0x008, 4, 0);
      __builtin_amdgcn_sched_group_barrier(0x100, 1, 0);
      __builtin_amdgcn_sched_group_barrier(0x008, 4, 0);
      __builtin_amdgcn_sched_group_barrier(0x100, 1, 0);
      __builtin_amdgcn_sched_group_barrier(0x008, 12, 0);
      __builtin_amdgcn_sched_barrier(0);
      if (kt + 2 < nkk) asm volatile("s_waitcnt vmcnt(6)" ::: "memory");
      else asm volatile("s_waitcnt vmcnt(0)" ::: "memory");
      asm volatile("s_waitcnt lgkmcnt(0)" ::: "memory");
      __builtin_amdgcn_s_barrier();
      cur = (cur == 2) ? 0 : cur + 1;
      nx2 = (nx2 == 2) ? 0 : nx2 + 1;
    }
#undef GLDS_STAGE
#undef MM4
#undef AFR
    if (EPI == 0) {
      bfr* dst; int ld, c0;
      if (tn < 8) { dst = WSP(bfr, OFF_PGDN); ld = 1024; c0 = tn * 128; }
      else if (tn < 14) { dst = WSP(bfr, OFF_PHY); ld = 768; c0 = (tn - 8) * 128; }
      else if (tn < 24) { dst = WSP(bfr, OFF_PHG); ld = 1280; c0 = (tn - 14) * 128; }
      else if (tn < 30) { dst = WSP(bfr, OFF_PDA); ld = 768; c0 = (tn - 24) * 128; }
      else { dst = nullptr; ld = 0; c0 = 0; }
      if (dst) {
        store_tile_bf16<false>(acc, dst, ld, tm * 256 + wr * 128, c0 + wc * 64, (bfr*)smemc + wave * (64 * 72), lane);
      } else if (wc == 0) {
        float* ab = WSP(float, OFF_AB);
#pragma unroll
        for (int m = 0; m < 8; ++m) {
          int row = tm * 256 + wr * 128 + m * 16 + fr;
          *(float4*)(ab + (size_t)row * 16 + fq * 4) = (float4){acc[m][0][0], acc[m][0][1], acc[m][0][2], acc[m][0][3]};
        }
      }
    } else if (EPI == 2) {
      store_tile_bf16<true>(acc, WSP(bfr, OFF_HID), 4096, tm * 256 + wr * 128, tn * 128 + wc * 64, (bfr*)smemc + wave * (64 * 72), lane);
    } else {
      const int midx = tm < 128 ? (tm >> 4) : 8;
      const float* gv = WSP(float, OFF_MOD) + (size_t)(l * 9 + midx) * 6144 + (EPI == 1 ? 2048 : 5120);
      float* wbuf = (float*)smemc + wave * (32 * 68);
      const int colw = tn * 128 + wc * 64;
      if (item >= 0) {
        float* slb = WSP(float, OFF_SLAB) + (size_t)item * 32768 + (size_t)(wr * 128) * 128 + wc * 64;
#pragma unroll
        for (int pass = 0; pass < 4; ++pass) {
#pragma unroll
          for (int mm = 0; mm < 2; ++mm)
#pragma unroll
            for (int n = 0; n < 4; ++n)
              *(f32x4*)(wbuf + (mm * 16 + fr) * 68 + n * 16 + fq * 4) = acc[2 * pass + mm][n];
#pragma unroll
          for (int q = 0; q < 8; ++q) {
            const int chunk = lane + 64 * q, rowl = chunk >> 4, c16 = chunk & 15;
            *(f32x4*)(slb + (size_t)(pass * 32 + rowl) * 128 + c16 * 4) = *(const f32x4*)(wbuf + rowl * 68 + c16 * 4);
          }
        }
      } else {
#pragma unroll
        for (int pass = 0; pass < 4; ++pass) {
#pragma unroll
          for (int mm = 0; mm < 2; ++mm)
#pragma unroll
            for (int n = 0; n < 4; ++n)
              *(f32x4*)(wbuf + (mm * 16 + fr) * 68 + n * 16 + fq * 4) = acc[2 * pass + mm][n];
#pragma unroll
          for (int q = 0; q < 8; ++q) {
            const int chunk = lane + 64 * q, rowl = chunk >> 4, c16 = chunk & 15;
            const int row = tm * 256 + wr * 128 + pass * 32 + rowl, col = colw + c16 * 4;
            const f32x4 a = *(const f32x4*)(wbuf + rowl * 68 + c16 * 4);
            const float* xi = (EPI == 1) ? xin_row(p, l, row) : (const float*)xout_row(p, row);
            float* xo = xout_row(p, row);
            float4 xv = *(const float4*)(xi + col);
            const float4 g4 = *(const float4*)(gv + col);
            xv.x += g4.x * a[0]; xv.y += g4.y * a[1]; xv.z += g4.z * a[2]; xv.w += g4.w * a[3];
            *(float4*)(xo + col) = xv;
          }
        }
      }
    }
  }
}

__device__ __forceinline__ void prep_task(const Params& p, int l, int task  , char* smemc) {
  const int tid = tidx();
  const bfr* pg = WSP(bfr, OFF_PGDN);
  const bfr* ph = WSP(bfr, OFF_PHY);
  bfr* gq = WSP(bfr, OFF_GQ);
  bfr* hv = WSP(bfr, OFF_HVC) - (size_t)NLAT * 256;
  const float* gw = p.in[9] + l * 3 * 768;
  const float* hw = p.in[13] + l * 3 * 768;
  float gw0[3], gw1[3], gw2[3], hw0[3];
#pragma unroll
  for (int i = 0; i < 3; ++i) {
    gw0[i] = gw[i * 768 + tid]; gw1[i] = gw[i * 768 + 256 + tid]; gw2[i] = gw[i * 768 + 512 + tid]; hw0[i] = hw[i * 768 + tid];
  }
  {
    const int row0 = task * 32;
    int t0, n;
    if (row0 < NLAT) { t0 = row0 & 4095; n = 4096; } else { t0 = (row0 - NLAT) & 255; n = 256; }
    const bool isctx = row0 >= NLAT;
#pragma unroll 1
    for (int rb = 0; rb < 32; rb += 8) {
      float xq[10], xk[10], xv[10], xh[10];
#pragma unroll
      for (int j = 0; j < 10; ++j) {
        const int tt = t0 + rb - 1 + j;
        const bool ok = tt >= 0 && tt < n;
        const bfr* r = pg + (size_t)(row0 + rb - 1 + j) * 1024;
        xq[j] = ok ? bf2f(r[tid]) : 0.f;
        xk[j] = ok ? bf2f(r[256 + tid]) : 0.f;
        xv[j] = ok ? bf2f(r[512 + tid]) : 0.f;
        xh[j] = (ok && isctx) ? bf2f(ph[(size_t)(row0 + rb - 1 + j) * 768 + tid]) : 0.f;
      }
#pragma unroll
      for (int r8 = 0; r8 < 8; ++r8) {
        const int row = row0 + rb + r8;
        float aq = gw0[0] * xq[r8] + gw0[1] * xq[r8 + 1] + gw0[2] * xq[r8 + 2];
        float ak = gw1[0] * xk[r8] + gw1[1] * xk[r8 + 1] + gw1[2] * xk[r8 + 2];
        float av = gw2[0] * xv[r8] + gw2[1] * xv[r8 + 1] + gw2[2] * xv[r8 + 2];
        aq *= fsigmoid(aq); ak *= fsigmoid(ak); av *= fsigmoid(av);
        float sq = wave_sum(aq * aq), sk = wave_sum(ak * ak);
        aq *= rsqrtf(sq + 1e-6f); ak *= rsqrtf(sk + 1e-6f);
        gq[(size_t)row * 768 + tid] = f2bf(aq);
        gq[(size_t)row * 768 + 256 + tid] = f2bf(ak);
        gq[(size_t)row * 768 + 512 + tid] = f2bf(av);
        if (isctx) hv[(size_t)row * 256 + tid] = f2bf(hw0[0] * xh[r8] + hw0[1] * xh[r8 + 1] + hw0[2] * xh[r8 + 2]);
      }
    }
  }
  bfr* pd = WSP(bfr, OFF_PDA);
  for (int gi = tid; gi < 512; gi += 256) {
    int rr = gi >> 4, g = gi & 15;
    int row = task * 32 + rr;
    int qk = g >> 3;
    bfr* ptr = pd + (size_t)row * 768 + g * 32;
    const float* nw = p.in[qk == 0 ? 25 : 26] + l * 32;
    float x[32];
    uint4 raw[4];
#pragma unroll
    for (int i = 0; i < 4; ++i) raw[i] = ((const uint4*)ptr)[i];
#pragma unroll
    for (int i = 0; i < 4; ++i) {
      unsigned w0 = raw[i].x, w1 = raw[i].y, w2 = raw[i].z, w3 = raw[i].w;
      x[8 * i + 0] = __uint_as_float(w0 << 16); x[8 * i + 1] = __uint_as_float(w0 & 0xffff0000u);
      x[8 * i + 2] = __uint_as_float(w1 << 16); x[8 * i + 3] = __uint_as_float(w1 & 0xffff0000u);
      x[8 * i + 4] = __uint_as_float(w2 << 16); x[8 * i + 5] = __uint_as_float(w2 & 0xffff0000u);
      x[8 * i + 6] = __uint_as_float(w3 << 16); x[8 * i + 7] = __uint_as_float(w3 & 0xffff0000u);
    }
    float ss = 0.f;
#pragma unroll
    for (int i = 0; i < 32; ++i) ss += x[i] * x[i];
    float r = rsqrtf(ss * (1.f / 32.f) + 1e-6f);
    if (qk == 0) r *= 0.25503486f;
#pragma unroll
    for (int i = 0; i < 32; ++i) x[i] = x[i] * r * nw[i];
    if (row < NLAT) {
      int t = row & 4095;
      const float* rr_ = WSP(float, OFF_ROPE) + (t >> 6) * 16;
      const float* rc_ = WSP(float, OFF_ROPE) + (t & 63) * 16;
      float crv[8], srv[8], ccv[8], scv[8];
#pragma unroll
      for (int i = 0; i < 2; ++i) {
        float4 a4 = ((const float4*)rr_)[i], b4 = ((const float4*)rr_)[2 + i], c4 = ((const float4*)rc_)[i], d4 = ((const float4*)rc_)[2 + i];
        crv[4 * i] = a4.x; crv[4 * i + 1] = a4.y; crv[4 * i + 2] = a4.z; crv[4 * i + 3] = a4.w;
        srv[4 * i] = b4.x; srv[4 * i + 1] = b4.y; srv[4 * i + 2] = b4.z; srv[4 * i + 3] = b4.w;
        ccv[4 * i] = c4.x; ccv[4 * i + 1] = c4.y; ccv[4 * i + 2] = c4.z; ccv[4 * i + 3] = c4.w;
        scv[4 * i] = d4.x; scv[4 * i + 1] = d4.y; scv[4 * i + 2] = d4.z; scv[4 * i + 3] = d4.w;
      }
#pragma unroll
      for (int i = 0; i < 8; ++i) {
        const float sr = srv[i], cr = crv[i], scn = scv[i], cc = ccv[i];
        float a = x[i], b = x[8 + i];
        x[i] = a * cr - b * sr; x[8 + i] = b * cr + a * sr;
        float c = x[16 + i], d = x[24 + i];
        x[16 + i] = c * cc - d * scn; x[24 + i] = d * cc + c * scn;
      }
    }
#pragma unroll
    for (int i = 0; i < 4; ++i) {
      uint4 o;
      o.x = (unsigned)f2bf(x[8 * i + 0]) | ((unsigned)f2bf(x[8 * i + 1]) << 16);
      o.y = (unsigned)f2bf(x[8 * i + 2]) | ((unsigned)f2bf(x[8 * i + 3]) << 16);
      o.z = (unsigned)f2bf(x[8 * i + 4]) | ((unsigned)f2bf(x[8 * i + 5]) << 16);
      o.w = (unsigned)f2bf(x[8 * i + 6]) | ((unsigned)f2bf(x[8 * i + 7]) << 16);
      ((uint4*)ptr)[i] = o;
    }
  }
  if (task < 1024) {
    bfr* tile = (bfr*)smemc;
    const int row0 = task * 32;
    const int bb = row0 >> 12, t0 = row0 & 4095;
#pragma unroll 1
    for (int k = 0; k < 3; ++k) {
      const int ch = k * 256 + tid;
      const float w0 = hw[ch], w1 = hw[768 + ch], w2 = hw[1536 + ch];
      bfr xr[34];
#pragma unroll
      for (int j = 0; j < 34; ++j) {
        const int tt = t0 - 1 + j;
        xr[j] = (tt >= 0 && tt < 4096) ? ph[(size_t)(row0 - 1 + j) * 768 + ch] : (bfr)0;
      }
#pragma unroll
      for (int rr = 0; rr < 32; rr += 2) {
        const float y0 = w0 * bf2f(xr[rr]) + w1 * bf2f(xr[rr + 1]) + w2 * bf2f(xr[rr + 2]);
        const float y1 = w0 * bf2f(xr[rr + 1]) + w1 * bf2f(xr[rr + 2]) + w2 * bf2f(xr[rr + 3]);
        *(unsigned*)(tile + tid * 40 + rr) = pk2(y0, y1);
      }
      __syncthreads();
      bfr* dst = WSP(bfr, k == 0 ? OFF_HVT : (k == 1 ? OFF_X1T : OFF_X2T)) + ((size_t)(tid * 8 + bb)) * 4096 + t0;
#pragma unroll
      for (int i = 0; i < 4; ++i) ((uint4*)dst)[i] = *(const uint4*)(tile + tid * 40 + 8 * i);
      __syncthreads();
    }
  }
  {
    bfr* tile = (bfr*)smemc;
    const int row0 = task * 32;
    bfr vr[32];
#pragma unroll
    for (int rr = 0; rr < 32; ++rr) vr[rr] = pd[(size_t)(row0 + rr) * 768 + 512 + tid];
#pragma unroll
    for (int rr = 0; rr < 32; ++rr) {
      int pp = rr & 15;
      int g = pp >> 2;
      g = (g == 1) ? 2 : (g == 2 ? 1 : g);
      int pos = (rr & 16) | (g << 2) | (pp & 3);
      tile[tid * 40 + pos] = vr[rr];
    }
    __syncthreads();
    int bb, kbase;
    if (row0 < NLAT) { bb = row0 >> 12; kbase = row0 & 4095; } else { bb = (row0 - NLAT) >> 8; kbase = 4096 + ((row0 - NLAT) & 255); }
    bfr* vt = WSP(bfr, OFF_VT) + ((size_t)(bb * 256 + tid)) * 4352 + kbase;
#pragma unroll
    for (int i = 0; i < 4; ++i) ((uint4*)vt)[i] = *(const uint4*)(tile + tid * 40 + 8 * i);
    __syncthreads();
  }
}

__device__ __forceinline__ size_t scan_row(int b, int d, int ci, int i) {
  if (ci < 8) { int c0 = ci * 32; int t = d == 0 ? c0 + i : 255 - c0 - i; return (size_t)NLAT + b * 256 + t; }
  int c0 = (ci - 8) * 32; int t = d == 0 ? c0 + i : 4095 - c0 - i; return (size_t)b * 4096 + t;
}

__device__ __forceinline__ void hgrn_scan(const Params& p, int l, int task, float* smem) {
  const int b = task >> 3, h = (task >> 1) & 3, d = task & 1;
  const int tid = tidx(), lane = tid & 63, wave = tid >> 6;
  const int kg = lane & 3, vv = wave * 16 + (lane >> 2);
  float* sq = smem;
  float* sf = smem + 2048;
  float* sv = smem + 4096;
  float* so = smem + 6144;
  bfr* P = WSP(bfr, OFF_PHG);
  const int ch = tid & 63, i0 = tid >> 6;
  const float lbv = WSP(float, OFF_LB)[l * 256 + h * 64 + ch];
  v2f S2[8];
#pragma unroll
  for (int i = 0; i < 8; ++i) S2[i] = (v2f){0.f, 0.f};
  __builtin_amdgcn_s_setprio(3);
  bfr rq[8], ri[8], rf[8];
#pragma unroll
  for (int j = 0; j < 8; ++j) {
    const bfr* pr = P + scan_row(b, d, 0, i0 + 4 * j) * 1280 + h * 64 + ch;
    rq[j] = pr[0]; ri[j] = pr[256]; rf[j] = pr[512 + d * 256];
  }
  for (int ci = 0; ci < 136; ++ci) {
#pragma unroll
    for (int j = 0; j < 8; ++j) {
      const int e = (i0 + 4 * j) * 64 + ch;
      sq[e] = siluf_(bf2f(rq[j]));
      sf[e] = lbv + (1.f - lbv) * sigmoidf_(bf2f(rf[j]));
      sv[e] = bf2f(ri[j]);
    }
    __syncthreads();
    if (ci + 1 < 136) {
#pragma unroll
      for (int j = 0; j < 8; ++j) {
        const bfr* pr = P + scan_row(b, d, ci + 1, i0 + 4 * j) * 1280 + h * 64 + ch;
        rq[j] = pr[0]; ri[j] = pr[256]; rf[j] = pr[512 + d * 256];
      }
    }
#pragma unroll 4
    for (int i = 0; i < 32; ++i) {
      const float vcur = sv[i * 64 + vv];
      const v2f vc2 = {vcur, vcur};
      const float4* f4 = (const float4*)(sf + i * 64 + kg * 16);
      const float4* q4 = (const float4*)(sq + i * 64 + kg * 16);
      v2f pa = {0.f, 0.f}, pb = {0.f, 0.f};
#pragma unroll
      for (int j = 0; j < 4; ++j) {
        float4 f = f4[j], q = q4[j];
        v2f fa = {f.x, f.y}, fb = {f.z, f.w}, qa = {q.x, q.y}, qb = {q.z, q.w};
        S2[2 * j] = fa * (S2[2 * j] - vc2) + vc2;
        S2[2 * j + 1] = fb * (S2[2 * j + 1] - vc2) + vc2;
        pa += S2[2 * j] * qa;
        pb += S2[2 * j + 1] * qb;
      }
      float po = quad_sum((pa.x + pa.y) + (pb.x + pb.y));
      if (kg == 0) so[i * 64 + vv] = po;
    }
    __syncthreads();
#pragma unroll
    for (int j = 0; j < 8; ++j) {
      const int i = i0 + 4 * j;
      P[scan_row(b, d, ci, i) * 1280 + 512 + d * 256 + h * 64 + ch] = f2bf(so[i * 64 + ch]);
    }
  }
  __builtin_amdgcn_s_setprio(0);
}

__device__ __forceinline__ bfr* sw_addr(bfr* base, int R, int chunk) { return base + R * 64 + ((chunk ^ (R & 7)) << 3); }
__device__ __forceinline__ bf16x8 frag_nat(bfr* base, int R, int kk, int hf) { return *(const bf16x8*)sw_addr(base, R, 2 * kk + hf); }
__device__ __forceinline__ bf16x8 frag_krow(bfr* base, int R, int c0, int hf) {
  uint2 lo = *(const uint2*)(sw_addr(base, R, c0) + 4 * hf);
  uint2 hi = *(const uint2*)(sw_addr(base, R, c0 + 1) + 4 * hf);
  return __builtin_bit_cast(bf16x8, (uint4){lo.x, lo.y, hi.x, hi.y});
}
__device__ __forceinline__ bf16x8 pack8(const f32x16& x, int st) {
  return __builtin_bit_cast(bf16x8, (uint4){pk2(x[8 * st + 0], x[8 * st + 1]), pk2(x[8 * st + 2], x[8 * st + 3]),
                                            pk2(x[8 * st + 4], x[8 * st + 5]), pk2(x[8 * st + 6], x[8 * st + 7])});
}
__device__ __forceinline__ int crow_(int reg, int hf) { return (reg & 3) + 8 * (reg >> 2) + 4 * hf; }
__device__ __forceinline__ size_t scan_row64(int b, int d, int ci, int i) {
  if (ci < 4) { int c0 = ci * 64; int t = d == 0 ? c0 + i : 255 - c0 - i; return (size_t)NLAT + b * 256 + t; }
  int c0 = (ci - 4) * 64; int t = d == 0 ? c0 + i : 4095 - c0 - i; return (size_t)b * 4096 + t;
}

__device__ __forceinline__ void hgrn_chunked(const Params& p, int l, int task, char* smemc) {
  const int b = task >> 3, h = (task >> 1) & 3, d = task & 1;
  const int tid = tidx(), lane = tid & 63, wave = tid >> 6, r = lane & 31, hf = lane >> 5;
  const int tb = wave >> 1, vb = wave & 1;
  bfr* QG = (bfr*)smemc;
  bfr* QT = QG + 4096;
  bfr* KT = QT + 4096;
  bfr* KET = KT + 4096;
  bfr* VT = KET + 4096;
  float* TOT = (float*)(smemc + 40960);
  float* EG = TOT + 256;
  bfr* P = WSP(bfr, OFF_PHG);
  const int c = tid & 63, qd = tid >> 6;
  const float lbv = WSP(float, OFF_LB)[l * 256 + h * 64 + c];
  f32x16 S[2];
#pragma unroll
  for (int m = 0; m < 2; ++m)
#pragma unroll
    for (int i = 0; i < 16; ++i) S[m][i] = 0.f;
  __builtin_amdgcn_s_setprio(3);
  bfr rq[16], ri[16], rf[16];
#pragma unroll
  for (int j = 0; j < 16; ++j) {
    const bfr* pr = P + scan_row64(b, d, 0, 16 * qd + j) * 1280 + h * 64 + c;
    rq[j] = pr[0]; ri[j] = pr[256]; rf[j] = pr[512 + d * 256];
  }
#pragma unroll 1
  for (int ci = 0; ci < 68; ++ci) {
    float g[16], ky[16], qh[16];
    float run = 0.f;
#pragma unroll
    for (int j = 0; j < 16; ++j) {
      float f = lbv + (1.f - lbv) * fsigmoid(bf2f(rf[j]));
      run += __logf(f);
      const float qv = bf2f(rq[j]);
      g[j] = run; ky[j] = 1.f - f; qh[j] = qv * fsigmoid(qv);
    }
    __syncthreads();
    TOT[qd * 64 + c] = run;
    __syncthreads();
    const float t0 = TOT[c], t1 = TOT[64 + c], t2 = TOT[128 + c], t3 = TOT[192 + c];
    const float off = (qd > 0 ? t0 : 0.f) + (qd > 1 ? t1 : 0.f) + (qd > 2 ? t2 : 0.f);
    const float gm = t0 + t1, g63 = (t0 + t1) + (t2 + t3);
    const float egm = __expf(gm), e6m = __expf(g63 - gm);
    unsigned wke[8], wvt[8];
#pragma unroll
    for (int j = 0; j < 16; ++j) {
      const int i = 16 * qd + j;
      const float gi = g[j] + off;
      const float e1 = __expf(fminf(fmaxf(gi - gm, -80.f), 80.f));
      const float e2 = __builtin_amdgcn_rcpf(e1);
      const float eg = e1 * egm;
      const float e3 = e2 * e6m;
      const int sw = ((c >> 3) ^ (i & 7)) * 8 + (c & 7);
      QG[i * 64 + sw] = f2bf(qh[j] * eg);
      QT[i * 64 + sw] = f2bf(qh[j] * e1);
      KT[i * 64 + sw] = f2bf(ky[j] * e2);
      const float ke = ky[j] * e3, vv = bf2f(ri[j]);
      if (j & 1) { wke[j >> 1] |= ((unsigned)f2bf(ke)) << 16; wvt[j >> 1] |= ((unsigned)ri[j]) << 16; }
      else { wke[j >> 1] = f2bf(ke); wvt[j >> 1] = ri[j]; }
      (void)vv;
    }
    *(uint4*)sw_addr(KET, c, 2 * qd) = (uint4){wke[0], wke[1], wke[2], wke[3]};
    *(uint4*)sw_addr(KET, c, 2 * qd + 1) = (uint4){wke[4], wke[5], wke[6], wke[7]};
    *(uint4*)sw_addr(VT, c, 2 * qd) = (uint4){wvt[0], wvt[1], wvt[2], wvt[3]};
    *(uint4*)sw_addr(VT, c, 2 * qd + 1) = (uint4){wvt[4], wvt[5], wvt[6], wvt[7]};
    if (qd == 0) EG[c] = __expf(g63);
    __syncthreads();
    if (ci + 1 < 68) {
#pragma unroll
      for (int j = 0; j < 16; ++j) {
        const bfr* pr = P + scan_row64(b, d, ci + 1, 16 * qd + j) * 1280 + h * 64 + c;
        rq[j] = pr[0]; ri[j] = pr[256]; rf[j] = pr[512 + d * 256];
      }
    }
    f32x16 AT[2];
#pragma unroll
    for (int m = 0; m < 2; ++m) {
#pragma unroll
      for (int i = 0; i < 16; ++i) AT[m][i] = 0.f;
      if (m <= tb) {
#pragma unroll
        for (int kk = 0; kk < 4; ++kk)
          AT[m] = __builtin_amdgcn_mfma_f32_32x32x16_bf16(frag_nat(KT, 32 * m + r, kk, hf), frag_nat(QT, 32 * tb + r, kk, hf), AT[m], 0, 0, 0);
        if (m == tb) {
#pragma unroll
          for (int i = 0; i < 16; ++i) if (crow_(i, hf) > r) AT[m][i] = 0.f;
        }
      }
    }
    f32x16 o;
#pragma unroll
    for (int i = 0; i < 16; ++i) o[i] = 0.f;
#pragma unroll
    for (int m = 0; m < 2; ++m)
#pragma unroll
      for (int st = 0; st < 2; ++st)
        o = __builtin_amdgcn_mfma_f32_32x32x16_bf16(frag_krow(QG, 32 * tb + r, 4 * m + 2 * st, hf), pack8(S[m], st), o, 0, 0, 0);
#pragma unroll
    for (int m = 0; m < 2; ++m) {
      if (m <= tb) {
#pragma unroll
        for (int st = 0; st < 2; ++st)
          o = __builtin_amdgcn_mfma_f32_32x32x16_bf16(pack8(AT[m], st), frag_krow(VT, 32 * vb + r, 4 * m + 2 * st, hf), o, 0, 0, 0);
      }
    }
#pragma unroll
    for (int m = 0; m < 2; ++m) {
#pragma unroll
      for (int gq = 0; gq < 4; ++gq) {
        float4 e4 = *(const float4*)(EG + 32 * m + 8 * gq + 4 * hf);
        S[m][4 * gq + 0] *= e4.x; S[m][4 * gq + 1] *= e4.y; S[m][4 * gq + 2] *= e4.z; S[m][4 * gq + 3] *= e4.w;
      }
#pragma unroll
      for (int kk = 0; kk < 4; ++kk)
        S[m] = __builtin_amdgcn_mfma_f32_32x32x16_bf16(frag_nat(KET, 32 * m + r, kk, hf), frag_nat(VT, 32 * vb + r, kk, hf), S[m], 0, 0, 0);
    }
#pragma unroll
    for (int i = 0; i < 16; ++i) {
      const int t = 32 * tb + crow_(i, hf);
      P[scan_row64(b, d, ci, t) * 1280 + 512 + d * 256 + h * 64 + 32 * vb + r] = f2bf(o[i]);
    }
  }
  __builtin_amdgcn_s_setprio(0);
}

__device__ __forceinline__ void gdn_solve_task(const Params& p, int l, int task, char* smemc) {
  const int tid = tidx(), lane = tid & 63, wave = __builtin_amdgcn_readfirstlane(tid >> 6), r = lane & 31, hf = lane >> 5;
  const int chunk = task >> 2, h = task & 3;
  const int row0 = chunk * 64;
  int t0, n;
  if (row0 < NLAT) { t0 = row0 & 4095; n = 4096; } else { t0 = (row0 - NLAT) & 255; n = 256; }
  bfr* Kt = (bfr*)smemc;
  float* T0 = (float*)(smemc + 8192);
  float* T1 = T0 + 4096;
  float* GC = T1 + 4096;
  float* BT = GC + 128;
  {
    const int c = lane, qd = wave;
    const int ch = 256 + h * 64 + c;
    const float* gw = p.in[9] + l * 3 * 768;
    const float w0 = gw[ch], w1 = gw[768 + ch], w2 = gw[1536 + ch];
    const bfr* pg = WSP(bfr, OFF_PGDN);
    float x[18];
#pragma unroll
    for (int j = 0; j < 18; ++j) {
      const int tt = t0 + 16 * qd - 1 + j;
      x[j] = (tt >= 0 && tt < n) ? bf2f(pg[(size_t)(row0 + 16 * qd - 1 + j) * 1024 + ch]) : 0.f;
    }
#pragma unroll
    for (int j = 0; j < 16; ++j) {
      float a = w0 * x[j] + w1 * x[j + 1] + w2 * x[j + 2];
      a *= fsigmoid(a);
      float ss = wave_sum(a * a);
      a *= rsqrtf(ss + 1e-6f);
      const int i = 16 * qd + j;
      Kt[i * 64 + (((c >> 3) ^ (i & 7)) << 3) + (c & 7)] = f2bf(a);
    }
  }
  if (wave < 2) {
    const int d = wave, i = lane;
    const int tok = d == 0 ? i : 63 - i;
    const float* ar = WSP(float, OFF_AB) + (size_t)(row0 + tok) * 16;
    const float x = ar[d * 4 + h] + p.in[11][l * 8 + d * 4 + h];
    const float sp = fmaxf(x, 0.f) + log1pf(expf(-fabsf(x)));
    float g = -expf(p.in[10][l * 8 + d * 4 + h]) * sp;
#pragma unroll
    for (int off = 1; off < 64; off <<= 1) { float t = __shfl_up(g, off); if (lane >= off) g += t; }
    GC[d * 64 + i] = g;
    BT[d * 64 + i] = sigmoidf_(ar[8 + d * 4 + h]);
    (WSP(float, OFF_AB) + (size_t)(row0 + tok) * 16)[d * 4 + h] = g;
  }
  __syncthreads();
  {
    const int mi = wave >> 1, nj = wave & 1;
    f32x16 acc;
#pragma unroll
    for (int i = 0; i < 16; ++i) acc[i] = 0.f;
#pragma unroll
    for (int kk = 0; kk < 4; ++kk)
      acc = __builtin_amdgcn_mfma_f32_32x32x16_bf16(frag_nat(Kt, 32 * mi + r, kk, hf), frag_nat(Kt, 32 * nj + r, kk, hf), acc, 0, 0, 0);
    const int tj = 32 * nj + r;
#pragma unroll
    for (int reg = 0; reg < 16; ++reg) {
      const int ti = 32 * mi + crow_(reg, hf);
      if (tj < ti) T0[ti * 64 + tj] = BT[ti] * acc[reg] * __expf(GC[ti] - GC[tj]);
      else if (tj > ti) { const int i = 63 - ti, j = 63 - tj; T1[i * 64 + j] = BT[64 + i] * acc[reg] * __expf(GC[64 + i] - GC[64 + j]); }
    }
  }
  __syncthreads();
  if (wave < 2) {
    const int d = wave, c = lane;
    const float* T = T0 + d * 4096;
    float X[64];
#pragma unroll
    for (int i = 0; i < 64; ++i) {
      float a0 = (i == c) ? 1.f : 0.f, a1 = 0.f, a2 = 0.f, a3 = 0.f;
#pragma unroll
      for (int j = 0; j < i; ++j) {
        const float tx = T[i * 64 + j] * X[j];
        if ((j & 3) == 0) a0 -= tx; else if ((j & 3) == 1) a1 -= tx; else if ((j & 3) == 2) a2 -= tx; else a3 -= tx;
      }
      X[i] = (a0 + a1) + (a2 + a3);
    }
    const float bc = BT[d * 64 + c];
    const int hd = h * 2 + d;
    const int colbase = hd < 4 ? hd * 64 : 512 + (hd - 4) * 64;
    bfr* oc = WSP(bfr, OFF_HN) + (size_t)row0 * 1024 + colbase + c;
#pragma unroll
    for (int i = 0; i < 64; ++i) {
      const int tok = d == 0 ? i : 63 - i;
      oc[(size_t)tok * 1024] = f2bf(X[i] * bc);
    }
  }
  __syncthreads();
}

__device__ __forceinline__ void gdn_chunked(const Params& p, int l, int task, char* smemc) {
  const int b = task >> 3, h = (task >> 1) & 3, d = task & 1;
  const int tid = tidx(), lane = tid & 63, wave = tid >> 6, r = lane & 31, hf = lane >> 5;
  const int tb = wave >> 1, vb = wave & 1;
  bfr* Qn = (bfr*)smemc;
  bfr* Kn = Qn + 4096;
  bfr* NKG = Kn + 4096;
  bfr* QG = NKG + 4096;
  bfr* KGET = QG + 4096;
  bfr* ABm = KGET + 4096;
  bfr* Vn = ABm + 4096;
  float* GC = (float*)(smemc + 57344);
  float* EGC = GC + 64;
  float* EGE = EGC + 64;
  const int cp = tid & 31, og = tid >> 5;
  const int hd = h * 2 + d;
  const int colbase = hd < 4 ? hd * 64 : 512 + (hd - 4) * 64;
  const float Aexp = expf(p.in[10][l * 8 + d * 4 + h]);
  const float dtb = p.in[11][l * 8 + d * 4 + h];
  const bfr* gq = WSP(bfr, OFF_GQ);
  const bfr* oc = WSP(bfr, OFF_HN);
  const float* ab = WSP(float, OFF_AB);
  bfr* P = WSP(bfr, OFF_PGDN);
  f32x16 S[2];
#pragma unroll
  for (int m = 0; m < 2; ++m)
#pragma unroll
    for (int i = 0; i < 16; ++i) S[m][i] = 0.f;
  __builtin_amdgcn_s_setprio(3);
  unsigned rq[8], rk[8], rv[8], ra[8];
  float rga = 0.f;
#pragma unroll
  for (int j = 0; j < 8; ++j) {
    const size_t row = scan_row64(b, d, 0, 8 * og + j);
    const bfr* pr = gq + row * 768 + h * 64 + 2 * cp;
    rq[j] = *(const unsigned*)pr; rk[j] = *(const unsigned*)(pr + 256); rv[j] = *(const unsigned*)(pr + 512);
    ra[j] = *(const unsigned*)(oc + row * 1024 + colbase + 2 * cp);
  }
  if (tid < 64) rga = ab[scan_row64(b, d, 0, tid) * 16 + d * 4 + h];
#pragma unroll 1
  for (int ci = 0; ci < 68; ++ci) {
    __syncthreads();
    if (wave == 0) {
      const float g = rga;
      const float g63 = __shfl(g, 63);
      GC[lane] = g; EGC[lane] = __expf(g); EGE[lane] = __expf(g63 - g);
    }
    __syncthreads();
    {
      unsigned w0[4], w1[4];
#pragma unroll
      for (int j = 0; j < 8; ++j) {
        const int i = 8 * og + j;
        const float eg = EGC[i], ee = EGE[i];
        const int addr = i * 64 + ((((cp >> 2) ^ (i & 7))) << 3) + 2 * (cp & 3);
        const float q0 = __uint_as_float(rq[j] << 16), q1 = __uint_as_float(rq[j] & 0xffff0000u);
        const float k0 = __uint_as_float(rk[j] << 16), k1 = __uint_as_float(rk[j] & 0xffff0000u);
        *(unsigned*)(Qn + addr) = rq[j];
        *(unsigned*)(Kn + addr) = rk[j];
        *(unsigned*)(Vn + addr) = rv[j];
        *(unsigned*)(ABm + addr) = ra[j];
        *(unsigned*)(NKG + addr) = pk2(-k0 * eg, -k1 * eg);
        *(unsigned*)(QG + addr) = pk2(q0 * 0.125f * eg, q1 * 0.125f * eg);
        const unsigned e0 = f2bf(k0 * ee), e1 = f2bf(k1 * ee);
        if (j & 1) { w0[j >> 1] |= e0 << 16; w1[j >> 1] |= e1 << 16; } else { w0[j >> 1] = e0; w1[j >> 1] = e1; }
      }
      *(uint4*)sw_addr(KGET, 2 * cp, og) = (uint4){w0[0], w0[1], w0[2], w0[3]};
      *(uint4*)sw_addr(KGET, 2 * cp + 1, og) = (uint4){w1[0], w1[1], w1[2], w1[3]};
    }
    __syncthreads();
    if (ci + 1 < 68) {
#pragma unroll
      for (int j = 0; j < 8; ++j) {
        const size_t row = scan_row64(b, d, ci + 1, 8 * og + j);
        const bfr* pr = gq + row * 768 + h * 64 + 2 * cp;
        rq[j] = *(const unsigned*)pr; rk[j] = *(const unsigned*)(pr + 256); rv[j] = *(const unsigned*)(pr + 512);
        ra[j] = *(const unsigned*)(oc + row * 1024 + colbase + 2 * cp);
      }
      if (tid < 64) rga = ab[scan_row64(b, d, ci + 1, tid) * 16 + d * 4 + h];
    }
    f32x16 vn[2];
#pragma unroll
    for (int mt = 0; mt < 2; ++mt)
#pragma unroll
      for (int i = 0; i < 16; ++i) vn[mt][i] = 0.f;
#pragma unroll
    for (int m = 0; m < 2; ++m) {
      f32x16 rr;
#pragma unroll
      for (int reg = 0; reg < 16; ++reg) {
        const int i = 32 * m + crow_(reg, hf), v = 32 * vb + r;
        rr[reg] = bf2f(Vn[i * 64 + (((v >> 3) ^ (i & 7)) << 3) + (v & 7)]);
      }
#pragma unroll
      for (int mp = 0; mp < 2; ++mp)
#pragma unroll
        for (int st = 0; st < 2; ++st)
          rr = __builtin_amdgcn_mfma_f32_32x32x16_bf16(frag_krow(NKG, 32 * m + r, 4 * mp + 2 * st, hf), pack8(S[mp], st), rr, 0, 0, 0);
#pragma unroll
      for (int mt = 0; mt < 2; ++mt) {
        if (m <= mt) {
#pragma unroll
          for (int st = 0; st < 2; ++st)
            vn[mt] = __builtin_amdgcn_mfma_f32_32x32x16_bf16(frag_krow(ABm, 32 * mt + r, 4 * m + 2 * st, hf), pack8(rr, st), vn[mt], 0, 0, 0);
        }
      }
    }
    f32x16 o;
#pragma unroll
    for (int i = 0; i < 16; ++i) o[i] = 0.f;
#pragma unroll
    for (int mp = 0; mp < 2; ++mp)
#pragma unroll
      for (int st = 0; st < 2; ++st)
        o = __builtin_amdgcn_mfma_f32_32x32x16_bf16(frag_krow(QG, 32 * tb + r, 4 * mp + 2 * st, hf), pack8(S[mp], st), o, 0, 0, 0);
    const float gct = GC[32 * tb + r];
#pragma unroll
    for (int m = 0; m < 2; ++m) {
      if (m <= tb) {
        f32x16 AT;
#pragma unroll
        for (int i = 0; i < 16; ++i) AT[i] = 0.f;
#pragma unroll
        for (int kk = 0; kk < 4; ++kk)
          AT = __builtin_amdgcn_mfma_f32_32x32x16_bf16(frag_nat(Kn, 32 * m + r, kk, hf), frag_nat(Qn, 32 * tb + r, kk, hf), AT, 0, 0, 0);
#pragma unroll
        for (int g4i = 0; g4i < 4; ++g4i) {
          const float4 g4 = *(const float4*)(GC + 32 * m + 8 * g4i + 4 * hf);
          const float gs[4] = {g4.x, g4.y, g4.z, g4.w};
#pragma unroll
          for (int jj = 0; jj < 4; ++jj) {
            const int reg = 4 * g4i + jj;
            const bool keep = (m < tb) || (crow_(reg, hf) <= r);
            AT[reg] = keep ? AT[reg] * 0.125f * __expf(gct - gs[jj]) : 0.f;
          }
        }
#pragma unroll
        for (int st = 0; st < 2; ++st)
          o = __builtin_amdgcn_mfma_f32_32x32x16_bf16(pack8(AT, st), pack8(vn[m], st), o, 0, 0, 0);
      }
    }
    const float eg63 = EGC[63];
#pragma unroll
    for (int mp = 0; mp < 2; ++mp) {
#pragma unroll
      for (int i = 0; i < 16; ++i) S[mp][i] *= eg63;
#pragma unroll
      for (int m = 0; m < 2; ++m)
#pragma unroll
        for (int st = 0; st < 2; ++st)
          S[mp] = __builtin_amdgcn_mfma_f32_32x32x16_bf16(frag_krow(KGET, 32 * mp + r, 4 * m + 2 * st, hf), pack8(vn[m], st), S[mp], 0, 0, 0);
    }
#pragma unroll
    for (int i = 0; i < 16; ++i) {
      const int t = 32 * tb + crow_(i, hf);
      P[scan_row64(b, d, ci, t) * 1024 + d * 256 + h * 64 + 32 * vb + r] = f2bf(o[i]);
    }
  }
  __builtin_amdgcn_s_setprio(0);
}

__device__ __forceinline__ void gdn_scan(const Params& p, int l, int task, float* smem) {
  const int b = task >> 3, h = (task >> 1) & 3, d = task & 1;
  const int tid = tidx(), lane = tid & 63, wave = tid >> 6;
  const int kg = lane & 3, vv = wave * 16 + (lane >> 2);
  float* sq = smem;
  float* sk = smem + 2048;
  float* sv = smem + 4096;
  float* so = smem + 6144;
  float* seg_ = smem + 8192;
  float* sbt = smem + 8192 + 32;
  const bfr* gq = WSP(bfr, OFF_GQ);
  const float* ab = WSP(float, OFF_AB);
  bfr* P = WSP(bfr, OFF_PGDN);
  const float Aexp = expf(p.in[10][l * 8 + d * 4 + h]);
  const float dtb = p.in[11][l * 8 + d * 4 + h];
  const int ch = tid & 63, i0 = tid >> 6;
  v2f S2[8];
#pragma unroll
  for (int i = 0; i < 8; ++i) S2[i] = (v2f){0.f, 0.f};
  __builtin_amdgcn_s_setprio(3);
  bfr rq[8], rk[8], rv[8];
  float ra = 0.f, rb = 0.f;
#pragma unroll
  for (int j = 0; j < 8; ++j) {
    const bfr* pr = gq + scan_row(b, d, 0, i0 + 4 * j) * 768 + h * 64 + ch;
    rq[j] = pr[0]; rk[j] = pr[256]; rv[j] = pr[512];
  }
  if (tid < 32) { const float* ar = ab + scan_row(b, d, 0, tid) * 16; ra = ar[d * 4 + h]; rb = ar[8 + d * 4 + h]; }
  for (int ci = 0; ci < 136; ++ci) {
#pragma unroll
    for (int j = 0; j < 8; ++j) {
      const int e = (i0 + 4 * j) * 64 + ch;
      sq[e] = bf2f(rq[j]) * 0.125f;
      sk[e] = bf2f(rk[j]);
      sv[e] = bf2f(rv[j]);
    }
    if (tid < 32) {
      float x = ra + dtb;
      float sp = fmaxf(x, 0.f) + log1pf(expf(-fabsf(x)));
      seg_[tid] = expf(-Aexp * sp);
      sbt[tid] = sigmoidf_(rb);
    }
    __syncthreads();
    if (ci + 1 < 136) {
#pragma unroll
      for (int j = 0; j < 8; ++j) {
        const bfr* pr = gq + scan_row(b, d, ci + 1, i0 + 4 * j) * 768 + h * 64 + ch;
        rq[j] = pr[0]; rk[j] = pr[256]; rv[j] = pr[512];
      }
      if (tid < 32) { const float* ar = ab + scan_row(b, d, ci + 1, tid) * 16; ra = ar[d * 4 + h]; rb = ar[8 + d * 4 + h]; }
    }
#pragma unroll 4
    for (int i = 0; i < 32; ++i) {
      const float vcur = sv[i * 64 + vv];
      const float eg = seg_[i], bt = sbt[i];
      const float4* k4 = (const float4*)(sk + i * 64 + kg * 16);
      const float4* q4 = (const float4*)(sq + i * 64 + kg * 16);
      v2f kk[8], qq[8];
#pragma unroll
      for (int j = 0; j < 4; ++j) {
        float4 a = k4[j], c = q4[j];
        kk[2 * j] = (v2f){a.x, a.y}; kk[2 * j + 1] = (v2f){a.z, a.w};
        qq[2 * j] = (v2f){c.x, c.y}; qq[2 * j + 1] = (v2f){c.z, c.w};
      }
      v2f ka = {0.f, 0.f}, kb = {0.f, 0.f};
#pragma unroll
      for (int j = 0; j < 4; ++j) { ka += kk[2 * j] * S2[2 * j]; kb += kk[2 * j + 1] * S2[2 * j + 1]; }
      const float ks = quad_sum((ka.x + ka.y) + (kb.x + kb.y));
      const float cfac = bt * (vcur - eg * ks);
      const v2f eg2 = {eg, eg}, cf2 = {cfac, cfac};
      v2f pa = {0.f, 0.f}, pb = {0.f, 0.f};
#pragma unroll
      for (int j = 0; j < 4; ++j) {
        S2[2 * j] = kk[2 * j] * cf2 + eg2 * S2[2 * j];
        S2[2 * j + 1] = kk[2 * j + 1] * cf2 + eg2 * S2[2 * j + 1];
        pa += qq[2 * j] * S2[2 * j];
        pb += qq[2 * j + 1] * S2[2 * j + 1];
      }
      const float po = quad_sum((pa.x + pa.y) + (pb.x + pb.y));
      if (kg == 0) so[i * 64 + vv] = po;
    }
    __syncthreads();
#pragma unroll
    for (int j = 0; j < 8; ++j) {
      const int i = i0 + 4 * j;
      P[scan_row(b, d, ci, i) * 1024 + d * 256 + h * 64 + ch] = f2bf(so[i * 64 + ch]);
    }
  }
  __builtin_amdgcn_s_setprio(0);
}

__device__ __forceinline__ void hy_conv(const Params& p, int l, int stage, int task) {
  const int c = tidx();
  int n, t0;
  size_t rowbase;
  const float* G;
  { int tk = task; int b = tk >> 4; n = 256; t0 = (tk & 15) * 16; rowbase = (size_t)NLAT + b * 256; G = ((l & 1) ? WSP(float, OFF_GFC2) : WSP(float, OFF_GFC)) + (size_t)stage * 511 * 256; }
  const bfr* U = (stage == 0 ? WSP(bfr, OFF_HVC) : WSP(bfr, OFF_HZC)) - (size_t)NLAT * 256;
  float acc[16];
#pragma unroll
  for (int i = 0; i < 16; ++i) acc[i] = 0.f;
  for (int s0 = 0; s0 < n; s0 += 16) {
    float u[16], w[31];
#pragma unroll
    for (int j = 0; j < 16; ++j) u[j] = bf2f(U[(rowbase + s0 + j) * 256 + c]);
    const float* Gb = G + (size_t)(t0 - s0 - 15 + n - 1) * 256 + c;
#pragma unroll
    for (int m = 0; m < 31; ++m) w[m] = Gb[(size_t)m * 256];
#pragma unroll
    for (int i = 0; i < 16; ++i)
#pragma unroll
      for (int j = 0; j < 16; ++j) acc[i] += w[i - j + 15] * u[j];
  }
  const bfr* ph = WSP(bfr, OFF_PHY);
  const float* hw = p.in[13] + l * 3 * 768;
  const int xc = 256 + stage * 256 + c;
  float w0 = hw[xc], w1 = hw[768 + xc], w2 = hw[1536 + xc];
#pragma unroll
  for (int i = 0; i < 16; ++i) {
    int t = t0 + i;
    size_t row = rowbase + t;
    float xg = w1 * bf2f(ph[row * 768 + xc]);
    if (t > 0) xg += w0 * bf2f(ph[(row - 1) * 768 + xc]);
    if (t < n - 1) xg += w2 * bf2f(ph[(row + 1) * 768 + xc]);
    float val = xg * acc[i];
    if (stage == 0) (WSP(bfr, OFF_HZC) - (size_t)NLAT * 256)[row * 256 + c] = f2bf(val);
    else WSP(bfr, OFF_HN)[row * 1024 + 256 + c] = f2bf(val);
  }
}

__device__ __forceinline__ bf16x8 toep_frag(const unsigned* Rs, int e0) {
  const int dw = e0 >> 1;
  const unsigned sh = (unsigned)(e0 & 1) * 16u;
  unsigned d0 = Rs[dw], d1 = Rs[dw + 1], d2 = Rs[dw + 2], d3 = Rs[dw + 3], d4 = Rs[dw + 4];
  uint4 o;
  o.x = __builtin_amdgcn_alignbit(d1, d0, sh);
  o.y = __builtin_amdgcn_alignbit(d2, d1, sh);
  o.z = __builtin_amdgcn_alignbit(d3, d2, sh);
  o.w = __builtin_amdgcn_alignbit(d4, d3, sh);
  return __builtin_bit_cast(bf16x8, o);
}
__device__ __forceinline__ void hy_task(const Params& p, int l, int task, char* smemc) {
  const int tid = tidx(), lane = tid & 63, wave = tid >> 6, r = lane & 31, hf = lane >> 5;
  const int c = task >> 1, bh = task & 1;
  unsigned* Rs = (unsigned*)smemc;
  bfr* Us = (bfr*)(smemc + 16384 + 64);
  constexpr int USTR = 4104;
  const int bl = r & 3, t1l = r >> 2;
  f32x16 acc[2][2];
  __syncthreads();
  for (int i = tid; i < 2048; i += 256) {
    int b4 = i >> 9, c16 = i & 511;
    *(uint4*)(Us + b4 * USTR + c16 * 8) = *(const uint4*)(WSP(bfr, OFF_HVT) + ((size_t)(c * 8 + bh * 4 + b4)) * 4096 + c16 * 8);
  }
#pragma unroll 1
  for (int stage = 0; stage < 2; ++stage) {
    {
      const uint4* rsrc = (const uint4*)(WSP(bfr, OFF_RF) + (size_t)(l & 1) * (4 * MIB) + ((size_t)(stage * 256 + c)) * 8192);
      for (int i = tid; i < 1024; i += 256) ((uint4*)Rs)[i] = rsrc[i];
      if (tid < 8) Rs[4096 + tid] = 0u;
    }
    __syncthreads();
#pragma unroll
    for (int a = 0; a < 2; ++a)
#pragma unroll
      for (int m = 0; m < 2; ++m)
#pragma unroll
        for (int i = 0; i < 16; ++i) acc[a][m][i] = 0.f;
#pragma unroll 1
    for (int d1 = 16 * wave - 63; d1 <= 16 * wave + 15; ++d1) {
      const int eb = 4096 - 64 * d1 - r + 8 * hf;
      bf16x8 f0 = toep_frag(Rs, eb);
      bf16x8 f1 = toep_frag(Rs, eb + 16);
      bf16x8 f2 = toep_frag(Rs, eb + 32);
      bf16x8 f3 = toep_frag(Rs, eb + 48);
      bf16x8 f4 = toep_frag(Rs, eb - 32);
      bf16x8 f5 = toep_frag(Rs, eb - 16);
#pragma unroll
      for (int nt = 0; nt < 2; ++nt) {
        const int t1lo = 16 * wave + 8 * nt;
        if (t1lo + 7 - d1 < 0 || t1lo - d1 > 63) continue;
        const int s1 = t1lo + t1l - d1;
        const bool valid = (s1 >= 0) && (s1 < 64);
        const bfr* up = Us + bl * USTR + 64 * (valid ? s1 : 0) + 8 * hf;
        bf16x8 b0 = *(const bf16x8*)(up), b1 = *(const bf16x8*)(up + 16), b2 = *(const bf16x8*)(up + 32), b3 = *(const bf16x8*)(up + 48);
        if (!valid) {
#pragma unroll
          for (int i = 0; i < 8; ++i) { b0[i] = 0; b1[i] = 0; b2[i] = 0; b3[i] = 0; }
        }
        acc[nt][0] = __builtin_amdgcn_mfma_f32_32x32x16_bf16(f0, b0, acc[nt][0], 0, 0, 0);
        acc[nt][0] = __builtin_amdgcn_mfma_f32_32x32x16_bf16(f1, b1, acc[nt][0], 0, 0, 0);
        acc[nt][0] = __builtin_amdgcn_mfma_f32_32x32x16_bf16(f2, b2, acc[nt][0], 0, 0, 0);
        acc[nt][0] = __builtin_amdgcn_mfma_f32_32x32x16_bf16(f3, b3, acc[nt][0], 0, 0, 0);
        acc[nt][1] = __builtin_amdgcn_mfma_f32_32x32x16_bf16(f4, b0, acc[nt][1], 0, 0, 0);
        acc[nt][1] = __builtin_amdgcn_mfma_f32_32x32x16_bf16(f5, b1, acc[nt][1], 0, 0, 0);
        acc[nt][1] = __builtin_amdgcn_mfma_f32_32x32x16_bf16(f0, b2, acc[nt][1], 0, 0, 0);
        acc[nt][1] = __builtin_amdgcn_mfma_f32_32x32x16_bf16(f1, b3, acc[nt][1], 0, 0, 0);
      }
    }
    const bfr* gate = WSP(bfr, stage == 0 ? OFF_X1T : OFF_X2T) + ((size_t)(c * 8 + bh * 4 + bl)) * 4096;
    __syncthreads();
#pragma unroll
    for (int nt = 0; nt < 2; ++nt)
#pragma unroll
      for (int m = 0; m < 2; ++m)
#pragma unroll
        for (int g = 0; g < 4; ++g) {
          const int t = 64 * (16 * wave + 8 * nt + t1l) + 32 * m + 8 * g + 4 * hf;
          uint2 gw = *(const uint2*)(gate + t);
          float v0 = acc[nt][m][4 * g + 0] * __uint_as_float(gw.x << 16);
          float v1 = acc[nt][m][4 * g + 1] * __uint_as_float(gw.x & 0xffff0000u);
          float v2 = acc[nt][m][4 * g + 2] * __uint_as_float(gw.y << 16);
          float v3 = acc[nt][m][4 * g + 3] * __uint_as_float(gw.y & 0xffff0000u);
          uint2 o; o.x = pk2(v0, v1); o.y = pk2(v2, v3);
          *(uint2*)(Us + bl * USTR + t) = o;
        }
  }
  __syncthreads();
  for (int i = tid; i < 2048; i += 256) {
    int b4 = i >> 9, c16 = i & 511;
    *(uint4*)(WSP(bfr, OFF_HVT) + ((size_t)(c * 8 + bh * 4 + b4)) * 4096 + c16 * 8) = *(const uint4*)(Us + b4 * USTR + c16 * 8);
  }
}

__device__ __forceinline__ void attn_task(const Params& p, int l, int task, char* smemc) {
  const int tid = tidx(), lane = tid & 63, wave = tid >> 6, r = lane & 31, hf = lane >> 5;
  int b, h, q0, kbeg;
  size_t qrowbase;
  if (task < 1024) { b = task >> 7; h = (task >> 5) & 3; q0 = (task & 31) * 128; qrowbase = (size_t)b * 4096; kbeg = 0; }
  else { int tk = task - 1024; b = tk >> 3; h = (tk >> 1) & 3; q0 = (tk & 1) * 128; qrowbase = (size_t)NLAT + b * 256; kbeg = 4096; }
  bfr* Ks = (bfr*)smemc;
  bfr* Vs = Ks + 2 * 64 * 72;
  const bfr* pd = WSP(bfr, OFF_PDA);
  const bfr* vt = WSP(bfr, OFF_VT) + (size_t)((b * 4 + h) * 64) * 4352;
  const size_t qrow = qrowbase + q0 + wave * 32 + r;
  bf16x8 qf[2][2];
#pragma unroll
  for (int j = 0; j < 2; ++j)
#pragma unroll
    for (int s = 0; s < 2; ++s) qf[j][s] = *(const bf16x8*)(pd + qrow * 768 + h * 64 + j * 32 + 16 * s + 8 * hf);
  float mq = 0.f, mk = 0.f;
  for (int i = 0; i < 32; ++i) { mq = fmaxf(mq, fabsf(p.in[25][l * 32 + i])); mk = fmaxf(mk, fabsf(p.in[26][l * 32 + i])); }
  const float Mb = 5.6568542f * 1.03f * mq * mk * 1.44269504f;
  f32x16 O[2][2];
#pragma unroll
  for (int j = 0; j < 2; ++j)
#pragma unroll
    for (int d = 0; d < 2; ++d)
#pragma unroll
      for (int i = 0; i < 16; ++i) O[j][d][i] = 0.f;
  float ls[2] = {0.f, 0.f};
  const int nt = (4352 - kbeg) >> 6;
  const int lrow = tid >> 3, lpart = (tid & 7) * 8;
  uint4 rk0, rk1, rv0, rv1;
  auto kptr = [&](int k0, int rowi) -> const bfr* {
    int kidx = k0 + rowi;
    size_t krow = kidx < 4096 ? (size_t)b * 4096 + kidx : (size_t)NLAT + b * 256 + (kidx - 4096);
    return pd + krow * 768 + 256 + h * 64 + lpart;
  };
  rk0 = *(const uint4*)kptr(kbeg, lrow);
  rk1 = *(const uint4*)kptr(kbeg, lrow + 32);
  rv0 = *(const uint4*)(vt + (size_t)lrow * 4352 + kbeg + lpart);
  rv1 = *(const uint4*)(vt + (size_t)(lrow + 32) * 4352 + kbeg + lpart);
  __syncthreads();
  *(uint4*)(Ks + (lrow)*72 + lpart) = rk0;
  *(uint4*)(Ks + (lrow + 32) * 72 + lpart) = rk1;
  *(uint4*)(Vs + (lrow)*72 + lpart) = rv0;
  *(uint4*)(Vs + (lrow + 32) * 72 + lpart) = rv1;
  __syncthreads();
  for (int kt = 0; kt < nt; ++kt) {
    const int cur = kt & 1;
    if (kt + 1 < nt) {
      const int k0 = kbeg + (kt + 1) * 64;
      rk0 = *(const uint4*)kptr(k0, lrow);
      rk1 = *(const uint4*)kptr(k0, lrow + 32);
      rv0 = *(const uint4*)(vt + (size_t)lrow * 4352 + k0 + lpart);
      rv1 = *(const uint4*)(vt + (size_t)(lrow + 32) * 4352 + k0 + lpart);
    }
#pragma unroll
    for (int sub = 0; sub < 2; ++sub) {
      bf16x8 vf[2][2];
#pragma unroll
      for (int d = 0; d < 2; ++d)
#pragma unroll
        for (int s = 0; s < 2; ++s) vf[d][s] = *(const bf16x8*)(Vs + (cur * 64 + d * 32 + r) * 72 + sub * 32 + 16 * s + 8 * hf);
#pragma unroll
      for (int j = 0; j < 2; ++j) {
        bf16x8 kf0 = *(const bf16x8*)(Ks + (cur * 64 + sub * 32 + r) * 72 + j * 32 + 8 * hf);
        bf16x8 kf1 = *(const bf16x8*)(Ks + (cur * 64 + sub * 32 + r) * 72 + j * 32 + 16 + 8 * hf);
        f32x16 S;
#pragma unroll
        for (int i = 0; i < 16; ++i) S[i] = -Mb;
        __builtin_amdgcn_s_setprio(1);
        S = __builtin_amdgcn_mfma_f32_32x32x16_bf16(kf0, qf[j][0], S, 0, 0, 0);
        S = __builtin_amdgcn_mfma_f32_32x32x16_bf16(kf1, qf[j][1], S, 0, 0, 0);
        __builtin_amdgcn_s_setprio(0);
#pragma unroll
        for (int i = 0; i < 16; ++i) S[i] = __builtin_amdgcn_exp2f(S[i]);
        v2f ps2 = {0.f, 0.f};
#pragma unroll
        for (int i = 0; i < 8; ++i) ps2 += (v2f){S[2 * i], S[2 * i + 1]};
        ls[j] += ps2.x + ps2.y;
        unsigned pw[8];
#pragma unroll
        for (int i = 0; i < 8; ++i) pw[i] = pk2(S[2 * i], S[2 * i + 1]);
        bf16x8 pf0 = __builtin_bit_cast(bf16x8, (uint4){pw[0], pw[1], pw[2], pw[3]});
        bf16x8 pf1 = __builtin_bit_cast(bf16x8, (uint4){pw[4], pw[5], pw[6], pw[7]});
        __builtin_amdgcn_s_setprio(1);
#pragma unroll
        for (int d = 0; d < 2; ++d) {
          O[j][d] = __builtin_amdgcn_mfma_f32_32x32x16_bf16(vf[d][0], pf0, O[j][d], 0, 0, 0);
          O[j][d] = __builtin_amdgcn_mfma_f32_32x32x16_bf16(vf[d][1], pf1, O[j][d], 0, 0, 0);
        }
        __builtin_amdgcn_s_setprio(0);
      }
    }
    if (kt + 1 < nt) {
      const int nx = cur ^ 1;
      *(uint4*)(Ks + (nx * 64 + lrow) * 72 + lpart) = rk0;
      *(uint4*)(Ks + (nx * 64 + lrow + 32) * 72 + lpart) = rk1;
      *(uint4*)(Vs + (nx * 64 + lrow) * 72 + lpart) = rv0;
      *(uint4*)(Vs + (nx * 64 + lrow + 32) * 72 + lpart) = rv1;
    }
    __syncthreads();
  }
  ls[0] += __shfl_xor(ls[0], 32);
  ls[1] += __shfl_xor(ls[1], 32);
  const float* lp = p.in[27] + l * 128;
  float d01 = 0.f, d23 = 0.f;
  for (int i = 0; i < 32; ++i) { d01 += lp[i] * lp[32 + i]; d23 += lp[64 + i] * lp[96 + i]; }
  const float lam_init = 0.8f - 0.6f * expf(-0.3f * (float)l);
  const float lam = expf(d01) - expf(d23) + lam_init;
  const float i0 = 1.f / ls[0], i1 = lam / ls[1];
  float ss = 0.f;
#pragma unroll
  for (int d = 0; d < 2; ++d)
#pragma unroll
    for (int i = 0; i < 16; ++i) { float o = O[0][d][i] * i0 - O[1][d][i] * i1; O[0][d][i] = o; ss += o * o; }
  ss += __shfl_xor(ss, 32);
  const float rn = rsqrtf(ss * (1.f / 64.f) + 1e-6f) * (1.f - lam_init);
  const float* sw = p.in[28] + l * 64;
  bfr* op = WSP(bfr, OFF_HN) + qrow * 1024 + 768 + h * 64;
#pragma unroll
  for (int d = 0; d < 2; ++d)
#pragma unroll
    for (int g = 0; g < 4; ++g) {
      const int dv = d * 32 + 8 * g + 4 * hf;
      float4 w4 = *(const float4*)(sw + dv);
      uint2 o;
      o.x = pk2(O[0][d][4 * g + 0] * rn * w4.x, O[0][d][4 * g + 1] * rn * w4.y);
      o.y = pk2(O[0][d][4 * g + 2] * rn * w4.z, O[0][d][4 * g + 3] * rn * w4.w);
      *(uint2*)(op + dv) = o;
    }
}

__device__ __forceinline__ void finish_task(const Params& p, int l, int task  , char* smemc) {
  const int tid = tidx();
  if (task < 1024) {
    bfr* tile = (bfr*)smemc;
    const int row0 = task * 32, bb = row0 >> 12, t0 = row0 & 4095;
    const bfr* src = WSP(bfr, OFF_HVT) + ((size_t)(tid * 8 + bb)) * 4096 + t0;
#pragma unroll
    for (int i = 0; i < 4; ++i) *(uint4*)(tile + tid * 40 + 8 * i) = ((const uint4*)src)[i];
    __syncthreads();
    const int rr = tid >> 3, part = tid & 7;
    bfr* dst = WSP(bfr, OFF_HN) + (size_t)(row0 + rr) * 1024 + 256 + part * 32;
#pragma unroll
    for (int i = 0; i < 4; ++i) {
      unsigned w[4];
#pragma unroll
      for (int q = 0; q < 4; ++q) {
        const int c0 = part * 32 + i * 8 + q * 2;
        w[q] = (unsigned)tile[c0 * 40 + rr] | ((unsigned)tile[(c0 + 1) * 40 + rr] << 16);
      }
      ((uint4*)dst)[i] = (uint4){w[0], w[1], w[2], w[3]};
    }
    __syncthreads();
  }
  const int rr = tid >> 3, hd = tid & 7;
  const size_t row = (size_t)task * 32 + rr;
  const bfr *pf, *pb, *pgt;
  const float* nw;
  bfr* dst;
  if (hd < 4) {
    const bfr* r = WSP(bfr, OFF_PGDN) + row * 1024;
    pf = r + hd * 64; pb = r + 256 + hd * 64; pgt = r + 768 + hd * 64;
    nw = p.in[12] + l * 64; dst = WSP(bfr, OFF_HN) + row * 1024 + hd * 64;
  } else {
    const int hh = hd - 4;
    const bfr* r = WSP(bfr, OFF_PHG) + row * 1280;
    pf = r + 512 + hh * 64; pb = r + 768 + hh * 64; pgt = r + 1024 + hh * 64;
    nw = p.in[24] + l * 64; dst = WSP(bfr, OFF_HN) + row * 1024 + 512 + hh * 64;
  }
  uint4 vf[8], vb[8], vg[8];
#pragma unroll
  for (int i = 0; i < 8; ++i) { vf[i] = ((const uint4*)pf)[i]; vb[i] = ((const uint4*)pb)[i]; vg[i] = ((const uint4*)pgt)[i]; }
  float o[64];
  float ss = 0.f;
#pragma unroll
  for (int i = 0; i < 8; ++i) {
    const unsigned a[4] = {vf[i].x, vf[i].y, vf[i].z, vf[i].w};
    const unsigned c[4] = {vb[i].x, vb[i].y, vb[i].z, vb[i].w};
#pragma unroll
    for (int q = 0; q < 4; ++q) {
      float lo = __uint_as_float(a[q] << 16) + __uint_as_float(c[q] << 16);
      float hi = __uint_as_float(a[q] & 0xffff0000u) + __uint_as_float(c[q] & 0xffff0000u);
      o[8 * i + 2 * q] = lo; o[8 * i + 2 * q + 1] = hi;
      ss += lo * lo + hi * hi;
    }
  }
  const float rn = rsqrtf(ss * (1.f / 64.f) + 1e-6f);
#pragma unroll
  for (int i = 0; i < 8; ++i) {
    const unsigned g[4] = {vg[i].x, vg[i].y, vg[i].z, vg[i].w};
    unsigned w[4];
#pragma unroll
    for (int q = 0; q < 4; ++q) {
      float g0 = __uint_as_float(g[q] << 16), g1 = __uint_as_float(g[q] & 0xffff0000u);
      float y0 = o[8 * i + 2 * q] * rn * nw[8 * i + 2 * q] * siluf_(g0);
      float y1 = o[8 * i + 2 * q + 1] * rn * nw[8 * i + 2 * q + 1] * siluf_(g1);
      w[q] = pk2(y0, y1);
    }
    ((uint4*)dst)[i] = (uint4){w[0], w[1], w[2], w[3]};
  }
}

__global__ void __launch_bounds__(256, 2) mega(Params p) {
  extern __shared__ __attribute__((aligned(1024))) char smemc[];
  __shared__ int s_task;
  float* smem = (float*)smemc;
  cg::grid_group grid = cg::this_grid();
  unsigned* ctr = WSP(unsigned, OFF_CTR);
  const int G = gridDim.x, bid = blockIdx.x;

  __shared__ uint4 xb_words;
  if (threadIdx.x == 0) xb_words = make_uint4(0u, 0u, 0u, 0u);
  __syncthreads();
  XcdBarrier xb = xcd_barrier_post(WSP(unsigned, OFF_CTR) + 1024, (volatile LAS unsigned*)&xb_words);
  phase_mod(p, smem);
  for (int task = G - 1 - bid; task < 272; task += G) { int l0 = 0; asm volatile("" : "+s"(l0)); filt_task(p, l0, task, smem); }
  grid.sync();

  for (int l = 0; l < 4; ++l) {
    const bool want_ctx = l < 3;
    for (int task = bid; task < 3296 + 1088; task += G) {
      int lq = l; asm volatile("" : "+s"(lq));
      if (task < 3296) wconv_tile(p, lq, task, smem);
      else norm_rows(p, lq, 0, task - 3296);
    }
    xcd_barrier(xb);
    { int lq = l; asm volatile("" : "+s"(lq));
    gemm_phase<0>(p, lq, WSP(bfr, OFF_HN), 1024, WSP(bfr, OFF_WIN), 1024, 136, 31, smemc); }
    xcd_barrier(xb);
    for (int task = bid; task < 1088 + 2176; task += G) {
      int lq = l; asm volatile("" : "+s"(lq));
      if (task < 2176) gdn_solve_task(p, lq, task, smemc);
      else prep_task(p, lq, task - 2176, smemc);
    }
    xcd_barrier(xb);
    {
      const int nhy = want_ctx ? 640 : 512, nat = want_ctx ? 1088 : 1024;
      const int nflt = want_ctx ? 272 : 0;
      const int total = 128 + nhy + nat + nflt;
      while (true) {
        __syncthreads();
        if (threadIdx.x == 0) s_task = (int)atomicAdd(&ctr[l * 2], 1u);
        __syncthreads();
        int task = s_task;
        if (task >= total) break;
        int lq = l; asm volatile("" : "+s"(lq));
        if (task < 64) gdn_chunked(p, lq, task, smemc);
        else if (task < 128) hgrn_chunked(p, lq, task - 64, smemc);
        else if (task < 128 + 512) hy_task(p, lq, task - 128, smemc);
        else if (task < 128 + nhy) hy_conv(p, lq, 0, task - 640);
        else if (task < 128 + nhy + nat) attn_task(p, lq, task - 128 - nhy, smemc);
        else filt_task(p, lq + 1, task - 128 - nhy - nat, smem);
      }
    }
    xcd_barrier(xb);
    {
      const int nhy = want_ctx ? 128 : 0, nfin = want_ctx ? 1088 : 1024;
      const int total = nhy + nfin;
      while (true) {
        __syncthreads();
        if (threadIdx.x == 0) s_task = (int)atomicAdd(&ctr[l * 2 + 1], 1u);
        __syncthreads();
        int task = s_task;
        if (task >= total) break;
        int lq = l; asm volatile("" : "+s"(lq));
        if (task < nhy) hy_conv(p, lq, 1, task);
        else finish_task(p, lq, task - nhy, smemc);
      }
    }
    xcd_barrier(xb);
    const int mt = want_ctx ? 136 : 128;
    { int lq = l; asm volatile("" : "+s"(lq));
    gemm_phase<1>(p, lq, WSP(bfr, OFF_HN), 1024, WSP(bfr, OFF_WOUT), 1024, mt, 8, smemc); }
    xcd_barrier(xb);
    for (int task = bid; task < mt * 8; task += G) { int lq = l; asm volatile("" : "+s"(lq)); norm_rows(p, lq, 1, task); }
    xcd_barrier(xb);
    { int lq = l; asm volatile("" : "+s"(lq));
    gemm_phase<2>(p, lq, WSP(bfr, OFF_HN), 1024, WSP(bfr, OFF_W1), 1024, mt, 32, smemc); }
    xcd_barrier(xb);
    { int lq = l; asm volatile("" : "+s"(lq));
    gemm_phase<3>(p, lq, WSP(bfr, OFF_HID), 4096, WSP(bfr, OFF_W2), 4096, mt, 8, smemc); }
    if (l < 3) xcd_barrier(xb);
  }
}

extern "C" void kernel_launch(void* const* d_in, const int* in_sizes, int n_in, void* d_out, int out_size, void* d_ws, size_t ws_size,
                              hipStream_t stream) {
  static int grid_blocks = 0;
  if (!grid_blocks) {
    int dev = 0, cus = 0, per_cu = 0;
    hipGetDevice(&dev);
    hipDeviceGetAttribute(&cus, hipDeviceAttributeMultiprocessorCount, dev);
    (void)hipFuncSetAttribute((const void*)mega, hipFuncAttributeMaxDynamicSharedMemorySize, LDS_BYTES);
    hipOccupancyMaxActiveBlocksPerMultiprocessor(&per_cu, mega, 256, LDS_BYTES);
    if (per_cu < 1) per_cu = 1;
    if (per_cu > 2) per_cu = 2;
    grid_blocks = cus * per_cu;
    if (ws_size < WS_NEED) fprintf(stderr, "kernel_launch: workspace too small: %zu < %zu\n", ws_size, (size_t)WS_NEED);
  }
  Params p{};
  for (int i = 0; i < 32; ++i) p.in[i] = (const float*)d_in[i];
  p.out = (float*)d_out;
  p.ws = (unsigned char*)d_ws;
  hipMemsetAsync(d_ws, 0, 32768, stream);
  void* args[] = {&p};
  hipError_t e = hipLaunchCooperativeKernel((void*)mega, dim3(grid_blocks), dim3(256), args, LDS_BYTES, stream);
  if (e != hipSuccess) fprintf(stderr, "cooperative launch failed: %s (grid %d)\n", hipGetErrorString(e), grid_blocks);
}
```

```cpp
#include <hip/hip_runtime.h>
#include <hip/hip_bf16.h>
#include <hip/hip_cooperative_groups.h>
#include <cstdio>
#include <cstdint>
namespace cg = cooperative_groups;

typedef unsigned short bfr;
using bf16x8 = __attribute__((ext_vector_type(8))) short;
using f32x4 = __attribute__((ext_vector_type(4))) float;

#define NLAT 32768
#define NCTX 2048
#define NTOK 34816
#define MIB ((size_t)1 << 20)
#define OFF_CTR 0
#define OFF_MOD (1 * MIB)
#define OFF_LB (OFF_MOD + 884736)
#define OFF_ROPE (OFF_LB + 4096)
#define OFF_XC (2 * MIB)
#define OFF_WIN (10 * MIB)
#define OFF_WOUT (OFF_WIN + 8126464)
#define OFF_W1 (OFF_WOUT + 2 * MIB)
#define OFF_W2 (OFF_W1 + 8 * MIB)
#define OFF_HN (36 * MIB)
#define OFF_AB (104 * MIB)
#define OFF_PGDN (107 * MIB)
#define OFF_PHY (175 * MIB)
#define OFF_PHG (226 * MIB)
#define OFF_PDA (311 * MIB)
#define OFF_GQ (362 * MIB)
#define OFF_HVT (413 * MIB)
#define OFF_HVC (429 * MIB)
#define OFF_X1T (430 * MIB)
#define OFF_HZC (446 * MIB)
#define OFF_RF (447 * MIB)
#define OFF_GFC (463 * MIB)
#define OFF_VT (464 * MIB)
#define OFF_X2T (482 * MIB)
#define OFF_SLAB (379 * MIB)
#define OFF_HID OFF_PGDN
#define OFF_GFC2 (498 * MIB)
#define WS_NEED (499 * MIB)
#define LDS_BYTES 73728

struct Params {
  const float* in[32];
  float* out;
  unsigned char* ws;
};

__device__ __forceinline__ float bf2f(bfr v) { return __uint_as_float(((unsigned)v) << 16); }
typedef __attribute__((ext_vector_type(2))) __bf16 bf2v_t;
typedef __attribute__((ext_vector_type(2))) float f2v_t;
using f32x16 = __attribute__((ext_vector_type(16))) float;
__device__ __forceinline__ unsigned pk2(float lo, float hi) {
  f2v_t f = {lo, hi};
  return __builtin_bit_cast(unsigned, __builtin_convertvector(f, bf2v_t));
}
__device__ __forceinline__ bfr f2bf(float f) { return (bfr)(pk2(f, 0.f) & 0xffffu); }
__device__ __forceinline__ float sigmoidf_(float x) { return 1.f / (1.f + expf(-x)); }
__device__ __forceinline__ float siluf_(float x) { return x / (1.f + expf(-x)); }
__device__ __forceinline__ float fsigmoid(float x) { return __builtin_amdgcn_rcpf(1.f + __expf(-x)); }
__device__ __forceinline__ float wave_sum(float v) {
#pragma unroll
  for (int o = 32; o >= 1; o >>= 1) v += __shfl_xor(v, o);
  return v;
}
__device__ __forceinline__ float quad_sum(float v) {
  v += __int_as_float(__builtin_amdgcn_mov_dpp(__float_as_int(v), 0xB1, 0xF, 0xF, true));
  v += __int_as_float(__builtin_amdgcn_mov_dpp(__float_as_int(v), 0x4E, 0xF, 0xF, true));
  return v;
}
typedef float v2f __attribute__((ext_vector_type(2)));

__device__ __forceinline__ int tidx() { int t = threadIdx.x; asm volatile("" : "+v"(t)); return t; }
#define WSP(T, off) ((T*)(p.ws + (off)))


#define XB_TMO      128
#define XB_XCNT(j)  (256  + 64 * (j))
#define XB_XSUB(j)  (1280 + 64 * (j))
#define XB_XGEN(j)  (2304 + 64 * (j))
#define XB_TOP      3328
#define XB_TOPGEN   3392
#define XCD_BAR_WORDS 3456
#define XB_SPIN_CAP (1u << 24)
#define LAS __attribute__((address_space(3)))
__device__ __forceinline__ unsigned xb_ld(unsigned* p) { return __hip_atomic_load(p, __ATOMIC_RELAXED, __HIP_MEMORY_SCOPE_AGENT); }
__device__ __forceinline__ unsigned xb_add(unsigned* p, unsigned v) { return __hip_atomic_fetch_add(p, v, __ATOMIC_RELAXED, __HIP_MEMORY_SCOPE_AGENT); }
__device__ __forceinline__ unsigned xb_xcc_id() { return (unsigned)__builtin_amdgcn_s_getreg((3 << 11) | 20) & 0xFu; }
#define XB_SPIN(cond, bar) do { unsigned _sp = 0; while (cond) { __builtin_amdgcn_s_sleep(1); \
    if ((++_sp & 255u) == 0u) { if (xb_ld(&(bar)[XB_TMO])) break; if (_sp > XB_SPIN_CAP) { atomicAdd(&(bar)[XB_TMO], 1u); break; } } } } while (0)
struct XcdBarrier { unsigned* bar; unsigned x; volatile LAS unsigned* st; };
__device__ __forceinline__ XcdBarrier xcd_barrier_post(unsigned* bar, volatile LAS unsigned* st) {
  XcdBarrier b; b.bar = bar; b.x = xb_xcc_id(); b.st = st;
  if (threadIdx.x == 0) (void)xb_add(&bar[XB_XCNT(b.x)], 1u);
  return b;
}
__device__ __forceinline__ void xcd_barrier_complete(unsigned* bar, unsigned x, unsigned& nloc, unsigned& nx) {
  const unsigned G = gridDim.x * gridDim.y * gridDim.z;
  unsigned sum, cnt, mine, sp = 0u;
  for (;;) {
    sum = 0u; cnt = 0u; mine = 0u;
#pragma unroll
    for (unsigned j = 0; j < 16; ++j) { const unsigned c = xb_ld(&bar[XB_XCNT(j)]); sum += c; cnt += (c > 0u) ? 1u : 0u; mine = (j == x) ? c : mine; }
    if (sum == G) break;
    __builtin_amdgcn_s_sleep(1);
    if ((++sp & 255u) == 0u) { if (xb_ld(&bar[XB_TMO])) break; if (sp > XB_SPIN_CAP) { atomicAdd(&bar[XB_TMO], 1u); break; } }
  }
  nloc = mine > 0u ? mine : 1u; nx = cnt > 0u ? cnt : 1u;
}
__device__ __forceinline__ void xcd_barrier(const XcdBarrier& b) {
  asm volatile("s_waitcnt vmcnt(0)" ::: "memory");
  __syncthreads();
  if (threadIdx.x == 0) {
    unsigned* bar = b.bar;
    __builtin_amdgcn_s_waitcnt(0);
    unsigned nloc = b.st[0], nx = b.st[1];
    if (nloc == 0u) { xcd_barrier_complete(bar, b.x, nloc, nx); b.st[0] = nloc; b.st[1] = nx; }
    const unsigned old = xb_add(&bar[XB_XSUB(b.x)], 1u);
    const unsigned gen = old / nloc;
    if (old + 1u == (gen + 1u) * nloc) {
      __builtin_amdgcn_fence(__ATOMIC_RELEASE, "agent");
      asm volatile("s_waitcnt vmcnt(0)" ::: "memory");
      const unsigned og = xb_add(&bar[XB_TOP], 1u);
      const unsigned tg = og / nx;
      if (og + 1u == (tg + 1u) * nx) xb_add(&bar[XB_TOPGEN], 1u);
      else XB_SPIN(xb_ld(&bar[XB_TOPGEN]) == tg, bar);
      __builtin_amdgcn_fence(__ATOMIC_ACQUIRE, "agent");
      xb_add(&bar[XB_XGEN(b.x)], 1u);
      asm volatile("s_waitcnt vmcnt(0)" ::: "memory");
    } else {
      XB_SPIN(xb_ld(&bar[XB_XGEN(b.x)]) == gen, bar);
      __builtin_amdgcn_fence(__ATOMIC_ACQUIRE, "agent");
      asm volatile("s_waitcnt vmcnt(0)" ::: "memory");
    }
  }
  __syncthreads();
}

__device__ __forceinline__ void phase_mod(const Params& p, float* smem) {
  const int tid = tidx();
  float* sc = smem;
  float* red = smem + 9 * 1024;
  float* mod = WSP(float, OFF_MOD);
  bool loaded = false;
  for (int task = blockIdx.x; task < 4 * 96; task += gridDim.x) {
    if (!loaded) {
      for (int i = tid; i < 9 * 1024; i += 256) {
        int m = i >> 10, k = i & 1023;
        float v = m < 8 ? p.in[1][m * 1024 + k] : p.in[3][k];
        sc[i] = siluf_(v);
      }
      __syncthreads();
      loaded = true;
    }
    int l = task / 96, cgp = task % 96;
    int col = cgp * 64 + (tid & 63), ks = tid >> 6;
    const float* w = p.in[4] + (size_t)l * 1024 * 6144 + col;
    float acc[9];
#pragma unroll
    for (int m = 0; m < 9; ++m) acc[m] = 0.f;
#pragma unroll 8
    for (int k = ks * 256; k < ks * 256 + 256; ++k) {
      float wv = w[(size_t)k * 6144];
#pragma unroll
      for (int m = 0; m < 9; ++m) acc[m] += sc[m * 1024 + k] * wv;
    }
#pragma unroll
    for (int m = 0; m < 9; ++m) red[(ks * 9 + m) * 64 + (tid & 63)] = acc[m];
    __syncthreads();
    if (tid < 64) {
#pragma unroll
      for (int m = 0; m < 9; ++m) {
        float s = red[(0 * 9 + m) * 64 + tid] + red[(1 * 9 + m) * 64 + tid] + red[(2 * 9 + m) * 64 + tid] + red[(3 * 9 + m) * 64 + tid];
        mod[(size_t)(l * 9 + m) * 6144 + col] = s + p.in[5][l * 6144 + col];
      }
    }
    __syncthreads();
  }
  if (blockIdx.x == gridDim.x - 2) {
    float* rope = WSP(float, OFF_ROPE);
    for (int e = tid; e < 512; e += 256) {
      const int pos = e >> 3, i = e & 7;
      const float inv = powf(10000.f, -(float)i / 8.f);
      float sn, cs;
      sincosf((float)pos * inv, &sn, &cs);
      rope[pos * 16 + i] = cs;
      rope[pos * 16 + 8 + i] = sn;
    }
  }
  if (blockIdx.x == gridDim.x - 1) {
    int c = tid;
    const float* raw = p.in[23];
    float r0 = raw[c], r1 = raw[256 + c], r2 = raw[512 + c], r3 = raw[768 + c];
    float mx = fmaxf(fmaxf(r0, r1), fmaxf(r2, r3));
    float e0 = expf(r0 - mx), e1 = expf(r1 - mx), e2 = expf(r2 - mx), e3 = expf(r3 - mx);
    float inv = 1.f / (e0 + e1 + e2 + e3);
    float* lb = WSP(float, OFF_LB);
    lb[c] = 0.f;
    lb[256 + c] = e1 * inv;
    lb[512 + c] = (e1 + e2) * inv;
    lb[768 + c] = (e1 + e2 + e3) * inv;
  }
}

__device__ __forceinline__ const float* xin_row(const Params& p, int l, int row) {
  if (row < NLAT) return (l == 0 ? p.in[0] : (const float*)p.out) + (size_t)row * 1024;
  return (l == 0 ? p.in[2] : (const float*)WSP(float, OFF_XC)) + (size_t)(row - NLAT) * 1024;
}
__device__ __forceinline__ float* xout_row(const Params& p, int row) {
  if (row < NLAT) return p.out + (size_t)row * 1024;
  return WSP(float, OFF_XC) + (size_t)(row - NLAT) * 1024;
}
__device__ __forceinline__ int mod_idx(int row) { return row < NLAT ? (row >> 12) : 8; }

__device__ __forceinline__ void norm_rows(const Params& p, int l, int which, int task  ) {
  const int tid = tidx(), lane = tid & 63, wave = tid >> 6;
  const float* lnw = p.in[which == 0 ? 6 : 7] + l * 1024;
  bfr* hn = WSP(bfr, OFF_HN);
  const int row0 = task * 32;
  const float* mv = WSP(float, OFF_MOD) + (size_t)(l * 9 + mod_idx(row0)) * 6144 + (which == 0 ? 0 : 3072);
  const bool fold = (which == 0) && (l >= 1) && (row0 >= NLAT);
  {
    constexpr int g = 0;
    float4 v[8][4];
#pragma unroll
    for (int j = 0; j < 8; ++j) {
      const int row = row0 + wave + 4 * (g * 4 + j);
      const float* xr = which == 0 ? xin_row(p, l, row) : (const float*)xout_row(p, row);
#pragma unroll
      for (int i = 0; i < 4; ++i) v[j][i] = ((const float4*)xr)[lane + 64 * i];
    }
    if (fold) {
#pragma unroll
      for (int j = 0; j < 8; ++j) {
        const int row = row0 + wave + 4 * (g * 4 + j), rc = row - NLAT;
#pragma unroll
        for (int i = 0; i < 4; ++i) {
          const int col = 4 * (lane + 64 * i);
          const float* sl = WSP(float, OFF_SLAB) + (size_t)(((rc >> 8) * 8 + (col >> 7)) * 8) * 32768 + (size_t)(rc & 255) * 128 + (col & 127);
          float4 sm = *(const float4*)sl;
#pragma unroll
          for (int ks = 1; ks < 8; ++ks) { const float4 t = *(const float4*)(sl + (size_t)ks * 32768); sm.x += t.x; sm.y += t.y; sm.z += t.z; sm.w += t.w; }
          const float4 g4 = *(const float4*)(WSP(float, OFF_MOD) + (size_t)((l - 1) * 9 + 8) * 6144 + 5120 + col);
          v[j][i].x += g4.x * sm.x; v[j][i].y += g4.y * sm.y; v[j][i].z += g4.z * sm.z; v[j][i].w += g4.w * sm.w;
          ((float4*)xout_row(p, row))[lane + 64 * i] = v[j][i];
        }
      }
    }
    float rj[8];
#pragma unroll
    for (int j = 0; j < 8; ++j) {
      float ss = 0.f;
#pragma unroll
      for (int i = 0; i < 4; ++i) ss += v[j][i].x * v[j][i].x + v[j][i].y * v[j][i].y + v[j][i].z * v[j][i].z + v[j][i].w * v[j][i].w;
      ss = wave_sum(ss);
      rj[j] = rsqrtf(ss * (1.f / 1024.f) + 1e-6f);
    }
#pragma unroll
    for (int i = 0; i < 4; ++i) {
      const int c = 4 * (lane + 64 * i);
      const float4 w = *(const float4*)(lnw + c);
      const float4 sh = *(const float4*)(mv + c);
      const float4 sc = *(const float4*)(mv + 1024 + c);
      const float m0 = w.x * (1.f + sc.x), m1 = w.y * (1.f + sc.y), m2 = w.z * (1.f + sc.z), m3 = w.w * (1.f + sc.w);
#pragma unroll
      for (int j = 0; j < 8; ++j) {
        const int row = row0 + wave + 4 * (g * 4 + j);
        const float r = rj[j];
        ushort4 o;
        o.x = f2bf(v[j][i].x * r * m0 + sh.x);
        o.y = f2bf(v[j][i].y * r * m1 + sh.y);
        o.z = f2bf(v[j][i].z * r * m2 + sh.z);
        o.w = f2bf(v[j][i].w * r * m3 + sh.w);
        *(ushort4*)(hn + (size_t)row * 1024 + c) = o;
      }
    }
  }
}

struct WcTile { const float* src; bfr* dst; int K, N, kt, nt, mode; };
__device__ __forceinline__ WcTile wc_decode(const Params& p, int l, int task) {
  WcTile w; w.mode = 0;
  if (task < 992) { w.src = p.in[8] + (size_t)l * 1024 * 3856; w.dst = WSP(bfr, OFF_WIN); w.K = 1024; w.N = 3856; w.kt = task / 62; w.nt = task % 62; w.mode = 1; }
  else if (task < 992 + 256) { int t = task - 992; w.src = p.in[29] + (size_t)l * 1024 * 1024; w.dst = WSP(bfr, OFF_WOUT); w.K = 1024; w.N = 1024; w.kt = t / 16; w.nt = t % 16; }
  else if (task < 992 + 256 + 1024) { int t = task - 1248; w.src = p.in[30] + (size_t)l * 1024 * 4096; w.dst = WSP(bfr, OFF_W1); w.K = 1024; w.N = 4096; w.kt = t / 64; w.nt = t % 64; }
  else { int t = task - 2272; w.src = p.in[31] + (size_t)l * 4096 * 1024; w.dst = WSP(bfr, OFF_W2); w.K = 4096; w.N = 1024; w.kt = t / 16; w.nt = t % 16; }
  return w;
}
__device__ __forceinline__ void wconv_pair(const Params& p, int l, int ta, int tb, float* smem) {
  const int tid = tidx();
  const WcTile A = wc_decode(p, l, ta);
  const WcTile B = wc_decode(p, l, tb >= 0 ? tb : ta);
  const bool hasb = tb >= 0;
  float* tileA = smem;
  float* tileB = smem + 64 * 65;
  const int nl = tid & 63, k0 = tid >> 6;
  float va[16], vb[16];
  {
    const int npa = A.nt * 64 + nl, npb = B.nt * 64 + nl;
    int sca = npa, scb = npb;
    if (A.mode == 1) sca = npa < 1024 ? npa : (npa < 3840 ? npa + 16 : (npa < 3856 ? npa - 3840 + 1024 : -1));
    if (B.mode == 1) scb = npb < 1024 ? npb : (npb < 3840 ? npb + 16 : (npb < 3856 ? npb - 3840 + 1024 : -1));
#pragma unroll
    for (int i = 0; i < 16; ++i) va[i] = sca >= 0 ? A.src[(size_t)(A.kt * 64 + k0 + 4 * i) * A.N + sca] : 0.f;
#pragma unroll
    for (int i = 0; i < 16; ++i) vb[i] = (hasb && scb >= 0) ? B.src[(size_t)(B.kt * 64 + k0 + 4 * i) * B.N + scb] : 0.f;
#pragma unroll
    for (int i = 0; i < 16; ++i) { tileA[(k0 + 4 * i) * 65 + nl] = va[i]; tileB[(k0 + 4 * i) * 65 + nl] = vb[i]; }
  }
  __syncthreads();
  {
    const int kl = tid & 63;
#pragma unroll
    for (int i = 0; i < 16; ++i) {
      const int n2 = (tid >> 6) + 4 * i;
      A.dst[(size_t)(A.nt * 64 + n2) * A.K + A.kt * 64 + kl] = f2bf(tileA[kl * 65 + n2]);
    }
    if (hasb) {
#pragma unroll
      for (int i = 0; i < 16; ++i) {
        const int n2 = (tid >> 6) + 4 * i;
        B.dst[(size_t)(B.nt * 64 + n2) * B.K + B.kt * 64 + kl] = f2bf(tileB[kl * 65 + n2]);
      }
    }
  }
  __syncthreads();
}

__device__ __forceinline__ void filt_task(const Params& p, int l, int task, float* smem) {
  const int tid = tidx();
  int n, pos0;
  float* G;
  if (task < 256) { n = 4096; pos0 = task * 16; G = nullptr; }
  else { n = 256; pos0 = (task - 256) * 16; G = (l & 1) ? WSP(float, OFF_GFC2) : WSP(float, OFF_GFC); }
  float* zs = smem;
  float* h1s = smem + 16 * 36;
  float* h2t = h1s + 16 * 64;
  const float* w1 = p.in[14] + l * 33 * 64;
  const float* b1 = p.in[15] + l * 64;
  const float* f1 = p.in[16] + l * 64;
  const float* w2 = p.in[17] + l * 64 * 64;
  const float* b2 = p.in[18] + l * 64;
  const float* f2 = p.in[19] + l * 64;
  const float* w3 = p.in[20] + (size_t)l * 64 * 1024;
  const float* dec = p.in[21] + l * 512;
  const float* skp = p.in[22] + l * 512;
  const float inv_nm1 = (n == 4096) ? (1.f / 4095.f) : (1.f / 255.f);
  const float twopi_n = (n == 4096) ? (6.283185307179586f / 4096.f) : (6.283185307179586f / 256.f);
  for (int i = tid; i < 16 * 33; i += 256) {
    int pp = i / 33, e = i % 33;
    float pos = (float)(pos0 + pp);
    float zv;
    if (e == 0) zv = pos * inv_nm1;
    else {
      int bi = (e - 1) & 15;
      float band = 1e-4f + (float)bi * ((15.f - 1e-4f) / 15.f);
      float ang = twopi_n * pos * band;
      zv = (e <= 16) ? cosf(ang) : -sinf(ang);
    }
    zs[pp * 36 + e] = zv;
  }
  __syncthreads();
  for (int i = tid; i < 16 * 64; i += 256) {
    int pp = i >> 6, j = i & 63;
    float a = b1[j];
    for (int e = 0; e < 33; ++e) a += zs[pp * 36 + e] * w1[e * 64 + j];
    h1s[pp * 64 + j] = sinf(f1[j] * a);
  }
  __syncthreads();
  for (int i = tid; i < 16 * 64; i += 256) {
    int pp = i >> 6, j = i & 63;
    float a = b2[j];
    for (int k = 0; k < 64; ++k) a += h1s[pp * 64 + k] * w2[k * 64 + j];
    h2t[j * 16 + pp] = sinf(f2[j] * a);
  }
  __syncthreads();
#pragma unroll 1
  for (int jj = 0; jj < 4; ++jj) {
    int col = tid + 256 * jj;
    float acc[16];
#pragma unroll
    for (int i = 0; i < 16; ++i) acc[i] = 0.f;
#pragma unroll 8
    for (int k = 0; k < 64; ++k) {
      float wv = w3[k * 1024 + col];
      const float4* h4 = (const float4*)(h2t + k * 16);
#pragma unroll
      for (int q = 0; q < 4; ++q) {
        float4 hv = h4[q];
        acc[4 * q + 0] += hv.x * wv; acc[4 * q + 1] += hv.y * wv; acc[4 * q + 2] += hv.z * wv; acc[4 * q + 3] += hv.w * wv;
      }
    }
    int side = col >> 9, f = (col >> 8) & 1, ch = col & 255;
    float dc = fabsf(dec[f * 256 + ch]);
    if (G) {
      float* Gf = G + (size_t)f * (2 * n - 1) * 256;
#pragma unroll
      for (int i = 0; i < 16; ++i) {
        int pos = pos0 + i;
        float val = acc[i] * expf(-(float)pos * inv_nm1 * dc);
        if (side == 0) {
          if (pos == 0) val += skp[f * 256 + ch];
          Gf[(size_t)(pos + n - 1) * 256 + ch] = val;
        } else if (pos >= 1) {
          Gf[(size_t)(n - 1 - pos) * 256 + ch] = val;
        }
      }
    } else {
      bfr* R = WSP(bfr, OFF_RF) + (size_t)(l & 1) * (4 * MIB) + ((size_t)(f * 256 + ch)) * 8192;
#pragma unroll
      for (int i = 0; i < 16; ++i) {
        int pos = pos0 + i;
        float val = acc[i] * expf(-(float)pos * inv_nm1 * dc);
        if (side == 0) {
          if (pos == 0) { val += skp[f * 256 + ch]; R[0] = 0; }
          R[4096 - pos] = f2bf(val);
        } else if (pos >= 1) {
          R[4096 + pos] = f2bf(val);
        }
      }
    }
  }
  __syncthreads();
}

template <bool RELU2>
__device__ __forceinline__ void store_tile_bf16(const f32x4 (&acc)[8][4], bfr* dst, int ld, int row_base, int col_base, bfr* wbuf, int lane) {
  const int fr = lane & 15, fq = lane >> 4;
#pragma unroll
  for (int pass = 0; pass < 2; ++pass) {
#pragma unroll
    for (int mm = 0; mm < 4; ++mm)
#pragma unroll
      for (int n = 0; n < 4; ++n) {
        f32x4 a = acc[4 * pass + mm][n];
        if (RELU2) {
          a[0] = fmaxf(a[0], 0.f); a[1] = fmaxf(a[1], 0.f); a[2] = fmaxf(a[2], 0.f); a[3] = fmaxf(a[3], 0.f);
          a[0] *= a[0]; a[1] *= a[1]; a[2] *= a[2]; a[3] *= a[3];
        }
        uint2 o; o.x = pk2(a[0], a[1]); o.y = pk2(a[2], a[3]);
        *(uint2*)(wbuf + (mm * 16 + fr) * 72 + n * 16 + fq * 4) = o;
      }
#pragma unroll
    for (int q = 0; q < 8; ++q) {
      const int chunk = lane + 64 * q, rowl = chunk >> 3, c16 = chunk & 7;
      const uint4 v = *(const uint4*)(wbuf + rowl * 72 + c16 * 8);
      *(uint4*)(dst + (size_t)(row_base + pass * 64 + rowl) * ld + col_base + c16 * 8) = v;
    }
  }
}

template <int EPI>
__device__ __forceinline__ void gemm_phase(const Params& p, int l, const bfr* A, int lda, const bfr* Bt, int K, int Mtiles, int Ntiles, char* smemc) {
  bfr* sA = (bfr*)smemc;
  bfr* sB = sA + 2 * 256 * 40;
  const int tid = tidx(), wave = __builtin_amdgcn_readfirstlane(tid >> 6), lane = tid & 63;
  const int wr = wave >> 1, wc = wave & 1, fr = lane & 15, fq = lane >> 4;
  const int ntiles = Mtiles * Ntiles;
  const int nk = K / 32;
  const int gsb = lane * 16, gsw = gsb ^ (((gsb >> 9) & 1) << 5);
  const int grl = gsw >> 6, gcl = (gsw & 63) >> 1;
  const int flo = (fr * 64 + fq * 16) ^ ((fr >> 3) << 5);
  const int xcd = blockIdx.x & 7, xidx = blockIdx.x >> 3, xnb = gridDim.x >> 3;
  const int SN = (Ntiles + 7) >> 3, nsup = (Mtiles >> 3) * SN;
  (void)ntiles;
  const int qper = (64 + xnb - 1) / xnb;
  const bool splitctx = (EPI == 3) && (Mtiles == 136);
  const int nsupm = splitctx ? 16 * SN : nsup;
  const int nmain = ((nsupm + 7) >> 3) * qper;
  const int nextra = splitctx ? (512 + (int)gridDim.x - 1) / (int)gridDim.x : 0;
  for (int it = 0; it < nmain + nextra; ++it) {
    int tm, tn, kt0 = 0, nkk = nk, item = -1;
    if (it < nmain) {
      const int sup = xcd + 8 * (it / qper), q = xidx + xnb * (it % qper);
      if (sup >= nsupm || q >= 64) continue;
      tm = (sup / SN) * 8 + (q >> 3); tn = (sup % SN) * 8 + (q & 7);
      if (tn >= Ntiles) continue;
    } else {
      item = blockIdx.x + gridDim.x * (it - nmain);
      if (item >= 512) continue;
      const int tl = item >> 3;
      tm = 128 + (tl >> 3); tn = tl & 7; nkk = nk >> 3; kt0 = (item & 7) * nkk;
    }
    const bfr* Ab = A + (size_t)tm * 256 * lda + (size_t)(wave * 16 + grl) * lda + gcl + kt0 * 32;
    const bfr* Bb = Bt + (size_t)tn * 128 * K + (size_t)(wave * 16 + grl) * K + gcl + kt0 * 32;
    f32x4 acc[8][4];
#pragma unroll
    for (int m = 0; m < 8; ++m)
#pragma unroll
      for (int n = 0; n < 4; ++n) acc[m][n] = (f32x4){0.f, 0.f, 0.f, 0.f};
#define GLDS_STAGE(BUF, K0) { char* la = smemc + (BUF) * 24576 + wave * 1024; \
      __builtin_amdgcn_global_load_lds((const unsigned*)(Ab + (K0)), (unsigned*)(la), 16, 0, 0); \
      __builtin_amdgcn_global_load_lds((const unsigned*)(Ab + (size_t)64 * lda + (K0)), (unsigned*)(la + 4096), 16, 0, 0); \
      __builtin_amdgcn_global_load_lds((const unsigned*)(Ab + (size_t)128 * lda + (K0)), (unsigned*)(la + 8192), 16, 0, 0); \
      __builtin_amdgcn_global_load_lds((const unsigned*)(Ab + (size_t)192 * lda + (K0)), (unsigned*)(la + 12288), 16, 0, 0); \
      __builtin_amdgcn_global_load_lds((const unsigned*)(Bb + (K0)), (unsigned*)(la + 16384), 16, 0, 0); \
      __builtin_amdgcn_global_load_lds((const unsigned*)(Bb + (size_t)64 * K + (K0)), (unsigned*)(la + 16384 + 4096), 16, 0, 0); }
#define MM4(M, AF) { acc[M][0] = __builtin_amdgcn_mfma_f32_16x16x32_bf16(bg0, AF, acc[M][0], 0, 0, 0); \
      acc[M][1] = __builtin_amdgcn_mfma_f32_16x16x32_bf16(bg1, AF, acc[M][1], 0, 0, 0); \
      acc[M][2] = __builtin_amdgcn_mfma_f32_16x16x32_bf16(bg2, AF, acc[M][2], 0, 0, 0); \
      acc[M][3] = __builtin_amdgcn_mfma_f32_16x16x32_bf16(bg3, AF, acc[M][3], 0, 0, 0); }
#define AFR(M) (*(const bf16x8*)(rap + (M) * 1024))
    __syncthreads();
    GLDS_STAGE(0, 0);
    GLDS_STAGE(1, 32);
    asm volatile("s_waitcnt vmcnt(6)" ::: "memory");
    asm volatile("s_waitcnt lgkmcnt(0)" ::: "memory");
    __builtin_amdgcn_s_barrier();
    int cur = 0, nx2 = 2;
    for (int kt = 0; kt < nkk; ++kt) {
      if (kt + 2 < nkk) GLDS_STAGE(nx2, (kt + 2) * 32);
      const char* rbp = smemc + cur * 24576 + 16384 + (wc * 4) * 1024 + flo;
      const char* rap = smemc + cur * 24576 + (wr * 8) * 1024 + flo;
      bf16x8 bg0 = *(const bf16x8*)(rbp), bg1 = *(const bf16x8*)(rbp + 1024), bg2 = *(const bf16x8*)(rbp + 2048), bg3 = *(const bf16x8*)(rbp + 3072);
      bf16x8 a0 = AFR(0), a1 = AFR(1), a2 = AFR(2);
      MM4(0, a0); a0 = AFR(3);
      MM4(1, a1); a1 = AFR(4);
      MM4(2, a2); a2 = AFR(5);
      MM4(3, a0); a0 = AFR(6);
      MM4(4, a1); a1 = AFR(7);
      MM4(5, a2);
      MM4(6, a0);
      MM4(7, a1);
      __builtin_amdgcn_sched_group_barrier(0x100, 7, 0);
      __builtin_amdgcn_sched_group_barrier(0x008, 4, 0);
      __builtin_amdgcn_sched_group_barrier(0x100, 1, 0);
      __builtin_amdgcn_sched_group_barrier(0x008, 4, 0);
      __builtin_amdgcn_sched_group_barrier(0x100, 1, 0);
      __builtin_amdgcn_sched_group_barrier(0x008, 4, 0);
      __builtin_amdgcn_sched_group_barrier(0x100, 1, 0);
      __builtin_amdgcn_sched_group_barrier(0x008, 4, 0);
      __builtin_amdgcn_sched_group_barrier(0x100, 1, 0);
      __builtin_amdgcn_sched_group_barrier(0x008, 4, 0);
      __builtin_amdgcn_sched_group_barrier(0x100, 1, 0);
      __builtin_amdgcn_sched_group_barrier(0x008, 12, 0);
      __builtin_amdgcn_sched_barrier(0);
      if (kt + 2 < nkk) asm volatile("s_waitcnt vmcnt(6)" ::: "memory");
      else asm volatile("s_waitcnt vmcnt(0)" ::: "memory");
      asm volatile("s_waitcnt lgkmcnt(0)" ::: "memory");
      __builtin_amdgcn_s_barrier();
      cur = (cur == 2) ? 0 : cur + 1;
      nx2 = (nx2 == 2) ? 0 : nx2 + 1;
    }
#undef GLDS_STAGE
#undef MM4
#undef AFR
    if (EPI == 0) {
      bfr* dst; int ld, c0;
      if (tn < 8) { dst = WSP(bfr, OFF_PGDN); ld = 1024; c0 = tn * 128; }
      else if (tn < 14) { dst = WSP(bfr, OFF_PHY); ld = 768; c0 = (tn - 8) * 128; }
      else if (tn < 24) { dst = WSP(bfr, OFF_PHG); ld = 1280; c0 = (tn - 14) * 128; }
      else if (tn < 30) { dst = WSP(bfr, OFF_PDA); ld = 768; c0 = (tn - 24) * 128; }
      else { dst = nullptr; ld = 0; c0 = 0; }
      if (dst) {
        store_tile_bf16<false>(acc, dst, ld, tm * 256 + wr * 128, c0 + wc * 64, (bfr*)smemc + wave * (64 * 72), lane);
      } else if (wc == 0) {
        float* ab = WSP(float, OFF_AB);
#pragma unroll
        for (int m = 0; m < 8; ++m) {
          int row = tm * 256 + wr * 128 + m * 16 + fr;
          *(float4*)(ab + (size_t)row * 16 + fq * 4) = (float4){acc[m][0][0], acc[m][0][1], acc[m][0][2], acc[m][0][3]};
        }
      }
    } else if (EPI == 2) {
      store_tile_bf16<true>(acc, WSP(bfr, OFF_HID), 4096, tm * 256 + wr * 128, tn * 128 + wc * 64, (bfr*)smemc + wave * (64 * 72), lane);
    } else {
      const int midx = tm < 128 ? (tm >> 4) : 8;
      const float* gv = WSP(float, OFF_MOD) + (size_t)(l * 9 + midx) * 6144 + (EPI == 1 ? 2048 : 5120);
      float* wbuf = (float*)smemc + wave * (32 * 68);
      const int colw = tn * 128 + wc * 64;
      if (item >= 0) {
        float* slb = WSP(float, OFF_SLAB) + (size_t)item * 32768 + (size_t)(wr * 128) * 128 + wc * 64;
#pragma unroll
        for (int pass = 0; pass < 4; ++pass) {
#pragma unroll
          for (int mm = 0; mm < 2; ++mm)
#pragma unroll
            for (int n = 0; n < 4; ++n)
              *(f32x4*)(wbuf + (mm * 16 + fr) * 68 + n * 16 + fq * 4) = acc[2 * pass + mm][n];
#pragma unroll
          for (int q = 0; q < 8; ++q) {
            const int chunk = lane + 64 * q, rowl = chunk >> 4, c16 = chunk & 15;
            *(f32x4*)(slb + (size_t)(pass * 32 + rowl) * 128 + c16 * 4) = *(const f32x4*)(wbuf + rowl * 68 + c16 * 4);
          }
        }
      } else {
#pragma unroll
        for (int pass = 0; pass < 4; ++pass) {
#pragma unroll
          for (int mm = 0; mm < 2; ++mm)
#pragma unroll
            for (int n = 0; n < 4; ++n)
              *(f32x4*)(wbuf + (mm * 16 + fr) * 68 + n * 16 + fq * 4) = acc[2 * pass + mm][n];
#pragma unroll
          for (int q = 0; q < 8; ++q) {
            const int chunk = lane + 64 * q, rowl = chunk >> 4, c16 = chunk & 15;
            const int row = tm * 256 + wr * 128 + pass * 32 + rowl, col = colw + c16 * 4;
            const f32x4 a = *(const f32x4*)(wbuf + rowl * 68 + c16 * 4);
            const float* xi = (EPI == 1) ? xin_row(p, l, row) : (const float*)xout_row(p, row);
            float* xo = xout_row(p, row);
            float4 xv = *(const float4*)(xi + col);
            const float4 g4 = *(const float4*)(gv + col);
            xv.x += g4.x * a[0]; xv.y += g4.y * a[1]; xv.z += g4.z * a[2]; xv.w += g4.w * a[3];
            *(float4*)(xo + col) = xv;
          }
        }
      }
    }
  }
}

__device__ __forceinline__ void prep_task(const Params& p, int l, int task  , char* smemc) {
  const int tid = tidx();
  const bfr* pg = WSP(bfr, OFF_PGDN);
  const bfr* ph = WSP(bfr, OFF_PHY);
  bfr* gq = WSP(bfr, OFF_GQ);
  bfr* hv = WSP(bfr, OFF_HVC) - (size_t)NLAT * 256;
  const float* gw = p.in[9] + l * 3 * 768;
  const float* hw = p.in[13] + l * 3 * 768;
  float gw0[3], gw1[3], gw2[3], hw0[3];
#pragma unroll
  for (int i = 0; i < 3; ++i) {
    gw0[i] = gw[i * 768 + tid]; gw1[i] = gw[i * 768 + 256 + tid]; gw2[i] = gw[i * 768 + 512 + tid]; hw0[i] = hw[i * 768 + tid];
  }
  {
    const int row0 = task * 32;
    int t0, n;
    if (row0 < NLAT) { t0 = row0 & 4095; n = 4096; } else { t0 = (row0 - NLAT) & 255; n = 256; }
    const bool isctx = row0 >= NLAT;
#pragma unroll 1
    for (int rb = 0; rb < 32; rb += 8) {
      float xq[10], xk[10], xv[10], xh[10];
#pragma unroll
      for (int j = 0; j < 10; ++j) {
        const int tt = t0 + rb - 1 + j;
        const bool ok = tt >= 0 && tt < n;
        const bfr* r = pg + (size_t)(row0 + rb - 1 + j) * 1024;
        xq[j] = ok ? bf2f(r[tid]) : 0.f;
        xk[j] = ok ? bf2f(r[256 + tid]) : 0.f;
        xv[j] = ok ? bf2f(r[512 + tid]) : 0.f;
        xh[j] = (ok && isctx) ? bf2f(ph[(size_t)(row0 + rb - 1 + j) * 768 + tid]) : 0.f;
      }
#pragma unroll
      for (int r8 = 0; r8 < 8; ++r8) {
        const int row = row0 + rb + r8;
        float aq = gw0[0] * xq[r8] + gw0[1] * xq[r8 + 1] + gw0[2] * xq[r8 + 2];
        float ak = gw1[0] * xk[r8] + gw1[1] * xk[r8 + 1] + gw1[2] * xk[r8 + 2];
        float av = gw2[0] * xv[r8] + gw2[1] * xv[r8 + 1] + gw2[2] * xv[r8 + 2];
        aq *= fsigmoid(aq); ak *= fsigmoid(ak); av *= fsigmoid(av);
        float sq = wave_sum(aq * aq), sk = wave_sum(ak * ak);
        aq *= rsqrtf(sq + 1e-6f); ak *= rsqrtf(sk + 1e-6f);
        gq[(size_t)row * 768 + tid] = f2bf(aq);
        gq[(size_t)row * 768 + 256 + tid] = f2bf(ak);
        gq[(size_t)row * 768 + 512 + tid] = f2bf(av);
        if (isctx) hv[(size_t)row * 256 + tid] = f2bf(hw0[0] * xh[r8] + hw0[1] * xh[r8 + 1] + hw0[2] * xh[r8 + 2]);
      }
    }
  }
  bfr* pd = WSP(bfr, OFF_PDA);
  for (int gi = tid; gi < 512; gi += 256) {
    int rr = gi >> 4, g = gi & 15;
    int row = task * 32 + rr;
    int qk = g >> 3;
    bfr* ptr = pd + (size_t)row * 768 + g * 32;
    const float* nw = p.in[qk == 0 ? 25 : 26] + l * 32;
    float x[32];
    uint4 raw[4];
#pragma unroll
    for (int i = 0; i < 4; ++i) raw[i] = ((const uint4*)ptr)[i];
#pragma unroll
    for (int i = 0; i < 4; ++i) {
      unsigned w0 = raw[i].x, w1 = raw[i].y, w2 = raw[i].z, w3 = raw[i].w;
      x[8 * i + 0] = __uint_as_float(w0 << 16); x[8 * i + 1] = __uint_as_float(w0 & 0xffff0000u);
      x[8 * i + 2] = __uint_as_float(w1 << 16); x[8 * i + 3] = __uint_as_float(w1 & 0xffff0000u);
      x[8 * i + 4] = __uint_as_float(w2 << 16); x[8 * i + 5] = __uint_as_float(w2 & 0xffff0000u);
      x[8 * i + 6] = __uint_as_float(w3 << 16); x[8 * i + 7] = __uint_as_float(w3 & 0xffff0000u);
    }
    float ss = 0.f;
#pragma unroll
    for (int i = 0; i < 32; ++i) ss += x[i] * x[i];
    float r = rsqrtf(ss * (1.f / 32.f) + 1e-6f);
    if (qk == 0) r *= 0.25503486f;
#pragma unroll
    for (int i = 0; i < 32; ++i) x[i] = x[i] * r * nw[i];
    if (row < NLAT) {
      int t = row & 4095;
      const float* rr_ = WSP(float, OFF_ROPE) + (t >> 6) * 16;
      const float* rc_ = WSP(float, OFF_ROPE) + (t & 63) * 16;
      float crv[8], srv[8], ccv[8], scv[8];
#pragma unroll
      for (int i = 0; i < 2; ++i) {
        float4 a4 = ((const float4*)rr_)[i], b4 = ((const float4*)rr_)[2 + i], c4 = ((const float4*)rc_)[i], d4 = ((const float4*)rc_)[2 + i];
        crv[4 * i] = a4.x; crv[4 * i + 1] = a4.y; crv[4 * i + 2] = a4.z; crv[4 * i + 3] = a4.w;
        srv[4 * i] = b4.x; srv[4 * i + 1] = b4.y; srv[4 * i + 2] = b4.z; srv[4 * i + 3] = b4.w;
        ccv[4 * i] = c4.x; ccv[4 * i + 1] = c4.y; ccv[4 * i + 2] = c4.z; ccv[4 * i + 3] = c4.w;
        scv[4 * i] = d4.x; scv[4 * i + 1] = d4.y; scv[4 * i + 2] = d4.z; scv[4 * i + 3] = d4.w;
      }
#pragma unroll
      for (int i = 0; i < 8; ++i) {
        const float sr = srv[i], cr = crv[i], scn = scv[i], cc = ccv[i];
        float a = x[i], b = x[8 + i];
        x[i] = a * cr - b * sr; x[8 + i] = b * cr + a * sr;
        float c = x[16 + i], d = x[24 + i];
        x[16 + i] = c * cc - d * scn; x[24 + i] = d * cc + c * scn;
      }
    }
#pragma unroll
    for (int i = 0; i < 4; ++i) {
      uint4 o;
      o.x = (unsigned)f2bf(x[8 * i + 0]) | ((unsigned)f2bf(x[8 * i + 1]) << 16);
      o.y = (unsigned)f2bf(x[8 * i + 2]) | ((unsigned)f2bf(x[8 * i + 3]) << 16);
      o.z = (unsigned)f2bf(x[8 * i + 4]) | ((unsigned)f2bf(x[8 * i + 5]) << 16);
      o.w = (unsigned)f2bf(x[8 * i + 6]) | ((unsigned)f2bf(x[8 * i + 7]) << 16);
      ((uint4*)ptr)[i] = o;
    }
  }
  if (task < 1024) {
    bfr* tile = (bfr*)smemc;
    const int row0 = task * 32;
    const int bb = row0 >> 12, t0 = row0 & 4095;
#pragma unroll 1
    for (int k = 0; k < 3; ++k) {
      const int ch = k * 256 + tid;
      const float w0 = hw[ch], w1 = hw[768 + ch], w2 = hw[1536 + ch];
      bfr xr[34];
#pragma unroll
      for (int j = 0; j < 34; ++j) {
        const int tt = t0 - 1 + j;
        xr[j] = (tt >= 0 && tt < 4096) ? ph[(size_t)(row0 - 1 + j) * 768 + ch] : (bfr)0;
      }
#pragma unroll
      for (int rr = 0; rr < 32; rr += 2) {
        const float y0 = w0 * bf2f(xr[rr]) + w1 * bf2f(xr[rr + 1]) + w2 * bf2f(xr[rr + 2]);
        const float y1 = w0 * bf2f(xr[rr + 1]) + w1 * bf2f(xr[rr + 2]) + w2 * bf2f(xr[rr + 3]);
        *(unsigned*)(tile + tid * 40 + rr) = pk2(y0, y1);
      }
      __syncthreads();
      bfr* dst = WSP(bfr, k == 0 ? OFF_HVT : (k == 1 ? OFF_X1T : OFF_X2T)) + ((size_t)(tid * 8 + bb)) * 4096 + t0;
#pragma unroll
      for (int i = 0; i < 4; ++i) ((uint4*)dst)[i] = *(const uint4*)(tile + tid * 40 + 8 * i);
      __syncthreads();
    }
  }
  {
    bfr* tile = (bfr*)smemc;
    const int row0 = task * 32;
    bfr vr[32];
#pragma unroll
    for (int rr = 0; rr < 32; ++rr) vr[rr] = pd[(size_t)(row0 + rr) * 768 + 512 + tid];
#pragma unroll
    for (int rr = 0; rr < 32; ++rr) {
      int pp = rr & 15;
      int g = pp >> 2;
      g = (g == 1) ? 2 : (g == 2 ? 1 : g);
      int pos = (rr & 16) | (g << 2) | (pp & 3);
      tile[tid * 40 + pos] = vr[rr];
    }
    __syncthreads();
    int bb, kbase;
    if (row0 < NLAT) { bb = row0 >> 12; kbase = row0 & 4095; } else { bb = (row0 - NLAT) >> 8; kbase = 4096 + ((row0 - NLAT) & 255); }
    bfr* vt = WSP(bfr, OFF_VT) + ((size_t)(bb * 256 + tid)) * 4352 + kbase;
#pragma unroll
    for (int i = 0; i < 4; ++i) ((uint4*)vt)[i] = *(const uint4*)(tile + tid * 40 + 8 * i);
    __syncthreads();
  }
}

__device__ __forceinline__ size_t scan_row(int b, int d, int ci, int i) {
  if (ci < 8) { int c0 = ci * 32; int t = d == 0 ? c0 + i : 255 - c0 - i; return (size_t)NLAT + b * 256 + t; }
  int c0 = (ci - 8) * 32; int t = d == 0 ? c0 + i : 4095 - c0 - i; return (size_t)b * 4096 + t;
}

__device__ __forceinline__ void hgrn_scan(const Params& p, int l, int task, float* smem) {
  const int b = task >> 3, h = (task >> 1) & 3, d = task & 1;
  const int tid = tidx(), lane = tid & 63, wave = tid >> 6;
  const int kg = lane & 3, vv = wave * 16 + (lane >> 2);
  float* sq = smem;
  float* sf = smem + 2048;
  float* sv = smem + 4096;
  float* so = smem + 6144;
  bfr* P = WSP(bfr, OFF_PHG);
  const int ch = tid & 63, i0 = tid >> 6;
  const float lbv = WSP(float, OFF_LB)[l * 256 + h * 64 + ch];
  v2f S2[8];
#pragma unroll
  for (int i = 0; i < 8; ++i) S2[i] = (v2f){0.f, 0.f};
  __builtin_amdgcn_s_setprio(3);
  bfr rq[8], ri[8], rf[8];
#pragma unroll
  for (int j = 0; j < 8; ++j) {
    const bfr* pr = P + scan_row(b, d, 0, i0 + 4 * j) * 1280 + h * 64 + ch;
    rq[j] = pr[0]; ri[j] = pr[256]; rf[j] = pr[512 + d * 256];
  }
  for (int ci = 0; ci < 136; ++ci) {
#pragma unroll
    for (int j = 0; j < 8; ++j) {
      const int e = (i0 + 4 * j) * 64 + ch;
      sq[e] = siluf_(bf2f(rq[j]));
      sf[e] = lbv + (1.f - lbv) * sigmoidf_(bf2f(rf[j]));
      sv[e] = bf2f(ri[j]);
    }
    __syncthreads();
    if (ci + 1 < 136) {
#pragma unroll
      for (int j = 0; j < 8; ++j) {
        const bfr* pr = P + scan_row(b, d, ci + 1, i0 + 4 * j) * 1280 + h * 64 + ch;
        rq[j] = pr[0]; ri[j] = pr[256]; rf[j] = pr[512 + d * 256];
      }
    }
#pragma unroll 4
    for (int i = 0; i < 32; ++i) {
      const float vcur = sv[i * 64 + vv];
      const v2f vc2 = {vcur, vcur};
      const float4* f4 = (const float4*)(sf + i * 64 + kg * 16);
      const float4* q4 = (const float4*)(sq + i * 64 + kg * 16);
      v2f pa = {0.f, 0.f}, pb = {0.f, 0.f};
#pragma unroll
      for (int j = 0; j < 4; ++j) {
        float4 f = f4[j], q = q4[j];
        v2f fa = {f.x, f.y}, fb = {f.z, f.w}, qa = {q.x, q.y}, qb = {q.z, q.w};
        S2[2 * j] = fa * (S2[2 * j] - vc2) + vc2;
        S2[2 * j + 1] = fb * (S2[2 * j + 1] - vc2) + vc2;
        pa += S2[2 * j] * qa;
        pb += S2[2 * j + 1] * qb;
      }
      float po = quad_sum((pa.x + pa.y) + (pb.x + pb.y));
      if (kg == 0) so[i * 64 + vv] = po;
    }
    __syncthreads();
#pragma unroll
    for (int j = 0; j < 8; ++j) {
      const int i = i0 + 4 * j;
      P[scan_row(b, d, ci, i) * 1280 + 512 + d * 256 + h * 64 + ch] = f2bf(so[i * 64 + ch]);
    }
  }
  __builtin_amdgcn_s_setprio(0);
}

__device__ __forceinline__ bfr* sw_addr(bfr* base, int R, int chunk) { return base + R * 64 + ((chunk ^ (R & 7)) << 3); }
__device__ __forceinline__ bf16x8 frag_nat(bfr* base, int R, int kk, int hf) { return *(const bf16x8*)sw_addr(base, R, 2 * kk + hf); }
__device__ __forceinline__ bf16x8 frag_krow(bfr* base, int R, int c0, int hf) {
  uint2 lo = *(const uint2*)(sw_addr(base, R, c0) + 4 * hf);
  uint2 hi = *(const uint2*)(sw_addr(base, R, c0 + 1) + 4 * hf);
  return __builtin_bit_cast(bf16x8, (uint4){lo.x, lo.y, hi.x, hi.y});
}
__device__ __forceinline__ bf16x8 pack8(const f32x16& x, int st) {
  return __builtin_bit_cast(bf16x8, (uint4){pk2(x[8 * st + 0], x[8 * st + 1]), pk2(x[8 * st + 2], x[8 * st + 3]),
                                            pk2(x[8 * st + 4], x[8 * st + 5]), pk2(x[8 * st + 6], x[8 * st + 7])});
}
__device__ __forceinline__ int crow_(int reg, int hf) { return (reg & 3) + 8 * (reg >> 2) + 4 * hf; }
__device__ __forceinline__ size_t scan_row64(int b, int d, int ci, int i) {
  if (ci < 4) { int c0 = ci * 64; int t = d == 0 ? c0 + i : 255 - c0 - i; return (size_t)NLAT + b * 256 + t; }
  int c0 = (ci - 4) * 64; int t = d == 0 ? c0 + i : 4095 - c0 - i; return (size_t)b * 4096 + t;
}

__device__ __forceinline__ void hgrn_chunked(const Params& p, int l, int task, char* smemc) {
  const int b = task >> 3, h = (task >> 1) & 3, d = task & 1;
  const int tid = tidx(), lane = tid & 63, wave = tid >> 6, r = lane & 31, hf = lane >> 5;
  const int tb = wave >> 1, vb = wave & 1;
  bfr* QG = (bfr*)smemc;
  bfr* QT = QG + 4096;
  bfr* KT = QT + 4096;
  bfr* KET = KT + 4096;
  bfr* VT = KET + 4096;
  float* TOT = (float*)(smemc + 40960);
  float* EG = TOT + 256;
  bfr* P = WSP(bfr, OFF_PHG);
  const int c = tid & 63, qd = tid >> 6;
  const float lbv = WSP(float, OFF_LB)[l * 256 + h * 64 + c];
  f32x16 S[2];
#pragma unroll
  for (int m = 0; m < 2; ++m)
#pragma unroll
    for (int i = 0; i < 16; ++i) S[m][i] = 0.f;
  __builtin_amdgcn_s_setprio(3);
  bfr rq[16], ri[16], rf[16];
#pragma unroll
  for (int j = 0; j < 16; ++j) {
    const bfr* pr = P + scan_row64(b, d, 0, 16 * qd + j) * 1280 + h * 64 + c;
    rq[j] = pr[0]; ri[j] = pr[256]; rf[j] = pr[512 + d * 256];
  }
#pragma unroll 1
  for (int ci = 0; ci < 68; ++ci) {
    float g[16], ky[16], qh[16];
    float run = 0.f;
#pragma unroll
    for (int j = 0; j < 16; ++j) {
      float f = lbv + (1.f - lbv) * fsigmoid(bf2f(rf[j]));
      run += __logf(f);
      const float qv = bf2f(rq[j]);
      g[j] = run; ky[j] = 1.f - f; qh[j] = qv * fsigmoid(qv);
    }
    __syncthreads();
    TOT[qd * 64 + c] = run;
    __syncthreads();
    const float t0 = TOT[c], t1 = TOT[64 + c], t2 = TOT[128 + c], t3 = TOT[192 + c];
    const float off = (qd > 0 ? t0 : 0.f) + (qd > 1 ? t1 : 0.f) + (qd > 2 ? t2 : 0.f);
    const float gm = t0 + t1, g63 = (t0 + t1) + (t2 + t3);
    const float egm = __expf(gm), e6m = __expf(g63 - gm);
    unsigned wke[8], wvt[8];
#pragma unroll
    for (int j = 0; j < 16; ++j) {
      const int i = 16 * qd + j;
      const float gi = g[j] + off;
      const float e1 = __expf(fminf(fmaxf(gi - gm, -80.f), 80.f));
      const float e2 = __builtin_amdgcn_rcpf(e1);
      const float eg = e1 * egm;
      const float e3 = e2 * e6m;
      const int sw = ((c >> 3) ^ (i & 7)) * 8 + (c & 7);
      QG[i * 64 + sw] = f2bf(qh[j] * eg);
      QT[i * 64 + sw] = f2bf(qh[j] * e1);
      KT[i * 64 + sw] = f2bf(ky[j] * e2);
      const float ke = ky[j] * e3, vv = bf2f(ri[j]);
      if (j & 1) { wke[j >> 1] |= ((unsigned)f2bf(ke)) << 16; wvt[j >> 1] |= ((unsigned)ri[j]) << 16; }
      else { wke[j >> 1] = f2bf(ke); wvt[j >> 1] = ri[j]; }
      (void)vv;
    }
    *(uint4*)sw_addr(KET, c, 2 * qd) = (uint4){wke[0], wke[1], wke[2], wke[3]};
    *(uint4*)sw_addr(KET, c, 2 * qd + 1) = (uint4){wke[4], wke[5], wke[6], wke[7]};
    *(uint4*)sw_addr(VT, c, 2 * qd) = (uint4){wvt[0], wvt[1], wvt[2], wvt[3]};
    *(uint4*)sw_addr(VT, c, 2 * qd + 1) = (uint4){wvt[4], wvt[5], wvt[6], wvt[7]};
    if (qd == 0) EG[c] = __expf(g63);
    __syncthreads();
    if (ci + 1 < 68) {
#pragma unroll
      for (int j = 0; j < 16; ++j) {
        const bfr* pr = P + scan_row64(b, d, ci + 1, 16 * qd + j) * 1280 + h * 64 + c;
        rq[j] = pr[0]; ri[j] = pr[256]; rf[j] = pr[512 + d * 256];
      }
    }
    f32x16 AT[2];
#pragma unroll
    for (int m = 0; m < 2; ++m) {
#pragma unroll
      for (int i = 0; i < 16; ++i) AT[m][i] = 0.f;
      if (m <= tb) {
#pragma unroll
        for (int kk = 0; kk < 4; ++kk)
          AT[m] = __builtin_amdgcn_mfma_f32_32x32x16_bf16(frag_nat(KT, 32 * m + r, kk, hf), frag_nat(QT, 32 * tb + r, kk, hf), AT[m], 0, 0, 0);
        if (m == tb) {
#pragma unroll
          for (int i = 0; i < 16; ++i) if (crow_(i, hf) > r) AT[m][i] = 0.f;
        }
      }
    }
    f32x16 o;
#pragma unroll
    for (int i = 0; i < 16; ++i) o[i] = 0.f;
#pragma unroll
    for (int m = 0; m < 2; ++m)
#pragma unroll
      for (int st = 0; st < 2; ++st)
        o = __builtin_amdgcn_mfma_f32_32x32x16_bf16(frag_krow(QG, 32 * tb + r, 4 * m + 2 * st, hf), pack8(S[m], st), o, 0, 0, 0);
#pragma unroll
    for (int m = 0; m < 2; ++m) {
      if (m <= tb) {
#pragma unroll
        for (int st = 0; st < 2; ++st)
          o = __builtin_amdgcn_mfma_f32_32x32x16_bf16(pack8(AT[m], st), frag_krow(VT, 32 * vb + r, 4 * m + 2 * st, hf), o, 0, 0, 0);
      }
    }
#pragma unroll
    for (int m = 0; m < 2; ++m) {
#pragma unroll
      for (int gq = 0; gq < 4; ++gq) {
        float4 e4 = *(const float4*)(EG + 32 * m + 8 * gq + 4 * hf);
        S[m][4 * gq + 0] *= e4.x; S[m][4 * gq + 1] *= e4.y; S[m][4 * gq + 2] *= e4.z; S[m][4 * gq + 3] *= e4.w;
      }
#pragma unroll
      for (int kk = 0; kk < 4; ++kk)
        S[m] = __builtin_amdgcn_mfma_f32_32x32x16_bf16(frag_nat(KET, 32 * m + r, kk, hf), frag_nat(VT, 32 * vb + r, kk, hf), S[m], 0, 0, 0);
    }
#pragma unroll
    for (int i = 0; i < 16; ++i) {
      const int t = 32 * tb + crow_(i, hf);
      P[scan_row64(b, d, ci, t) * 1280 + 512 + d * 256 + h * 64 + 32 * vb + r] = f2bf(o[i]);
    }
  }
  __builtin_amdgcn_s_setprio(0);
}

__device__ __forceinline__ void gdn_solve_task(const Params& p, int l, int task, char* smemc) {
  const int tid = tidx(), lane = tid & 63, wave = __builtin_amdgcn_readfirstlane(tid >> 6), r = lane & 31, hf = lane >> 5;
  const int chunk = task >> 2, h = task & 3;
  const int row0 = chunk * 64;
  int t0, n;
  if (row0 < NLAT) { t0 = row0 & 4095; n = 4096; } else { t0 = (row0 - NLAT) & 255; n = 256; }
  bfr* Kt = (bfr*)smemc;
  float* T0 = (float*)(smemc + 8192);
  float* T1 = T0 + 4096;
  float* GC = T1 + 4096;
  float* BT = GC + 128;
  {
    const int c = lane, qd = wave;
    const int ch = 256 + h * 64 + c;
    const float* gw = p.in[9] + l * 3 * 768;
    const float w0 = gw[ch], w1 = gw[768 + ch], w2 = gw[1536 + ch];
    const bfr* pg = WSP(bfr, OFF_PGDN);
    float x[18];
#pragma unroll
    for (int j = 0; j < 18; ++j) {
      const int tt = t0 + 16 * qd - 1 + j;
      x[j] = (tt >= 0 && tt < n) ? bf2f(pg[(size_t)(row0 + 16 * qd - 1 + j) * 1024 + ch]) : 0.f;
    }
#pragma unroll
    for (int j = 0; j < 16; ++j) {
      float a = w0 * x[j] + w1 * x[j + 1] + w2 * x[j + 2];
      a *= fsigmoid(a);
      float ss = wave_sum(a * a);
      a *= rsqrtf(ss + 1e-6f);
      const int i = 16 * qd + j;
      Kt[i * 64 + (((c >> 3) ^ (i & 7)) << 3) + (c & 7)] = f2bf(a);
    }
  }
  if (wave < 2) {
    const int d = wave, i = lane;
    const int tok = d == 0 ? i : 63 - i;
    const float* ar = WSP(float, OFF_AB) + (size_t)(row0 + tok) * 16;
    const float x = ar[d * 4 + h] + p.in[11][l * 8 + d * 4 + h];
    const float sp = fmaxf(x, 0.f) + log1pf(expf(-fabsf(x)));
    float g = -expf(p.in[10][l * 8 + d * 4 + h]) * sp;
#pragma unroll
    for (int off = 1; off < 64; off <<= 1) { float t = __shfl_up(g, off); if (lane >= off) g += t; }
    GC[d * 64 + i] = g;
    BT[d * 64 + i] = sigmoidf_(ar[8 + d * 4 + h]);
    (WSP(float, OFF_AB) + (size_t)(row0 + tok) * 16)[d * 4 + h] = g;
  }
  __syncthreads();
  {
    const int mi = wave >> 1, nj = wave & 1;
    f32x16 acc;
#pragma unroll
    for (int i = 0; i < 16; ++i) acc[i] = 0.f;
#pragma unroll
    for (int kk = 0; kk < 4; ++kk)
      acc = __builtin_amdgcn_mfma_f32_32x32x16_bf16(frag_nat(Kt, 32 * mi + r, kk, hf), frag_nat(Kt, 32 * nj + r, kk, hf), acc, 0, 0, 0);
    const int tj = 32 * nj + r;
#pragma unroll
    for (int reg = 0; reg < 16; ++reg) {
      const int ti = 32 * mi + crow_(reg, hf);
      if (tj < ti) T0[ti * 64 + tj] = BT[ti] * acc[reg] * __expf(GC[ti] - GC[tj]);
      else if (tj > ti) { const int i = 63 - ti, j = 63 - tj; T1[i * 64 + j] = BT[64 + i] * acc[reg] * __expf(GC[64 + i] - GC[64 + j]); }
    }
  }
  __syncthreads();
  if (wave < 2) {
    const int d = wave, c = lane;
    const float* T = T0 + d * 4096;
    float X[64];
#pragma unroll
    for (int i = 0; i < 64; ++i) {
      float a0 = (i == c) ? 1.f : 0.f, a1 = 0.f, a2 = 0.f, a3 = 0.f;
#pragma unroll
      for (int j = 0; j < i; ++j) {
        const float tx = T[i * 64 + j] * X[j];
        if ((j & 3) == 0) a0 -= tx; else if ((j & 3) == 1) a1 -= tx; else if ((j & 3) == 2) a2 -= tx; else a3 -= tx;
      }
      X[i] = (a0 + a1) + (a2 + a3);
    }
    const float bc = BT[d * 64 + c];
    const int hd = h * 2 + d;
    const int colbase = hd < 4 ? hd * 64 : 512 + (hd - 4) * 64;
    bfr* oc = WSP(bfr, OFF_HN) + (size_t)row0 * 1024 + colbase + c;
#pragma unroll
    for (int i = 0; i < 64; ++i) {
      const int tok = d == 0 ? i : 63 - i;
      oc[(size_t)tok * 1024] = f2bf(X[i] * bc);
    }
  }
  __syncthreads();
}

__device__ __forceinline__ void gdn_chunked(const Params& p, int l, int task, char* smemc) {
  const int b = task >> 3, h = (task >> 1) & 3, d = task & 1;
  const int tid = tidx(), lane = tid & 63, wave = tid >> 6, r = lane & 31, hf = lane >> 5;
  const int tb = wave >> 1, vb = wave & 1;
  bfr* Qn = (bfr*)smemc;
  bfr* Kn = Qn + 4096;
  bfr* NKG = Kn + 4096;
  bfr* QG = NKG + 4096;
  bfr* KGET = QG + 4096;
  bfr* ABm = KGET + 4096;
  bfr* Vn = ABm + 4096;
  float* GC = (float*)(smemc + 57344);
  float* EGC = GC + 64;
  float* EGE = EGC + 64;
  const int cp = tid & 31, og = tid >> 5;
  const int hd = h * 2 + d;
  const int colbase = hd < 4 ? hd * 64 : 512 + (hd - 4) * 64;
  const float Aexp = expf(p.in[10][l * 8 + d * 4 + h]);
  const float dtb = p.in[11][l * 8 + d * 4 + h];
  const bfr* gq = WSP(bfr, OFF_GQ);
  const bfr* oc = WSP(bfr, OFF_HN);
  const float* ab = WSP(float, OFF_AB);
  bfr* P = WSP(bfr, OFF_PGDN);
  f32x16 S[2];
#pragma unroll
  for (int m = 0; m < 2; ++m)
#pragma unroll
    for (int i = 0; i < 16; ++i) S[m][i] = 0.f;
  __builtin_amdgcn_s_setprio(3);
  unsigned rq[8], rk[8], rv[8], ra[8];
  float rga = 0.f;
#pragma unroll
  for (int j = 0; j < 8; ++j) {
    const size_t row = scan_row64(b, d, 0, 8 * og + j);
    const bfr* pr = gq + row * 768 + h * 64 + 2 * cp;
    rq[j] = *(const unsigned*)pr; rk[j] = *(const unsigned*)(pr + 256); rv[j] = *(const unsigned*)(pr + 512);
    ra[j] = *(const unsigned*)(oc + row * 1024 + colbase + 2 * cp);
  }
  if (tid < 64) rga = ab[scan_row64(b, d, 0, tid) * 16 + d * 4 + h];
#pragma unroll 1
  for (int ci = 0; ci < 68; ++ci) {
    __syncthreads();
    if (wave == 0) {
      const float g = rga;
      const float g63 = __shfl(g, 63);
      GC[lane] = g; EGC[lane] = __expf(g); EGE[lane] = __expf(g63 - g);
    }
    __syncthreads();
    {
      unsigned w0[4], w1[4];
#pragma unroll
      for (int j = 0; j < 8; ++j) {
        const int i = 8 * og + j;
        const float eg = EGC[i], ee = EGE[i];
        const int addr = i * 64 + ((((cp >> 2) ^ (i & 7))) << 3) + 2 * (cp & 3);
        const float q0 = __uint_as_float(rq[j] << 16), q1 = __uint_as_float(rq[j] & 0xffff0000u);
        const float k0 = __uint_as_float(rk[j] << 16), k1 = __uint_as_float(rk[j] & 0xffff0000u);
        *(unsigned*)(Qn + addr) = rq[j];
        *(unsigned*)(Kn + addr) = rk[j];
        *(unsigned*)(Vn + addr) = rv[j];
        *(unsigned*)(ABm + addr) = ra[j];
        *(unsigned*)(NKG + addr) = pk2(-k0 * eg, -k1 * eg);
        *(unsigned*)(QG + addr) = pk2(q0 * 0.125f * eg, q1 * 0.125f * eg);
        const unsigned e0 = f2bf(k0 * ee), e1 = f2bf(k1 * ee);
        if (j & 1) { w0[j >> 1] |= e0 << 16; w1[j >> 1] |= e1 << 16; } else { w0[j >> 1] = e0; w1[j >> 1] = e1; }
      }
      *(uint4*)sw_addr(KGET, 2 * cp, og) = (uint4){w0[0], w0[1], w0[2], w0[3]};
      *(uint4*)sw_addr(KGET, 2 * cp + 1, og) = (uint4){w1[0], w1[1], w1[2], w1[3]};
    }
    __syncthreads();
    if (ci + 1 < 68) {
#pragma unroll
      for (int j = 0; j < 8; ++j) {
        const size_t row = scan_row64(b, d, ci + 1, 8 * og + j);
        const bfr* pr = gq + row * 768 + h * 64 + 2 * cp;
        rq[j] = *(const unsigned*)pr; rk[j] = *(const unsigned*)(pr + 256); rv[j] = *(const unsigned*)(pr + 512);
        ra[j] = *(const unsigned*)(oc + row * 1024 + colbase + 2 * cp);
      }
      if (tid < 64) rga = ab[scan_row64(b, d, ci + 1, tid) * 16 + d * 4 + h];
    }
    f32x16 vn[2];
#pragma unroll
    for (int mt = 0; mt < 2; ++mt)
#pragma unroll
      for (int i = 0; i < 16; ++i) vn[mt][i] = 0.f;
#pragma unroll
    for (int m = 0; m < 2; ++m) {
      f32x16 rr;
#pragma unroll
      for (int reg = 0; reg < 16; ++reg) {
        const int i = 32 * m + crow_(reg, hf), v = 32 * vb + r;
        rr[reg] = bf2f(Vn[i * 64 + (((v >> 3) ^ (i & 7)) << 3) + (v & 7)]);
      }
#pragma unroll
      for (int mp = 0; mp < 2; ++mp)
#pragma unroll
        for (int st = 0; st < 2; ++st)
          rr = __builtin_amdgcn_mfma_f32_32x32x16_bf16(frag_krow(NKG, 32 * m + r, 4 * mp + 2 * st, hf), pack8(S[mp], st), rr, 0, 0, 0);
#pragma unroll
      for (int mt = 0; mt < 2; ++mt) {
        if (m <= mt) {
#pragma unroll
          for (int st = 0; st < 2; ++st)
            vn[mt] = __builtin_amdgcn_mfma_f32_32x32x16_bf16(frag_krow(ABm, 32 * mt + r, 4 * m + 2 * st, hf), pack8(rr, st), vn[mt], 0, 0, 0);
        }
      }
    }
    f32x16 o;
#pragma unroll
    for (int i = 0; i < 16; ++i) o[i] = 0.f;
#pragma unroll
    for (int mp = 0; mp < 2; ++mp)
#pragma unroll
      for (int st = 0; st < 2; ++st)
        o = __builtin_amdgcn_mfma_f32_32x32x16_bf16(frag_krow(QG, 32 * tb + r, 4 * mp + 2 * st, hf), pack8(S[mp], st), o, 0, 0, 0);
    const float gct = GC[32 * tb + r];
#pragma unroll
    for (int m = 0; m < 2; ++m) {
      if (m <= tb) {
        f32x16 AT;
#pragma unroll
        for (int i = 0; i < 16; ++i) AT[i] = 0.f;
#pragma unroll
        for (int kk = 0; kk < 4; ++kk)
          AT = __builtin_amdgcn_mfma_f32_32x32x16_bf16(frag_nat(Kn, 32 * m + r, kk, hf), frag_nat(Qn, 32 * tb + r, kk, hf), AT, 0, 0, 0);
#pragma unroll
        for (int g4i = 0; g4i < 4; ++g4i) {
          const float4 g4 = *(const float4*)(GC + 32 * m + 8 * g4i + 4 * hf);
          const float gs[4] = {g4.x, g4.y, g4.z, g4.w};
#pragma unroll
          for (int jj = 0; jj < 4; ++jj) {
            const int reg = 4 * g4i + jj;
            const bool keep = (m < tb) || (crow_(reg, hf) <= r);
            AT[reg] = keep ? AT[reg] * 0.125f * __expf(gct - gs[jj]) : 0.f;
          }
        }
#pragma unroll
        for (int st = 0; st < 2; ++st)
          o = __builtin_amdgcn_mfma_f32_32x32x16_bf16(pack8(AT, st), pack8(vn[m], st), o, 0, 0, 0);
      }
    }
    const float eg63 = EGC[63];
#pragma unroll
    for (int mp = 0; mp < 2; ++mp) {
#pragma unroll
      for (int i = 0; i < 16; ++i) S[mp][i] *= eg63;
#pragma unroll
      for (int m = 0; m < 2; ++m)
#pragma unroll
        for (int st = 0; st < 2; ++st)
          S[mp] = __builtin_amdgcn_mfma_f32_32x32x16_bf16(frag_krow(KGET, 32 * mp + r, 4 * m + 2 * st, hf), pack8(vn[m], st), S[mp], 0, 0, 0);
    }
#pragma unroll
    for (int i = 0; i < 16; ++i) {
      const int t = 32 * tb + crow_(i, hf);
      P[scan_row64(b, d, ci, t) * 1024 + d * 256 + h * 64 + 32 * vb + r] = f2bf(o[i]);
    }
  }
  __builtin_amdgcn_s_setprio(0);
}

__device__ __forceinline__ void gdn_scan(const Params& p, int l, int task, float* smem) {
  const int b = task >> 3, h = (task >> 1) & 3, d = task & 1;
  const int tid = tidx(), lane = tid & 63, wave = tid >> 6;
  const int kg = lane & 3, vv = wave * 16 + (lane >> 2);
  float* sq = smem;
  float* sk = smem + 2048;
  float* sv = smem + 4096;
  float* so = smem + 6144;
  float* seg_ = smem + 8192;
  float* sbt = smem + 8192 + 32;
  const bfr* gq = WSP(bfr, OFF_GQ);
  const float* ab = WSP(float, OFF_AB);
  bfr* P = WSP(bfr, OFF_PGDN);
  const float Aexp = expf(p.in[10][l * 8 + d * 4 + h]);
  const float dtb = p.in[11][l * 8 + d * 4 + h];
  const int ch = tid & 63, i0 = tid >> 6;
  v2f S2[8];
#pragma unroll
  for (int i = 0; i < 8; ++i) S2[i] = (v2f){0.f, 0.f};
  __builtin_amdgcn_s_setprio(3);
  bfr rq[8], rk[8], rv[8];
  float ra = 0.f, rb = 0.f;
#pragma unroll
  for (int j = 0; j < 8; ++j) {
    const bfr* pr = gq + scan_row(b, d, 0, i0 + 4 * j) * 768 + h * 64 + ch;
    rq[j] = pr[0]; rk[j] = pr[256]; rv[j] = pr[512];
  }
  if (tid < 32) { const float* ar = ab + scan_row(b, d, 0, tid) * 16; ra = ar[d * 4 + h]; rb = ar[8 + d * 4 + h]; }
  for (int ci = 0; ci < 136; ++ci) {
#pragma unroll
    for (int j = 0; j < 8; ++j) {
      const int e = (i0 + 4 * j) * 64 + ch;
      sq[e] = bf2f(rq[j]) * 0.125f;
      sk[e] = bf2f(rk[j]);
      sv[e] = bf2f(rv[j]);
    }
    if (tid < 32) {
      float x = ra + dtb;
      float sp = fmaxf(x, 0.f) + log1pf(expf(-fabsf(x)));
      seg_[tid] = expf(-Aexp * sp);
      sbt[tid] = sigmoidf_(rb);
    }
    __syncthreads();
    if (ci + 1 < 136) {
#pragma unroll
      for (int j = 0; j < 8; ++j) {
        const bfr* pr = gq + scan_row(b, d, ci + 1, i0 + 4 * j) * 768 + h * 64 + ch;
        rq[j] = pr[0]; rk[j] = pr[256]; rv[j] = pr[512];
      }
      if (tid < 32) { const float* ar = ab + scan_row(b, d, ci + 1, tid) * 16; ra = ar[d * 4 + h]; rb = ar[8 + d * 4 + h]; }
    }
#pragma unroll 4
    for (int i = 0; i < 32; ++i) {
      const float vcur = sv[i * 64 + vv];
      const float eg = seg_[i], bt = sbt[i];
      const float4* k4 = (const float4*)(sk + i * 64 + kg * 16);
      const float4* q4 = (const float4*)(sq + i * 64 + kg * 16);
      v2f kk[8], qq[8];
#pragma unroll
      for (int j = 0; j < 4; ++j) {
        float4 a = k4[j], c = q4[j];
        kk[2 * j] = (v2f){a.x, a.y}; kk[2 * j + 1] = (v2f){a.z, a.w};
        qq[2 * j] = (v2f){c.x, c.y}; qq[2 * j + 1] = (v2f){c.z, c.w};
      }
      v2f ka = {0.f, 0.f}, kb = {0.f, 0.f};
#pragma unroll
      for (int j = 0; j < 4; ++j) { ka += kk[2 * j] * S2[2 * j]; kb += kk[2 * j + 1] * S2[2 * j + 1]; }
      const float ks = quad_sum((ka.x + ka.y) + (kb.x + kb.y));
      const float cfac = bt * (vcur - eg * ks);
      const v2f eg2 = {eg, eg}, cf2 = {cfac, cfac};
      v2f pa = {0.f, 0.f}, pb = {0.f, 0.f};
#pragma unroll
      for (int j = 0; j < 4; ++j) {
        S2[2 * j] = kk[2 * j] * cf2 + eg2 * S2[2 * j];
        S2[2 * j + 1] = kk[2 * j + 1] * cf2 + eg2 * S2[2 * j + 1];
        pa += qq[2 * j] * S2[2 * j];
        pb += qq[2 * j + 1] * S2[2 * j + 1];
      }
      const float po = quad_sum((pa.x + pa.y) + (pb.x + pb.y));
      if (kg == 0) so[i * 64 + vv] = po;
    }
    __syncthreads();
#pragma unroll
    for (int j = 0; j < 8; ++j) {
      const int i = i0 + 4 * j;
      P[scan_row(b, d, ci, i) * 1024 + d * 256 + h * 64 + ch] = f2bf(so[i * 64 + ch]);
    }
  }
  __builtin_amdgcn_s_setprio(0);
}

__device__ __forceinline__ void hy_conv(const Params& p, int l, int stage, int task) {
  const int c = tidx();
  int n, t0;
  size_t rowbase;
  const float* G;
  { int tk = task; int b = tk >> 4; n = 256; t0 = (tk & 15) * 16; rowbase = (size_t)NLAT + b * 256; G = ((l & 1) ? WSP(float, OFF_GFC2) : WSP(float, OFF_GFC)) + (size_t)stage * 511 * 256; }
  const bfr* U = (stage == 0 ? WSP(bfr, OFF_HVC) : WSP(bfr, OFF_HZC)) - (size_t)NLAT * 256;
  float acc[16];
#pragma unroll
  for (int i = 0; i < 16; ++i) acc[i] = 0.f;
  for (int s0 = 0; s0 < n; s0 += 16) {
    float u[16], w[31];
#pragma unroll
    for (int j = 0; j < 16; ++j) u[j] = bf2f(U[(rowbase + s0 + j) * 256 + c]);
    const float* Gb = G + (size_t)(t0 - s0 - 15 + n - 1) * 256 + c;
#pragma unroll
    for (int m = 0; m < 31; ++m) w[m] = Gb[(size_t)m * 256];
#pragma unroll
    for (int i = 0; i < 16; ++i)
#pragma unroll
      for (int j = 0; j < 16; ++j) acc[i] += w[i - j + 15] * u[j];
  }
  const bfr* ph = WSP(bfr, OFF_PHY);
  const float* hw = p.in[13] + l * 3 * 768;
  const int xc = 256 + stage * 256 + c;
  float w0 = hw[xc], w1 = hw[768 + xc], w2 = hw[1536 + xc];
#pragma unroll
  for (int i = 0; i < 16; ++i) {
    int t = t0 + i;
    size_t row = rowbase + t;
    float xg = w1 * bf2f(ph[row * 768 + xc]);
    if (t > 0) xg += w0 * bf2f(ph[(row - 1) * 768 + xc]);
    if (t < n - 1) xg += w2 * bf2f(ph[(row + 1) * 768 + xc]);
    float val = xg * acc[i];
    if (stage == 0) (WSP(bfr, OFF_HZC) - (size_t)NLAT * 256)[row * 256 + c] = f2bf(val);
    else WSP(bfr, OFF_HN)[row * 1024 + 256 + c] = f2bf(val);
  }
}

__device__ __forceinline__ bf16x8 toep_frag(const unsigned* Rs, int e0) {
  const int dw = e0 >> 1;
  const unsigned sh = (unsigned)(e0 & 1) * 16u;
  unsigned d0 = Rs[dw], d1 = Rs[dw + 1], d2 = Rs[dw + 2], d3 = Rs[dw + 3], d4 = Rs[dw + 4];
  uint4 o;
  o.x = __builtin_amdgcn_alignbit(d1, d0, sh);
  o.y = __builtin_amdgcn_alignbit(d2, d1, sh);
  o.z = __builtin_amdgcn_alignbit(d3, d2, sh);
  o.w = __builtin_amdgcn_alignbit(d4, d3, sh);
  return __builtin_bit_cast(bf16x8, o);
}
__device__ __forceinline__ void hy_task(const Params& p, int l, int task, char* smemc) {
  const int tid = tidx(), lane = tid & 63, wave = tid >> 6, r = lane & 31, hf = lane >> 5;
  const int c = task >> 1, bh = task & 1;
  unsigned* Rs = (unsigned*)smemc;
  bfr* Us = (bfr*)(smemc + 16384 + 64);
  constexpr int USTR = 4104;
  const int bl = r & 3, t1l = r >> 2;
  f32x16 acc[2][2];
  __syncthreads();
  for (int i = tid; i < 2048; i += 256) {
    int b4 = i >> 9, c16 = i & 511;
    *(uint4*)(Us + b4 * USTR + c16 * 8) = *(const uint4*)(WSP(bfr, OFF_HVT) + ((size_t)(c * 8 + bh * 4 + b4)) * 4096 + c16 * 8);
  }
#pragma unroll 1
  for (int stage = 0; stage < 2; ++stage) {
    {
      const uint4* rsrc = (const uint4*)(WSP(bfr, OFF_RF) + (size_t)(l & 1) * (4 * MIB) + ((size_t)(stage * 256 + c)) * 8192);
      for (int i = tid; i < 1024; i += 256) ((uint4*)Rs)[i] = rsrc[i];
      if (tid < 8) Rs[4096 + tid] = 0u;
    }
    __syncthreads();
#pragma unroll
    for (int a = 0; a < 2; ++a)
#pragma unroll
      for (int m = 0; m < 2; ++m)
#pragma unroll
        for (int i = 0; i < 16; ++i) acc[a][m][i] = 0.f;
#pragma unroll 1
    for (int d1 = 16 * wave - 63; d1 <= 16 * wave + 15; ++d1) {
      const int eb = 4096 - 64 * d1 - r + 8 * hf;
      bf16x8 f0 = toep_frag(Rs, eb);
      bf16x8 f1 = toep_frag(Rs, eb + 16);
      bf16x8 f2 = toep_frag(Rs, eb + 32);
      bf16x8 f3 = toep_frag(Rs, eb + 48);
      bf16x8 f4 = toep_frag(Rs, eb - 32);
      bf16x8 f5 = toep_frag(Rs, eb - 16);
#pragma unroll
      for (int nt = 0; nt < 2; ++nt) {
        const int t1lo = 16 * wave + 8 * nt;
        if (t1lo + 7 - d1 < 0 || t1lo - d1 > 63) continue;
        const int s1 = t1lo + t1l - d1;
        const bool valid = (s1 >= 0) && (s1 < 64);
        const bfr* up = Us + bl * USTR + 64 * (valid ? s1 : 0) + 8 * hf;
        bf16x8 b0 = *(const bf16x8*)(up), b1 = *(const bf16x8*)(up + 16), b2 = *(const bf16x8*)(up + 32), b3 = *(const bf16x8*)(up + 48);
        if (!valid) {
#pragma unroll
          for (int i = 0; i < 8; ++i) { b0[i] = 0; b1[i] = 0; b2[i] = 0; b3[i] = 0; }
        }
        acc[nt][0] = __builtin_amdgcn_mfma_f32_32x32x16_bf16(f0, b0, acc[nt][0], 0, 0, 0);
        acc[nt][0] = __builtin_amdgcn_mfma_f32_32x32x16_bf16(f1, b1, acc[nt][0], 0, 0, 0);
        acc[nt][0] = __builtin_amdgcn_mfma_f32_32x32x16_bf16(f2, b2, acc[nt][0], 0, 0, 0);
        acc[nt][0] = __builtin_amdgcn_mfma_f32_32x32x16_bf16(f3, b3, acc[nt][0], 0, 0, 0);
        acc[nt][1] = __builtin_amdgcn_mfma_f32_32x32x16_bf16(f4, b0, acc[nt][1], 0, 0, 0);
        acc[nt][1] = __builtin_amdgcn_mfma_f32_32x32x16_bf16(f5, b1, acc[nt][1], 0, 0, 0);
        acc[nt][1] = __builtin_amdgcn_mfma_f32_32x32x16_bf16(f0, b2, acc[nt][1], 0, 0, 0);
        acc[nt][1] = __builtin_amdgcn_mfma_f32_32x32x16_bf16(f1, b3, acc[nt][1], 0, 0, 0);
      }
    }
    const bfr* gate = WSP(bfr, stage == 0 ? OFF_X1T : OFF_X2T) + ((size_t)(c * 8 + bh * 4 + bl)) * 4096;
    __syncthreads();
#pragma unroll
    for (int nt = 0; nt < 2; ++nt)
#pragma unroll
      for (int m = 0; m < 2; ++m)
#pragma unroll
        for (int g = 0; g < 4; ++g) {
          const int t = 64 * (16 * wave + 8 * nt + t1l) + 32 * m + 8 * g + 4 * hf;
          uint2 gw = *(const uint2*)(gate + t);
          float v0 = acc[nt][m][4 * g + 0] * __uint_as_float(gw.x << 16);
          float v1 = acc[nt][m][4 * g + 1] * __uint_as_float(gw.x & 0xffff0000u);
          float v2 = acc[nt][m][4 * g + 2] * __uint_as_float(gw.y << 16);
          float v3 = acc[nt][m][4 * g + 3] * __uint_as_float(gw.y & 0xffff0000u);
          uint2 o; o.x = pk2(v0, v1); o.y = pk2(v2, v3);
          *(uint2*)(Us + bl * USTR + t) = o;
        }
  }
  __syncthreads();
  for (int i = tid; i < 2048; i += 256) {
    int b4 = i >> 9, c16 = i & 511;
    *(uint4*)(WSP(bfr, OFF_HVT) + ((size_t)(c * 8 + bh * 4 + b4)) * 4096 + c16 * 8) = *(const uint4*)(Us + b4 * USTR + c16 * 8);
  }
}

__device__ __forceinline__ void attn_task(const Params& p, int l, int task, char* smemc) {
  const int tid = tidx(), lane = tid & 63, wave = tid >> 6, r = lane & 31, hf = lane >> 5;
  int b, h, q0, kbeg;
  size_t qrowbase;
  if (task < 1024) { b = task >> 7; h = (task >> 5) & 3; q0 = (task & 31) * 128; qrowbase = (size_t)b * 4096; kbeg = 0; }
  else { int tk = task - 1024; b = tk >> 3; h = (tk >> 1) & 3; q0 = (tk & 1) * 128; qrowbase = (size_t)NLAT + b * 256; kbeg = 4096; }
  bfr* Ks = (bfr*)smemc;
  bfr* Vs = Ks + 2 * 64 * 72;
  const bfr* pd = WSP(bfr, OFF_PDA);
  const bfr* vt = WSP(bfr, OFF_VT) + (size_t)((b * 4 + h) * 64) * 4352;
  const size_t qrow = qrowbase + q0 + wave * 32 + r;
  bf16x8 qf[2][2];
#pragma unroll
  for (int j = 0; j < 2; ++j)
#pragma unroll
    for (int s = 0; s < 2; ++s) qf[j][s] = *(const bf16x8*)(pd + qrow * 768 + h * 64 + j * 32 + 16 * s + 8 * hf);
  float mq = 0.f, mk = 0.f;
  for (int i = 0; i < 32; ++i) { mq = fmaxf(mq, fabsf(p.in[25][l * 32 + i])); mk = fmaxf(mk, fabsf(p.in[26][l * 32 + i])); }
  const float Mb = 5.6568542f * 1.03f * mq * mk * 1.44269504f;
  f32x16 O[2][2];
#pragma unroll
  for (int j = 0; j < 2; ++j)
#pragma unroll
    for (int d = 0; d < 2; ++d)
#pragma unroll
      for (int i = 0; i < 16; ++i) O[j][d][i] = 0.f;
  float ls[2] = {0.f, 0.f};
  const int nt = (4352 - kbeg) >> 6;
  const int lrow = tid >> 3, lpart = (tid & 7) * 8;
  uint4 rk0, rk1, rv0, rv1;
  auto kptr = [&](int k0, int rowi) -> const bfr* {
    int kidx = k0 + rowi;
    size_t krow = kidx < 4096 ? (size_t)b * 4096 + kidx : (size_t)NLAT + b * 256 + (kidx - 4096);
    return pd + krow * 768 + 256 + h * 64 + lpart;
  };
  rk0 = *(const uint4*)kptr(kbeg, lrow);
  rk1 = *(const uint4*)kptr(kbeg, lrow + 32);
  rv0 = *(const uint4*)(vt + (size_t)lrow * 4352 + kbeg + lpart);
  rv1 = *(const uint4*)(vt + (size_t)(lrow + 32) * 4352 + kbeg + lpart);
  __syncthreads();
  *(uint4*)(Ks + (lrow)*72 + lpart) = rk0;
  *(uint4*)(Ks + (lrow + 32) * 72 + lpart) = rk1;
  *(uint4*)(Vs + (lrow)*72 + lpart) = rv0;
  *(uint4*)(Vs + (lrow + 32) * 72 + lpart) = rv1;
  __syncthreads();
  for (int kt = 0; kt < nt; ++kt) {
    const int cur = kt & 1;
    if (kt + 1 < nt) {
      const int k0 = kbeg + (kt + 1) * 64;
      rk0 = *(const uint4*)kptr(k0, lrow);
      rk1 = *(const uint4*)kptr(k0, lrow + 32);
      rv0 = *(const uint4*)(vt + (size_t)lrow * 4352 + k0 + lpart);
      rv1 = *(const uint4*)(vt + (size_t)(lrow + 32) * 4352 + k0 + lpart);
    }
#pragma unroll
    for (int sub = 0; sub < 2; ++sub) {
      bf16x8 vf[2][2];
#pragma unroll
      for (int d = 0; d < 2; ++d)
#pragma unroll
        for (int s = 0; s < 2; ++s) vf[d][s] = *(const bf16x8*)(Vs + (cur * 64 + d * 32 + r) * 72 + sub * 32 + 16 * s + 8 * hf);
#pragma unroll
      for (int j = 0; j < 2; ++j) {
        bf16x8 kf0 = *(const bf16x8*)(Ks + (cur * 64 + sub * 32 + r) * 72 + j * 32 + 8 * hf);
        bf16x8 kf1 = *(const bf16x8*)(Ks + (cur * 64 + sub * 32 + r) * 72 + j * 32 + 16 + 8 * hf);
        f32x16 S;
#pragma unroll
        for (int i = 0; i < 16; ++i) S[i] = -Mb;
        __builtin_amdgcn_s_setprio(1);
        S = __builtin_amdgcn_mfma_f32_32x32x16_bf16(kf0, qf[j][0], S, 0, 0, 0);
        S = __builtin_amdgcn_mfma_f32_32x32x16_bf16(kf1, qf[j][1], S, 0, 0, 0);
        __builtin_amdgcn_s_setprio(0);
#pragma unroll
        for (int i = 0; i < 16; ++i) S[i] = __builtin_amdgcn_exp2f(S[i]);
        v2f ps2 = {0.f, 0.f};
#pragma unroll
        for (int i = 0; i < 8; ++i) ps2 += (v2f){S[2 * i], S[2 * i + 1]};
        ls[j] += ps2.x + ps2.y;
        unsigned pw[8];
#pragma unroll
        for (int i = 0; i < 8; ++i) pw[i] = pk2(S[2 * i], S[2 * i + 1]);
        bf16x8 pf0 = __builtin_bit_cast(bf16x8, (uint4){pw[0], pw[1], pw[2], pw[3]});
        bf16x8 pf1 = __builtin_bit_cast(bf16x8, (uint4){pw[4], pw[5], pw[6], pw[7]});
        __builtin_amdgcn_s_setprio(1);
#pragma unroll
        for (int d = 0; d < 2; ++d) {
          O[j][d] = __builtin_amdgcn_mfma_f32_32x32x16_bf16(vf[d][0], pf0, O[j][d], 0, 0, 0);
          O[j][d] = __builtin_amdgcn_mfma_f32_32x32x16_bf16(vf[d][1], pf1, O[j][d], 0, 0, 0);
        }
        __builtin_amdgcn_s_setprio(0);
      }
    }
    if (kt + 1 < nt) {
      const int nx = cur ^ 1;
      *(uint4*)(Ks + (nx * 64 + lrow) * 72 + lpart) = rk0;
      *(uint4*)(Ks + (nx * 64 + lrow + 32) * 72 + lpart) = rk1;
      *(uint4*)(Vs + (nx * 64 + lrow) * 72 + lpart) = rv0;
      *(uint4*)(Vs + (nx * 64 + lrow + 32) * 72 + lpart) = rv1;
    }
    __syncthreads();
  }
  ls[0] += __shfl_xor(ls[0], 32);
  ls[1] += __shfl_xor(ls[1], 32);
  const float* lp = p.in[27] + l * 128;
  float d01 = 0.f, d23 = 0.f;
  for (int i = 0; i < 32; ++i) { d01 += lp[i] * lp[32 + i]; d23 += lp[64 + i] * lp[96 + i]; }
  const float lam_init = 0.8f - 0.6f * expf(-0.3f * (float)l);
  const float lam = expf(d01) - expf(d23) + lam_init;
  const float i0 = 1.f / ls[0], i1 = lam / ls[1];
  float ss = 0.f;
#pragma unroll
  for (int d = 0; d < 2; ++d)
#pragma unroll
    for (int i = 0; i < 16; ++i) { float o = O[0][d][i] * i0 - O[1][d][i] * i1; O[0][d][i] = o; ss += o * o; }
  ss += __shfl_xor(ss, 32);
  const float rn = rsqrtf(ss * (1.f / 64.f) + 1e-6f) * (1.f - lam_init);
  const float* sw = p.in[28] + l * 64;
  bfr* op = WSP(bfr, OFF_HN) + qrow * 1024 + 768 + h * 64;
#pragma unroll
  for (int d = 0; d < 2; ++d)
#pragma unroll
    for (int g = 0; g < 4; ++g) {
      const int dv = d * 32 + 8 * g + 4 * hf;
      float4 w4 = *(const float4*)(sw + dv);
      uint2 o;
      o.x = pk2(O[0][d][4 * g + 0] * rn * w4.x, O[0][d][4 * g + 1] * rn * w4.y);
      o.y = pk2(O[0][d][4 * g + 2] * rn * w4.z, O[0][d][4 * g + 3] * rn * w4.w);
      *(uint2*)(op + dv) = o;
    }
}

__device__ __forceinline__ void finish_task(const Params& p, int l, int task  , char* smemc) {
  const int tid = tidx();
  if (task < 1024) {
    bfr* tile = (bfr*)smemc;
    const int row0 = task * 32, bb = row0 >> 12, t0 = row0 & 4095;
    const bfr* src = WSP(bfr, OFF_HVT) + ((size_t)(tid * 8 + bb)) * 4096 + t0;
#pragma unroll
    for (int i = 0; i < 4; ++i) *(uint4*)(tile + tid * 40 + 8 * i) = ((const uint4*)src)[i];
    __syncthreads();
    const int rr = tid >> 3, part = tid & 7;
    bfr* dst = WSP(bfr, OFF_HN) + (size_t)(row0 + rr) * 1024 + 256 + part * 32;
#pragma unroll
    for (int i = 0; i < 4; ++i) {
      unsigned w[4];
#pragma unroll
      for (int q = 0; q < 4; ++q) {
        const int c0 = part * 32 + i * 8 + q * 2;
        w[q] = (unsigned)tile[c0 * 40 + rr] | ((unsigned)tile[(c0 + 1) * 40 + rr] << 16);
      }
      ((uint4*)dst)[i] = (uint4){w[0], w[1], w[2], w[3]};
    }
    __syncthreads();
  }
  const int rr = tid >> 3, hd = tid & 7;
  const size_t row = (size_t)task * 32 + rr;
  const bfr *pf, *pb, *pgt;
  const float* nw;
  bfr* dst;
  if (hd < 4) {
    const bfr* r = WSP(bfr, OFF_PGDN) + row * 1024;
    pf = r + hd * 64; pb = r + 256 + hd * 64; pgt = r + 768 + hd * 64;
    nw = p.in[12] + l * 64; dst = WSP(bfr, OFF_HN) + row * 1024 + hd * 64;
  } else {
    const int hh = hd - 4;
    const bfr* r = WSP(bfr, OFF_PHG) + row * 1280;
    pf = r + 512 + hh * 64; pb = r + 768 + hh * 64; pgt = r + 1024 + hh * 64;
    nw = p.in[24] + l * 64; dst = WSP(bfr, OFF_HN) + row * 1024 + 512 + hh * 64;
  }
  uint4 vf[8], vb[8], vg[8];
#pragma unroll
  for (int i = 0; i < 8; ++i) { vf[i] = ((const uint4*)pf)[i]; vb[i] = ((const uint4*)pb)[i]; vg[i] = ((const uint4*)pgt)[i]; }
  float o[64];
  float ss = 0.f;
#pragma unroll
  for (int i = 0; i < 8; ++i) {
    const unsigned a[4] = {vf[i].x, vf[i].y, vf[i].z, vf[i].w};
    const unsigned c[4] = {vb[i].x, vb[i].y, vb[i].z, vb[i].w};
#pragma unroll
    for (int q = 0; q < 4; ++q) {
      float lo = __uint_as_float(a[q] << 16) + __uint_as_float(c[q] << 16);
      float hi = __uint_as_float(a[q] & 0xffff0000u) + __uint_as_float(c[q] & 0xffff0000u);
      o[8 * i + 2 * q] = lo; o[8 * i + 2 * q + 1] = hi;
      ss += lo * lo + hi * hi;
    }
  }
  const float rn = rsqrtf(ss * (1.f / 64.f) + 1e-6f);
#pragma unroll
  for (int i = 0; i < 8; ++i) {
    const unsigned g[4] = {vg[i].x, vg[i].y, vg[i].z, vg[i].w};
    unsigned w[4];
#pragma unroll
    for (int q = 0; q < 4; ++q) {
      float g0 = __uint_as_float(g[q] << 16), g1 = __uint_as_float(g[q] & 0xffff0000u);
      float y0 = o[8 * i + 2 * q] * rn * nw[8 * i + 2 * q] * siluf_(g0);
      float y1 = o[8 * i + 2 * q + 1] * rn * nw[8 * i + 2 * q + 1] * siluf_(g1);
      w[q] = pk2(y0, y1);
    }
    ((uint4*)dst)[i] = (uint4){w[0], w[1], w[2], w[3]};
  }
}

__global__ void __launch_bounds__(256, 2) mega(Params p) {
  extern __shared__ __attribute__((aligned(1024))) char smemc[];
  __shared__ int s_task;
  float* smem = (float*)smemc;
  cg::grid_group grid = cg::this_grid();
  unsigned* ctr = WSP(unsigned, OFF_CTR);
  const int G = gridDim.x, bid = blockIdx.x;

  __shared__ uint4 xb_words;
  if (threadIdx.x == 0) xb_words = make_uint4(0u, 0u, 0u, 0u);
  __syncthreads();
  XcdBarrier xb = xcd_barrier_post(WSP(unsigned, OFF_CTR) + 1024, (volatile LAS unsigned*)&xb_words);
  phase_mod(p, smem);
  for (int task = G - 1 - bid; task < 272; task += G) { int l0 = 0; asm volatile("" : "+s"(l0)); filt_task(p, l0, task, smem); }
  grid.sync();

  for (int l = 0; l < 4; ++l) {
    const bool want_ctx = l < 3;
    for (int task = bid; task < 3296; task += 2 * G) {
      int lq = l; asm volatile("" : "+s"(lq));
      wconv_pair(p, lq, task, task + G < 3296 ? task + G : -1, smem);
    }
    for (int task = bid; task < 1088; task += G) {
      int lq = l; asm volatile("" : "+s"(lq));
      norm_rows(p, lq, 0, task);
    }
    xcd_barrier(xb);
    { int lq = l; asm volatile("" : "+s"(lq));
    gemm_phase<0>(p, lq, WSP(bfr, OFF_HN), 1024, WSP(bfr, OFF_WIN), 1024, 136, 31, smemc); }
    xcd_barrier(xb);
    for (int task = bid; task < 1088 + 2176; task += G) {
      int lq = l; asm volatile("" : "+s"(lq));
      if (task < 2176) gdn_solve_task(p, lq, task, smemc);
      else prep_task(p, lq, task - 2176, smemc);
    }
    xcd_barrier(xb);
    {
      const int nhy = want_ctx ? 640 : 512, nat = want_ctx ? 1088 : 1024;
      const int nflt = want_ctx ? 272 : 0;
      const int total = 128 + nhy + nat + nflt;
      while (true) {
        __syncthreads();
        if (threadIdx.x == 0) s_task = (int)atomicAdd(&ctr[l * 2], 1u);
        __syncthreads();
        int task = s_task;
        if (task >= total) break;
        int lq = l; asm volatile("" : "+s"(lq));
        if (task < 64) gdn_chunked(p, lq, task, smemc);
        else if (task < 128) hgrn_chunked(p, lq, task - 64, smemc);
        else if (task < 128 + 512) hy_task(p, lq, task - 128, smemc);
        else if (task < 128 + nhy) hy_conv(p, lq, 0, task - 640);
        else if (task < 128 + nhy + nat) attn_task(p, lq, task - 128 - nhy, smemc);
        else filt_task(p, lq + 1, task - 128 - nhy - nat, smem);
      }
    }
    xcd_barrier(xb);
    {
      const int nhy = want_ctx ? 128 : 0, nfin = want_ctx ? 1088 : 1024;
      const int total = nhy + nfin;
      while (true) {
        __syncthreads();
        if (threadIdx.x == 0) s_task = (int)atomicAdd(&ctr[l * 2 + 1], 1u);
        __syncthreads();
        int task = s_task;
        if (task >= total) break;
        int lq = l; asm volatile("" : "+s"(lq));
        if (task < nhy) hy_conv(p, lq, 1, task);
        else finish_task(p, lq, task - nhy, smemc);
      }
    }
    xcd_barrier(xb);
    const int mt = want_ctx ? 136 : 128;
    { int lq = l; asm volatile("" : "+s"(lq));
    gemm_phase<1>(p, lq, WSP(bfr, OFF_HN), 1024, WSP(bfr, OFF_WOUT), 1024, mt, 8, smemc); }
    xcd_barrier(xb);
    for (int task = bid; task < mt * 8; task += G) { int lq = l; asm volatile("" : "+s"(lq)); norm_rows(p, lq, 1, task); }
    xcd_barrier(xb);
    { int lq = l; asm volatile("" : "+s"(lq));
    gemm_phase<2>(p, lq, WSP(bfr, OFF_HN), 1024, WSP(bfr, OFF_W1), 1024, mt, 32, smemc); }
    xcd_barrier(xb);
    { int lq = l; asm volatile("" : "+s"(lq));
    gemm_phase<3>(p, lq, WSP(bfr, OFF_HID), 4096, WSP(bfr, OFF_W2), 4096, mt, 8, smemc); }
    if (l < 3) xcd_barrier(xb);
  }
}

extern "C" void kernel_launch(void* const* d_in, const int* in_sizes, int n_in, void* d_out, int out_size, void* d_ws, size_t ws_size,
                              hipStream_t stream) {
  static int grid_blocks = 0;
  if (!grid_blocks) {
    int dev = 0, cus = 0, per_cu = 0;
    hipGetDevice(&dev);
    hipDeviceGetAttribute(&cus, hipDeviceAttributeMultiprocessorCount, dev);
    (void)hipFuncSetAttribute((const void*)mega, hipFuncAttributeMaxDynamicSharedMemorySize, LDS_BYTES);
    hipOccupancyMaxActiveBlocksPerMultiprocessor(&per_cu, mega, 256, LDS_BYTES);
    if (per_cu < 1) per_cu = 1;
    if (per_cu > 2) per_cu = 2;
    grid_blocks = cus * per_cu;
    if (ws_size < WS_NEED) fprintf(stderr, "kernel_launch: workspace too small: %zu < %zu\n", ws_size, (size_t)WS_NEED);
  }
  Params p{};
  for (int i = 0; i < 32; ++i) p.in[i] = (const float*)d_in[i];
  p.out = (float*)d_out;
  p.ws = (unsigned char*)d_ws;
  hipMemsetAsync(d_ws, 0, 32768, stream);
  void* args[] = {&p};
  hipError_t e = hipLaunchCooperativeKernel((void*)mega, dim3(grid_blocks), dim3(256), args, LDS_BYTES, stream);
  if (e != hipSuccess) fprintf(stderr, "cooperative launch failed: %s (grid %d)\n", hipGetErrorString(e), grid_blocks);
}
```

```cpp
#include <hip/hip_runtime.h>
#include <hip/hip_bf16.h>
#include <hip/hip_cooperative_groups.h>
#include <cstdio>
#include <cstdint>
namespace cg = cooperative_groups;

typedef unsigned short bfr;
using bf16x8 = __attribute__((ext_vector_type(8))) short;
using f32x4 = __attribute__((ext_vector_type(4))) float;

#define NLAT 32768
#define NCTX 2048
#define NTOK 34816
#define MIB ((size_t)1 << 20)
#define OFF_CTR 0
#define OFF_MOD (1 * MIB)
#define OFF_LB (OFF_MOD + 884736)
#define OFF_ROPE (OFF_LB + 4096)
#define OFF_XC (2 * MIB)
#define OFF_WIN (10 * MIB)
#define OFF_WOUT (OFF_WIN + 8126464)
#define OFF_W1 (OFF_WOUT + 2 * MIB)
#define OFF_W2 (OFF_W1 + 8 * MIB)
#define OFF_HN (36 * MIB)
#define OFF_AB (104 * MIB)
#define OFF_PGDN (107 * MIB)
#define OFF_PHY (175 * MIB)
#define OFF_PHG (226 * MIB)
#define OFF_PDA (311 * MIB)
#define OFF_GQ (362 * MIB)
#define OFF_HVT (413 * MIB)
#define OFF_HVC (429 * MIB)
#define OFF_X1T (430 * MIB)
#define OFF_HZC (446 * MIB)
#define OFF_RF (447 * MIB)
#define OFF_GFC (463 * MIB)
#define OFF_VT (464 * MIB)
#define OFF_X2T (482 * MIB)
#define OFF_SLAB (379 * MIB)
#define OFF_HID OFF_PGDN
#define OFF_GFC2 (498 * MIB)
#define WS_NEED (499 * MIB)
#define LDS_BYTES 73728

struct Params {
  const float* in[32];
  float* out;
  unsigned char* ws;
};

__device__ __forceinline__ float bf2f(bfr v) { return __uint_as_float(((unsigned)v) << 16); }
typedef __attribute__((ext_vector_type(2))) __bf16 bf2v_t;
typedef __attribute__((ext_vector_type(2))) float f2v_t;
using f32x16 = __attribute__((ext_vector_type(16))) float;
__device__ __forceinline__ unsigned pk2(float lo, float hi) {
  f2v_t f = {lo, hi};
  return __builtin_bit_cast(unsigned, __builtin_convertvector(f, bf2v_t));
}
__device__ __forceinline__ bfr f2bf(float f) { return (bfr)(pk2(f, 0.f) & 0xffffu); }
__device__ __forceinline__ float sigmoidf_(float x) { return 1.f / (1.f + expf(-x)); }
__device__ __forceinline__ float siluf_(float x) { return x / (1.f + expf(-x)); }
__device__ __forceinline__ float fsigmoid(float x) { return __builtin_amdgcn_rcpf(1.f + __expf(-x)); }
__device__ __forceinline__ float wave_sum(float v) {
#pragma unroll
  for (int o = 32; o >= 1; o >>= 1) v += __shfl_xor(v, o);
  return v;
}
__device__ __forceinline__ float quad_sum(float v) {
  v += __int_as_float(__builtin_amdgcn_mov_dpp(__float_as_int(v), 0xB1, 0xF, 0xF, true));
  v += __int_as_float(__builtin_amdgcn_mov_dpp(__float_as_int(v), 0x4E, 0xF, 0xF, true));
  return v;
}
typedef float v2f __attribute__((ext_vector_type(2)));

__device__ __forceinline__ int tidx() { int t = threadIdx.x; asm volatile("" : "+v"(t)); return t; }
#define WSP(T, off) ((T*)(p.ws + (off)))


#define XB_TMO      128
#define XB_XCNT(j)  (256  + 64 * (j))
#define XB_XSUB(j)  (1280 + 64 * (j))
#define XB_XGEN(j)  (2304 + 64 * (j))
#define XB_TOP      3328
#define XB_TOPGEN   3392
#define XCD_BAR_WORDS 3456
#define XB_SPIN_CAP (1u << 24)
#define LAS __attribute__((address_space(3)))
__device__ __forceinline__ unsigned xb_ld(unsigned* p) { return __hip_atomic_load(p, __ATOMIC_RELAXED, __HIP_MEMORY_SCOPE_AGENT); }
__device__ __forceinline__ unsigned xb_add(unsigned* p, unsigned v) { return __hip_atomic_fetch_add(p, v, __ATOMIC_RELAXED, __HIP_MEMORY_SCOPE_AGENT); }
__device__ __forceinline__ unsigned xb_xcc_id() { return (unsigned)__builtin_amdgcn_s_getreg((3 << 11) | 20) & 0xFu; }
#define XB_SPIN(cond, bar) do { unsigned _sp = 0; while (cond) { __builtin_amdgcn_s_sleep(1); \
    if ((++_sp & 255u) == 0u) { if (xb_ld(&(bar)[XB_TMO])) break; if (_sp > XB_SPIN_CAP) { atomicAdd(&(bar)[XB_TMO], 1u); break; } } } } while (0)
struct XcdBarrier { unsigned* bar; unsigned x; volatile LAS unsigned* st; };
__device__ __forceinline__ XcdBarrier xcd_barrier_post(unsigned* bar, volatile LAS unsigned* st) {
  XcdBarrier b; b.bar = bar; b.x = xb_xcc_id(); b.st = st;
  if (threadIdx.x == 0) (void)xb_add(&bar[XB_XCNT(b.x)], 1u);
  return b;
}
__device__ __forceinline__ void xcd_barrier_complete(unsigned* bar, unsigned x, unsigned& nloc, unsigned& nx) {
  const unsigned G = gridDim.x * gridDim.y * gridDim.z;
  unsigned sum, cnt, mine, sp = 0u;
  for (;;) {
    sum = 0u; cnt = 0u; mine = 0u;
#pragma unroll
    for (unsigned j = 0; j < 16; ++j) { const unsigned c = xb_ld(&bar[XB_XCNT(j)]); sum += c; cnt += (c > 0u) ? 1u : 0u; mine = (j == x) ? c : mine; }
    if (sum == G) break;
    __builtin_amdgcn_s_sleep(1);
    if ((++sp & 255u) == 0u) { if (xb_ld(&bar[XB_TMO])) break; if (sp > XB_SPIN_CAP) { atomicAdd(&bar[XB_TMO], 1u); break; } }
  }
  nloc = mine > 0u ? mine : 1u; nx = cnt > 0u ? cnt : 1u;
}
__device__ __forceinline__ void xcd_barrier(const XcdBarrier& b) {
  asm volatile("s_waitcnt vmcnt(0)" ::: "memory");
  __syncthreads();
  if (threadIdx.x == 0) {
    unsigned* bar = b.bar;
    __builtin_amdgcn_s_waitcnt(0);
    unsigned nloc = b.st[0], nx = b.st[1];
    if (nloc == 0u) { xcd_barrier_complete(bar, b.x, nloc, nx); b.st[0] = nloc; b.st[1] = nx; }
    const unsigned old = xb_add(&bar[XB_XSUB(b.x)], 1u);
    const unsigned gen = old / nloc;
    if (old + 1u == (gen + 1u) * nloc) {
      __builtin_amdgcn_fence(__ATOMIC_RELEASE, "agent");
      asm volatile("s_waitcnt vmcnt(0)" ::: "memory");
      const unsigned og = xb_add(&bar[XB_TOP], 1u);
      const unsigned tg = og / nx;
      if (og + 1u == (tg + 1u) * nx) xb_add(&bar[XB_TOPGEN], 1u);
      else XB_SPIN(xb_ld(&bar[XB_TOPGEN]) == tg, bar);
      __builtin_amdgcn_fence(__ATOMIC_ACQUIRE, "agent");
      xb_add(&bar[XB_XGEN(b.x)], 1u);
      asm volatile("s_waitcnt vmcnt(0)" ::: "memory");
    } else {
      XB_SPIN(xb_ld(&bar[XB_XGEN(b.x)]) == gen, bar);
      __builtin_amdgcn_fence(__ATOMIC_ACQUIRE, "agent");
      asm volatile("s_waitcnt vmcnt(0)" ::: "memory");
    }
  }
  __syncthreads();
}

__device__ __forceinline__ void phase_mod(const Params& p, float* smem) {
  const int tid = tidx();
  float* sc = smem;
  float* red = smem + 9 * 1024;
  float* mod = WSP(float, OFF_MOD);
  bool loaded = false;
  for (int task = blockIdx.x; task < 4 * 96; task += gridDim.x) {
    if (!loaded) {
      for (int i = tid; i < 9 * 1024; i += 256) {
        int m = i >> 10, k = i & 1023;
        float v = m < 8 ? p.in[1][m * 1024 + k] : p.in[3][k];
        sc[i] = siluf_(v);
      }
      __syncthreads();
      loaded = true;
    }
    int l = task / 96, cgp = task % 96;
    int col = cgp * 64 + (tid & 63), ks = tid >> 6;
    const float* w = p.in[4] + (size_t)l * 1024 * 6144 + col;
    float acc[9];
#pragma unroll
    for (int m = 0; m < 9; ++m) acc[m] = 0.f;
#pragma unroll 16
    for (int k = ks * 256; k < ks * 256 + 256; ++k) {
      float wv = w[(size_t)k * 6144];
#pragma unroll
      for (int m = 0; m < 9; ++m) acc[m] += sc[m * 1024 + k] * wv;
    }
#pragma unroll
    for (int m = 0; m < 9; ++m) red[(ks * 9 + m) * 64 + (tid & 63)] = acc[m];
    __syncthreads();
    if (tid < 64) {
#pragma unroll
      for (int m = 0; m < 9; ++m) {
        float s = red[(0 * 9 + m) * 64 + tid] + red[(1 * 9 + m) * 64 + tid] + red[(2 * 9 + m) * 64 + tid] + red[(3 * 9 + m) * 64 + tid];
        mod[(size_t)(l * 9 + m) * 6144 + col] = s + p.in[5][l * 6144 + col];
      }
    }
    __syncthreads();
  }
  if (blockIdx.x == gridDim.x - 2) {
    float* rope = WSP(float, OFF_ROPE);
    for (int e = tid; e < 512; e += 256) {
      const int pos = e >> 3, i = e & 7;
      const float inv = powf(10000.f, -(float)i / 8.f);
      float sn, cs;
      sincosf((float)pos * inv, &sn, &cs);
      rope[pos * 16 + i] = cs;
      rope[pos * 16 + 8 + i] = sn;
    }
  }
  if (blockIdx.x == gridDim.x - 1) {
    int c = tid;
    const float* raw = p.in[23];
    float r0 = raw[c], r1 = raw[256 + c], r2 = raw[512 + c], r3 = raw[768 + c];
    float mx = fmaxf(fmaxf(r0, r1), fmaxf(r2, r3));
    float e0 = expf(r0 - mx), e1 = expf(r1 - mx), e2 = expf(r2 - mx), e3 = expf(r3 - mx);
    float inv = 1.f / (e0 + e1 + e2 + e3);
    float* lb = WSP(float, OFF_LB);
    lb[c] = 0.f;
    lb[256 + c] = e1 * inv;
    lb[512 + c] = (e1 + e2) * inv;
    lb[768 + c] = (e1 + e2 + e3) * inv;
  }
}

__device__ __forceinline__ const float* xin_row(const Params& p, int l, int row) {
  if (row < NLAT) return (l == 0 ? p.in[0] : (const float*)p.out) + (size_t)row * 1024;
  return (l == 0 ? p.in[2] : (const float*)WSP(float, OFF_XC)) + (size_t)(row - NLAT) * 1024;
}
__device__ __forceinline__ float* xout_row(const Params& p, int row) {
  if (row < NLAT) return p.out + (size_t)row * 1024;
  return WSP(float, OFF_XC) + (size_t)(row - NLAT) * 1024;
}
__device__ __forceinline__ int mod_idx(int row) { return row < NLAT ? (row >> 12) : 8; }

__device__ __forceinline__ void norm_rows(const Params& p, int l, int which, int task  ) {
  const int tid = tidx(), lane = tid & 63, wave = tid >> 6;
  const float* lnw = p.in[which == 0 ? 6 : 7] + l * 1024;
  bfr* hn = WSP(bfr, OFF_HN);
  const int row0 = task * 32;
  const float* mv = WSP(float, OFF_MOD) + (size_t)(l * 9 + mod_idx(row0)) * 6144 + (which == 0 ? 0 : 3072);
  const bool fold = (which == 0) && (l >= 1) && (row0 >= NLAT);
  {
    constexpr int g = 0;
    float4 v[8][4];
#pragma unroll
    for (int j = 0; j < 8; ++j) {
      const int row = row0 + wave + 4 * (g * 4 + j);
      const float* xr = which == 0 ? xin_row(p, l, row) : (const float*)xout_row(p, row);
#pragma unroll
      for (int i = 0; i < 4; ++i) v[j][i] = ((const float4*)xr)[lane + 64 * i];
    }
    if (fold) {
#pragma unroll
      for (int j = 0; j < 8; ++j) {
        const int row = row0 + wave + 4 * (g * 4 + j), rc = row - NLAT;
#pragma unroll
        for (int i = 0; i < 4; ++i) {
          const int col = 4 * (lane + 64 * i);
          const float* sl = WSP(float, OFF_SLAB) + (size_t)(((rc >> 8) * 8 + (col >> 7)) * 8) * 32768 + (size_t)(rc & 255) * 128 + (col & 127);
          float4 sm = *(const float4*)sl;
#pragma unroll
          for (int ks = 1; ks < 8; ++ks) { const float4 t = *(const float4*)(sl + (size_t)ks * 32768); sm.x += t.x; sm.y += t.y; sm.z += t.z; sm.w += t.w; }
          const float4 g4 = *(const float4*)(WSP(float, OFF_MOD) + (size_t)((l - 1) * 9 + 8) * 6144 + 5120 + col);
          v[j][i].x += g4.x * sm.x; v[j][i].y += g4.y * sm.y; v[j][i].z += g4.z * sm.z; v[j][i].w += g4.w * sm.w;
          ((float4*)xout_row(p, row))[lane + 64 * i] = v[j][i];
        }
      }
    }
    float rj[8];
#pragma unroll
    for (int j = 0; j < 8; ++j) {
      float ss = 0.f;
#pragma unroll
      for (int i = 0; i < 4; ++i) ss += v[j][i].x * v[j][i].x + v[j][i].y * v[j][i].y + v[j][i].z * v[j][i].z + v[j][i].w * v[j][i].w;
      ss = wave_sum(ss);
      rj[j] = rsqrtf(ss * (1.f / 1024.f) + 1e-6f);
    }
#pragma unroll
    for (int i = 0; i < 4; ++i) {
      const int c = 4 * (lane + 64 * i);
      const float4 w = *(const float4*)(lnw + c);
      const float4 sh = *(const float4*)(mv + c);
      const float4 sc = *(const float4*)(mv + 1024 + c);
      const float m0 = w.x * (1.f + sc.x), m1 = w.y * (1.f + sc.y), m2 = w.z * (1.f + sc.z), m3 = w.w * (1.f + sc.w);
#pragma unroll
      for (int j = 0; j < 8; ++j) {
        const int row = row0 + wave + 4 * (g * 4 + j);
        const float r = rj[j];
        ushort4 o;
        o.x = f2bf(v[j][i].x * r * m0 + sh.x);
        o.y = f2bf(v[j][i].y * r * m1 + sh.y);
        o.z = f2bf(v[j][i].z * r * m2 + sh.z);
        o.w = f2bf(v[j][i].w * r * m3 + sh.w);
        *(ushort4*)(hn + (size_t)row * 1024 + c) = o;
      }
    }
  }
}

struct WcTile { const float* src; bfr* dst; int K, N, kt, nt, mode; };
__device__ __forceinline__ WcTile wc_decode(const Params& p, int l, int task) {
  WcTile w; w.mode = 0;
  if (task < 992) { w.src = p.in[8] + (size_t)l * 1024 * 3856; w.dst = WSP(bfr, OFF_WIN); w.K = 1024; w.N = 3856; w.kt = task / 62; w.nt = task % 62; w.mode = 1; }
  else if (task < 992 + 256) { int t = task - 992; w.src = p.in[29] + (size_t)l * 1024 * 1024; w.dst = WSP(bfr, OFF_WOUT); w.K = 1024; w.N = 1024; w.kt = t / 16; w.nt = t % 16; }
  else if (task < 992 + 256 + 1024) { int t = task - 1248; w.src = p.in[30] + (size_t)l * 1024 * 4096; w.dst = WSP(bfr, OFF_W1); w.K = 1024; w.N = 4096; w.kt = t / 64; w.nt = t % 64; }
  else { int t = task - 2272; w.src = p.in[31] + (size_t)l * 4096 * 1024; w.dst = WSP(bfr, OFF_W2); w.K = 4096; w.N = 1024; w.kt = t / 16; w.nt = t % 16; }
  return w;
}
__device__ __forceinline__ void wconv_quad(const Params& p, int l, int t0, int t1, int t2, int t3, float* smem) {
  const int tid = tidx();
  const int tk[4] = {t0, t1, t2, t3};
  const int nl = tid & 63, k0 = tid >> 6;
  float v[4][16];
#pragma unroll
  for (int q = 0; q < 4; ++q) {
    const bool has = tk[q] >= 0;
    const WcTile W = wc_decode(p, l, has ? tk[q] : t0);
    const int np = W.nt * 64 + nl;
    int sc = np;
    if (W.mode == 1) sc = np < 1024 ? np : (np < 3840 ? np + 16 : (np < 3856 ? np - 3840 + 1024 : -1));
#pragma unroll
    for (int i = 0; i < 16; ++i) v[q][i] = (has && sc >= 0) ? W.src[(size_t)(W.kt * 64 + k0 + 4 * i) * W.N + sc] : 0.f;
  }
#pragma unroll
  for (int q = 0; q < 4; ++q)
#pragma unroll
    for (int i = 0; i < 16; ++i) smem[q * (64 * 65) + (k0 + 4 * i) * 65 + nl] = v[q][i];
  __syncthreads();
  {
    const int kl = tid & 63;
#pragma unroll
    for (int q = 0; q < 4; ++q) {
      if (tk[q] >= 0) {
        const WcTile W = wc_decode(p, l, tk[q]);
#pragma unroll
        for (int i = 0; i < 16; ++i) {
          const int n2 = (tid >> 6) + 4 * i;
          W.dst[(size_t)(W.nt * 64 + n2) * W.K + W.kt * 64 + kl] = f2bf(smem[q * (64 * 65) + kl * 65 + n2]);
        }
      }
    }
  }
  __syncthreads();
}

__device__ __forceinline__ void filt_task(const Params& p, int l, int task, float* smem) {
  const int tid = tidx();
  int n, pos0;
  float* G;
  if (task < 256) { n = 4096; pos0 = task * 16; G = nullptr; }
  else { n = 256; pos0 = (task - 256) * 16; G = (l & 1) ? WSP(float, OFF_GFC2) : WSP(float, OFF_GFC); }
  float* zs = smem;
  float* h1s = smem + 16 * 36;
  float* h2t = h1s + 16 * 64;
  const float* w1 = p.in[14] + l * 33 * 64;
  const float* b1 = p.in[15] + l * 64;
  const float* f1 = p.in[16] + l * 64;
  const float* w2 = p.in[17] + l * 64 * 64;
  const float* b2 = p.in[18] + l * 64;
  const float* f2 = p.in[19] + l * 64;
  const float* w3 = p.in[20] + (size_t)l * 64 * 1024;
  const float* dec = p.in[21] + l * 512;
  const float* skp = p.in[22] + l * 512;
  const float inv_nm1 = (n == 4096) ? (1.f / 4095.f) : (1.f / 255.f);
  const float twopi_n = (n == 4096) ? (6.283185307179586f / 4096.f) : (6.283185307179586f / 256.f);
  for (int i = tid; i < 16 * 33; i += 256) {
    int pp = i / 33, e = i % 33;
    float pos = (float)(pos0 + pp);
    float zv;
    if (e == 0) zv = pos * inv_nm1;
    else {
      int bi = (e - 1) & 15;
      float band = 1e-4f + (float)bi * ((15.f - 1e-4f) / 15.f);
      float ang = twopi_n * pos * band;
      zv = (e <= 16) ? cosf(ang) : -sinf(ang);
    }
    zs[pp * 36 + e] = zv;
  }
  __syncthreads();
  for (int i = tid; i < 16 * 64; i += 256) {
    int pp = i >> 6, j = i & 63;
    float a = b1[j];
    for (int e = 0; e < 33; ++e) a += zs[pp * 36 + e] * w1[e * 64 + j];
    h1s[pp * 64 + j] = sinf(f1[j] * a);
  }
  __syncthreads();
  for (int i = tid; i < 16 * 64; i += 256) {
    int pp = i >> 6, j = i & 63;
    float a = b2[j];
    for (int k = 0; k < 64; ++k) a += h1s[pp * 64 + k] * w2[k * 64 + j];
    h2t[j * 16 + pp] = sinf(f2[j] * a);
  }
  __syncthreads();
#pragma unroll 1
  for (int jj = 0; jj < 4; ++jj) {
    int col = tid + 256 * jj;
    float acc[16];
#pragma unroll
    for (int i = 0; i < 16; ++i) acc[i] = 0.f;
#pragma unroll 8
    for (int k = 0; k < 64; ++k) {
      float wv = w3[k * 1024 + col];
      const float4* h4 = (const float4*)(h2t + k * 16);
#pragma unroll
      for (int q = 0; q < 4; ++q) {
        float4 hv = h4[q];
        acc[4 * q + 0] += hv.x * wv; acc[4 * q + 1] += hv.y * wv; acc[4 * q + 2] += hv.z * wv; acc[4 * q + 3] += hv.w * wv;
      }
    }
    int side = col >> 9, f = (col >> 8) & 1, ch = col & 255;
    float dc = fabsf(dec[f * 256 + ch]);
    if (G) {
      float* Gf = G + (size_t)f * (2 * n - 1) * 256;
#pragma unroll
      for (int i = 0; i < 16; ++i) {
        int pos = pos0 + i;
        float val = acc[i] * expf(-(float)pos * inv_nm1 * dc);
        if (side == 0) {
          if (pos == 0) val += skp[f * 256 + ch];
          Gf[(size_t)(pos + n - 1) * 256 + ch] = val;
        } else if (pos >= 1) {
          Gf[(size_t)(n - 1 - pos) * 256 + ch] = val;
        }
      }
    } else {
      bfr* R = WSP(bfr, OFF_RF) + (size_t)(l & 1) * (4 * MIB) + ((size_t)(f * 256 + ch)) * 8192;
#pragma unroll
      for (int i = 0; i < 16; ++i) {
        int pos = pos0 + i;
        float val = acc[i] * expf(-(float)pos * inv_nm1 * dc);
        if (side == 0) {
          if (pos == 0) { val += skp[f * 256 + ch]; R[0] = 0; }
          R[4096 - pos] = f2bf(val);
        } else if (pos >= 1) {
          R[4096 + pos] = f2bf(val);
        }
      }
    }
  }
  __syncthreads();
}

template <bool RELU2>
__device__ __forceinline__ void store_tile_bf16(const f32x4 (&acc)[8][4], bfr* dst, int ld, int row_base, int col_base, bfr* wbuf, int lane) {
  const int fr = lane & 15, fq = lane >> 4;
#pragma unroll
  for (int pass = 0; pass < 2; ++pass) {
#pragma unroll
    for (int mm = 0; mm < 4; ++mm)
#pragma unroll
      for (int n = 0; n < 4; ++n) {
        f32x4 a = acc[4 * pass + mm][n];
        if (RELU2) {
          a[0] = fmaxf(a[0], 0.f); a[1] = fmaxf(a[1], 0.f); a[2] = fmaxf(a[2], 0.f); a[3] = fmaxf(a[3], 0.f);
          a[0] *= a[0]; a[1] *= a[1]; a[2] *= a[2]; a[3] *= a[3];
        }
        uint2 o; o.x = pk2(a[0], a[1]); o.y = pk2(a[2], a[3]);
        *(uint2*)(wbuf + (mm * 16 + fr) * 72 + n * 16 + fq * 4) = o;
      }
#pragma unroll
    for (int q = 0; q < 8; ++q) {
      const int chunk = lane + 64 * q, rowl = chunk >> 3, c16 = chunk & 7;
      const uint4 v = *(const uint4*)(wbuf + rowl * 72 + c16 * 8);
      *(uint4*)(dst + (size_t)(row_base + pass * 64 + rowl) * ld + col_base + c16 * 8) = v;
    }
  }
}

template <int EPI>
__device__ __forceinline__ void gemm_phase(const Params& p, int l, const bfr* A, int lda, const bfr* Bt, int K, int Mtiles, int Ntiles, char* smemc) {
  bfr* sA = (bfr*)smemc;
  bfr* sB = sA + 2 * 256 * 40;
  const int tid = tidx(), wave = __builtin_amdgcn_readfirstlane(tid >> 6), lane = tid & 63;
  const int wr = wave >> 1, wc = wave & 1, fr = lane & 15, fq = lane >> 4;
  const int ntiles = Mtiles * Ntiles;
  const int nk = K / 32;
  const int gsb = lane * 16, gsw = gsb ^ (((gsb >> 9) & 1) << 5);
  const int grl = gsw >> 6, gcl = (gsw & 63) >> 1;
  const int flo = (fr * 64 + fq * 16) ^ ((fr >> 3) << 5);
  const int xcd = blockIdx.x & 7, xidx = blockIdx.x >> 3, xnb = gridDim.x >> 3;
  const int SN = (Ntiles + 7) >> 3, nsup = (Mtiles >> 3) * SN;
  (void)ntiles;
  const int qper = (64 + xnb - 1) / xnb;
  const bool splitctx = (EPI == 3) && (Mtiles == 136);
  const int nsupm = splitctx ? 16 * SN : nsup;
  const int nmain = ((nsupm + 7) >> 3) * qper;
  const int nextra = splitctx ? (512 + (int)gridDim.x - 1) / (int)gridDim.x : 0;
  for (int it = 0; it < nmain + nextra; ++it) {
    int tm, tn, kt0 = 0, nkk = nk, item = -1;
    if (it < nmain) {
      const int sup = xcd + 8 * (it / qper), q = xidx + xnb * (it % qper);
      if (sup >= nsupm || q >= 64) continue;
      tm = (sup / SN) * 8 + (q >> 3); tn = (sup % SN) * 8 + (q & 7);
      if (tn >= Ntiles) continue;
    } else {
      item = blockIdx.x + gridDim.x * (it - nmain);
      if (item >= 512) continue;
      const int tl = item >> 3;
      tm = 128 + (tl >> 3); tn = tl & 7; nkk = nk >> 3; kt0 = (item & 7) * nkk;
    }
    const bfr* Ab = A + (size_t)tm * 256 * lda + (size_t)(wave * 16 + grl) * lda + gcl + kt0 * 32;
    const bfr* Bb = Bt + (size_t)tn * 128 * K + (size_t)(wave * 16 + grl) * K + gcl + kt0 * 32;
    f32x4 acc[8][4];
#pragma unroll
    for (int m = 0; m < 8; ++m)
#pragma unroll
      for (int n = 0; n < 4; ++n) acc[m][n] = (f32x4){0.f, 0.f, 0.f, 0.f};
#define GLDS_STAGE(BUF, K0) { char* la = smemc + (BUF) * 24576 + wave * 1024; \
      __builtin_amdgcn_global_load_lds((const unsigned*)(Ab + (K0)), (unsigned*)(la), 16, 0, 0); \
      __builtin_amdgcn_global_load_lds((const unsigned*)(Ab + (size_t)64 * lda + (K0)), (unsigned*)(la + 4096), 16, 0, 0); \
      __builtin_amdgcn_global_load_lds((const unsigned*)(Ab + (size_t)128 * lda + (K0)), (unsigned*)(la + 8192), 16, 0, 0); \
      __builtin_amdgcn_global_load_lds((const unsigned*)(Ab + (size_t)192 * lda + (K0)), (unsigned*)(la + 12288), 16, 0, 0); \
      __builtin_amdgcn_global_load_lds((const unsigned*)(Bb + (K0)), (unsigned*)(la + 16384), 16, 0, 0); \
      __builtin_amdgcn_global_load_lds((const unsigned*)(Bb + (size_t)64 * K + (K0)), (unsigned*)(la + 16384 + 4096), 16, 0, 0); }
#define MM4(M, AF) { acc[M][0] = __builtin_amdgcn_mfma_f32_16x16x32_bf16(bg0, AF, acc[M][0], 0, 0, 0); \
      acc[M][1] = __builtin_amdgcn_mfma_f32_16x16x32_bf16(bg1, AF, acc[M][1], 0, 0, 0); \
      acc[M][2] = __builtin_amdgcn_mfma_f32_16x16x32_bf16(bg2, AF, acc[M][2], 0, 0, 0); \
      acc[M][3] = __builtin_amdgcn_mfma_f32_16x16x32_bf16(bg3, AF, acc[M][3], 0, 0, 0); }
#define AFR(M) (*(const bf16x8*)(rap + (M) * 1024))
    __syncthreads();
    GLDS_STAGE(0, 0);
    GLDS_STAGE(1, 32);
    asm volatile("s_waitcnt vmcnt(6)" ::: "memory");
    asm volatile("s_waitcnt lgkmcnt(0)" ::: "memory");
    __builtin_amdgcn_s_barrier();
    int cur = 0, nx2 = 2;
    for (int kt = 0; kt < nkk; ++kt) {
      if (kt + 2 < nkk) GLDS_STAGE(nx2, (kt + 2) * 32);
      const char* rbp = smemc + cur * 24576 + 16384 + (wc * 4) * 1024 + flo;
      const char* rap = smemc + cur * 24576 + (wr * 8) * 1024 + flo;
      bf16x8 bg0 = *(const bf16x8*)(rbp), bg1 = *(const bf16x8*)(rbp + 1024), bg2 = *(const bf16x8*)(rbp + 2048), bg3 = *(const bf16x8*)(rbp + 3072);
      bf16x8 a0 = AFR(0), a1 = AFR(1), a2 = AFR(2);
      MM4(0, a0); a0 = AFR(3);
      MM4(1, a1); a1 = AFR(4);
      MM4(2, a2); a2 = AFR(5);
      MM4(3, a0); a0 = AFR(6);
      MM4(4, a1); a1 = AFR(7);
      MM4(5, a2);
      MM4(6, a0);
      MM4(7, a1);
      __builtin_amdgcn_sched_group_barrier(0x100, 7, 0);
      __builtin_amdgcn_sched_group_barrier(0x008, 4, 0);
      __builtin_amdgcn_sched_group_barrier(0x100, 1, 0);
      __builtin_amdgcn_sched_group_barrier(0x008, 4, 0);
      __builtin_amdgcn_sched_group_barrier(0x100, 1, 0);
      __builtin_amdgcn_sched_group_barrier(0x008, 4, 0);
      __builtin_amdgcn_sched_group_barrier(0x100, 1, 0);
      __builtin_amdgcn_sched_group_barrier(0x008, 4, 0);
      __builtin_amdgcn_sched_group_barrier(0x100, 1, 0);
      __builtin_amdgcn_sched_group_barrier(0x008, 4, 0);
      __builtin_amdgcn_sched_group_barrier(0x100, 1, 0);
      __builtin_amdgcn_sched_group_barrier(0x008, 12, 0);
      __builtin_amdgcn_sched_barrier(0);
      if (kt + 2 < nkk) asm volatile("s_waitcnt vmcnt(6)" ::: "memory");
      else asm volatile("s_waitcnt vmcnt(0)" ::: "memory");
      asm volatile("s_waitcnt lgkmcnt(0)" ::: "memory");
      __builtin_amdgcn_s_barrier();
      cur = (cur == 2) ? 0 : cur + 1;
      nx2 = (nx2 == 2) ? 0 : nx2 + 1;
    }
#undef GLDS_STAGE
#undef MM4
#undef AFR
    if (EPI == 0) {
      bfr* dst; int ld, c0;
      if (tn < 8) { dst = WSP(bfr, OFF_PGDN); ld = 1024; c0 = tn * 128; }
      else if (tn < 14) { dst = WSP(bfr, OFF_PHY); ld = 768; c0 = (tn - 8) * 128; }
      else if (tn < 24) { dst = WSP(bfr, OFF_PHG); ld = 1280; c0 = (tn - 14) * 128; }
      else if (tn < 30) { dst = WSP(bfr, OFF_PDA); ld = 768; c0 = (tn - 24) * 128; }
      else { dst = nullptr; ld = 0; c0 = 0; }
      if (dst) {
        store_tile_bf16<false>(acc, dst, ld, tm * 256 + wr * 128, c0 + wc * 64, (bfr*)smemc + wave * (64 * 72), lane);
      } else if (wc == 0) {
        float* ab = WSP(float, OFF_AB);
#pragma unroll
        for (int m = 0; m < 8; ++m) {
          int row = tm * 256 + wr * 128 + m * 16 + fr;
          *(float4*)(ab + (size_t)row * 16 + fq * 4) = (float4){acc[m][0][0], acc[m][0][1], acc[m][0][2], acc[m][0][3]};
        }
      }
    } else if (EPI == 2) {
      store_tile_bf16<true>(acc, WSP(bfr, OFF_HID), 4096, tm * 256 + wr * 128, tn * 128 + wc * 64, (bfr*)smemc + wave * (64 * 72), lane);
    } else {
      const int midx = tm < 128 ? (tm >> 4) : 8;
      const float* gv = WSP(float, OFF_MOD) + (size_t)(l * 9 + midx) * 6144 + (EPI == 1 ? 2048 : 5120);
      float* wbuf = (float*)smemc + wave * (32 * 68);
      const int colw = tn * 128 + wc * 64;
      if (item >= 0) {
        float* slb = WSP(float, OFF_SLAB) + (size_t)item * 32768 + (size_t)(wr * 128) * 128 + wc * 64;
#pragma unroll
        for (int pass = 0; pass < 4; ++pass) {
#pragma unroll
          for (int mm = 0; mm < 2; ++mm)
#pragma unroll
            for (int n = 0; n < 4; ++n)
              *(f32x4*)(wbuf + (mm * 16 + fr) * 68 + n * 16 + fq * 4) = acc[2 * pass + mm][n];
#pragma unroll
          for (int q = 0; q < 8; ++q) {
            const int chunk = lane + 64 * q, rowl = chunk >> 4, c16 = chunk & 15;
            *(f32x4*)(slb + (size_t)(pass * 32 + rowl) * 128 + c16 * 4) = *(const f32x4*)(wbuf + rowl * 68 + c16 * 4);
          }
        }
      } else {
#pragma unroll
        for (int pass = 0; pass < 4; ++pass) {
#pragma unroll
          for (int mm = 0; mm < 2; ++mm)
#pragma unroll
            for (int n = 0; n < 4; ++n)
              *(f32x4*)(wbuf + (mm * 16 + fr) * 68 + n * 16 + fq * 4) = acc[2 * pass + mm][n];
#pragma unroll
          for (int q = 0; q < 8; ++q) {
            const int chunk = lane + 64 * q, rowl = chunk >> 4, c16 = chunk & 15;
            const int row = tm * 256 + wr * 128 + pass * 32 + rowl, col = colw + c16 * 4;
            const f32x4 a = *(const f32x4*)(wbuf + rowl * 68 + c16 * 4);
            const float* xi = (EPI == 1) ? xin_row(p, l, row) : (const float*)xout_row(p, row);
            float* xo = xout_row(p, row);
            float4 xv = *(const float4*)(xi + col);
            const float4 g4 = *(const float4*)(gv + col);
            xv.x += g4.x * a[0]; xv.y += g4.y * a[1]; xv.z += g4.z * a[2]; xv.w += g4.w * a[3];
            *(float4*)(xo + col) = xv;
          }
        }
      }
    }
  }
}

__device__ __forceinline__ void prep_task(const Params& p, int l, int task  , char* smemc) {
  const int tid = tidx();
  const bfr* pg = WSP(bfr, OFF_PGDN);
  const bfr* ph = WSP(bfr, OFF_PHY);
  bfr* gq = WSP(bfr, OFF_GQ);
  bfr* hv = WSP(bfr, OFF_HVC) - (size_t)NLAT * 256;
  const float* gw = p.in[9] + l * 3 * 768;
  const float* hw = p.in[13] + l * 3 * 768;
  float gw0[3], gw1[3], gw2[3], hw0[3];
#pragma unroll
  for (int i = 0; i < 3; ++i) {
    gw0[i] = gw[i * 768 + tid]; gw1[i] = gw[i * 768 + 256 + tid]; gw2[i] = gw[i * 768 + 512 + tid]; hw0[i] = hw[i * 768 + tid];
  }
  {
    const int row0 = task * 32;
    int t0, n;
    if (row0 < NLAT) { t0 = row0 & 4095; n = 4096; } else { t0 = (row0 - NLAT) & 255; n = 256; }
    const bool isctx = row0 >= NLAT;
#pragma unroll 1
    for (int rb = 0; rb < 32; rb += 8) {
      float xq[10], xk[10], xv[10], xh[10];
#pragma unroll
      for (int j = 0; j < 10; ++j) {
        const int tt = t0 + rb - 1 + j;
        const bool ok = tt >= 0 && tt < n;
        const bfr* r = pg + (size_t)(row0 + rb - 1 + j) * 1024;
        xq[j] = ok ? bf2f(r[tid]) : 0.f;
        xk[j] = ok ? bf2f(r[256 + tid]) : 0.f;
        xv[j] = ok ? bf2f(r[512 + tid]) : 0.f;
        xh[j] = (ok && isctx) ? bf2f(ph[(size_t)(row0 + rb - 1 + j) * 768 + tid]) : 0.f;
      }
#pragma unroll
      for (int r8 = 0; r8 < 8; ++r8) {
        const int row = row0 + rb + r8;
        float aq = gw0[0] * xq[r8] + gw0[1] * xq[r8 + 1] + gw0[2] * xq[r8 + 2];
        float ak = gw1[0] * xk[r8] + gw1[1] * xk[r8 + 1] + gw1[2] * xk[r8 + 2];
        float av = gw2[0] * xv[r8] + gw2[1] * xv[r8 + 1] + gw2[2] * xv[r8 + 2];
        aq *= fsigmoid(aq); ak *= fsigmoid(ak); av *= fsigmoid(av);
        float sq = wave_sum(aq * aq), sk = wave_sum(ak * ak);
        aq *= rsqrtf(sq + 1e-6f); ak *= rsqrtf(sk + 1e-6f);
        gq[(size_t)row * 768 + tid] = f2bf(aq);
        gq[(size_t)row * 768 + 256 + tid] = f2bf(ak);
        gq[(size_t)row * 768 + 512 + tid] = f2bf(av);
        if (isctx) hv[(size_t)row * 256 + tid] = f2bf(hw0[0] * xh[r8] + hw0[1] * xh[r8 + 1] + hw0[2] * xh[r8 + 2]);
      }
    }
  }
  bfr* pd = WSP(bfr, OFF_PDA);
  for (int gi = tid; gi < 512; gi += 256) {
    int rr = gi >> 4, g = gi & 15;
    int row = task * 32 + rr;
    int qk = g >> 3;
    bfr* ptr = pd + (size_t)row * 768 + g * 32;
    const float* nw = p.in[qk == 0 ? 25 : 26] + l * 32;
    float x[32];
    uint4 raw[4];
#pragma unroll
    for (int i = 0; i < 4; ++i) raw[i] = ((const uint4*)ptr)[i];
#pragma unroll
    for (int i = 0; i < 4; ++i) {
      unsigned w0 = raw[i].x, w1 = raw[i].y, w2 = raw[i].z, w3 = raw[i].w;
      x[8 * i + 0] = __uint_as_float(w0 << 16); x[8 * i + 1] = __uint_as_float(w0 & 0xffff0000u);
      x[8 * i + 2] = __uint_as_float(w1 << 16); x[8 * i + 3] = __uint_as_float(w1 & 0xffff0000u);
      x[8 * i + 4] = __uint_as_float(w2 << 16); x[8 * i + 5] = __uint_as_float(w2 & 0xffff0000u);
      x[8 * i + 6] = __uint_as_float(w3 << 16); x[8 * i + 7] = __uint_as_float(w3 & 0xffff0000u);
    }
    float ss = 0.f;
#pragma unroll
    for (int i = 0; i < 32; ++i) ss += x[i] * x[i];
    float r = rsqrtf(ss * (1.f / 32.f) + 1e-6f);
    if (qk == 0) r *= 0.25503486f;
#pragma unroll
    for (int i = 0; i < 32; ++i) x[i] = x[i] * r * nw[i];
    if (row < NLAT) {
      int t = row & 4095;
      const float* rr_ = WSP(float, OFF_ROPE) + (t >> 6) * 16;
      const float* rc_ = WSP(float, OFF_ROPE) + (t & 63) * 16;
      float crv[8], srv[8], ccv[8], scv[8];
#pragma unroll
      for (int i = 0; i < 2; ++i) {
        float4 a4 = ((const float4*)rr_)[i], b4 = ((const float4*)rr_)[2 + i], c4 = ((const float4*)rc_)[i], d4 = ((const float4*)rc_)[2 + i];
        crv[4 * i] = a4.x; crv[4 * i + 1] = a4.y; crv[4 * i + 2] = a4.z; crv[4 * i + 3] = a4.w;
        srv[4 * i] = b4.x; srv[4 * i + 1] = b4.y; srv[4 * i + 2] = b4.z; srv[4 * i + 3] = b4.w;
        ccv[4 * i] = c4.x; ccv[4 * i + 1] = c4.y; ccv[4 * i + 2] = c4.z; ccv[4 * i + 3] = c4.w;
        scv[4 * i] = d4.x; scv[4 * i + 1] = d4.y; scv[4 * i + 2] = d4.z; scv[4 * i + 3] = d4.w;
      }
#pragma unroll
      for (int i = 0; i < 8; ++i) {
        const float sr = srv[i], cr = crv[i], scn = scv[i], cc = ccv[i];
        float a = x[i], b = x[8 + i];
        x[i] = a * cr - b * sr; x[8 + i] = b * cr + a * sr;
        float c = x[16 + i], d = x[24 + i];
        x[16 + i] = c * cc - d * scn; x[24 + i] = d * cc + c * scn;
      }
    }
#pragma unroll
    for (int i = 0; i < 4; ++i) {
      uint4 o;
      o.x = (unsigned)f2bf(x[8 * i + 0]) | ((unsigned)f2bf(x[8 * i + 1]) << 16);
      o.y = (unsigned)f2bf(x[8 * i + 2]) | ((unsigned)f2bf(x[8 * i + 3]) << 16);
      o.z = (unsigned)f2bf(x[8 * i + 4]) | ((unsigned)f2bf(x[8 * i + 5]) << 16);
      o.w = (unsigned)f2bf(x[8 * i + 6]) | ((unsigned)f2bf(x[8 * i + 7]) << 16);
      ((uint4*)ptr)[i] = o;
    }
  }
  if (task < 1024) {
    bfr* tile = (bfr*)smemc;
    const int row0 = task * 32;
    const int bb = row0 >> 12, t0 = row0 & 4095;
#pragma unroll 1
    for (int k = 0; k < 3; ++k) {
      const int ch = k * 256 + tid;
      const float w0 = hw[ch], w1 = hw[768 + ch], w2 = hw[1536 + ch];
      bfr xr[34];
#pragma unroll
      for (int j = 0; j < 34; ++j) {
        const int tt = t0 - 1 + j;
        xr[j] = (tt >= 0 && tt < 4096) ? ph[(size_t)(row0 - 1 + j) * 768 + ch] : (bfr)0;
      }
#pragma unroll
      for (int rr = 0; rr < 32; rr += 2) {
        const float y0 = w0 * bf2f(xr[rr]) + w1 * bf2f(xr[rr + 1]) + w2 * bf2f(xr[rr + 2]);
        const float y1 = w0 * bf2f(xr[rr + 1]) + w1 * bf2f(xr[rr + 2]) + w2 * bf2f(xr[rr + 3]);
        *(unsigned*)(tile + tid * 40 + rr) = pk2(y0, y1);
      }
      __syncthreads();
      bfr* dst = WSP(bfr, k == 0 ? OFF_HVT : (k == 1 ? OFF_X1T : OFF_X2T)) + ((size_t)(tid * 8 + bb)) * 4096 + t0;
#pragma unroll
      for (int i = 0; i < 4; ++i) ((uint4*)dst)[i] = *(const uint4*)(tile + tid * 40 + 8 * i);
      __syncthreads();
    }
  }
  {
    bfr* tile = (bfr*)smemc;
    const int row0 = task * 32;
    bfr vr[32];
#pragma unroll
    for (int rr = 0; rr < 32; ++rr) vr[rr] = pd[(size_t)(row0 + rr) * 768 + 512 + tid];
#pragma unroll
    for (int rr = 0; rr < 32; ++rr) {
      int pp = rr & 15;
      int g = pp >> 2;
      g = (g == 1) ? 2 : (g == 2 ? 1 : g);
      int pos = (rr & 16) | (g << 2) | (pp & 3);
      tile[tid * 40 + pos] = vr[rr];
    }
    __syncthreads();
    int bb, kbase;
    if (row0 < NLAT) { bb = row0 >> 12; kbase = row0 & 4095; } else { bb = (row0 - NLAT) >> 8; kbase = 4096 + ((row0 - NLAT) & 255); }
    bfr* vt = WSP(bfr, OFF_VT) + ((size_t)(bb * 256 + tid)) * 4352 + kbase;
#pragma unroll
    for (int i = 0; i < 4; ++i) ((uint4*)vt)[i] = *(const uint4*)(tile + tid * 40 + 8 * i);
    __syncthreads();
  }
}

__device__ __forceinline__ size_t scan_row(int b, int d, int ci, int i) {
  if (ci < 8) { int c0 = ci * 32; int t = d == 0 ? c0 + i : 255 - c0 - i; return (size_t)NLAT + b * 256 + t; }
  int c0 = (ci - 8) * 32; int t = d == 0 ? c0 + i : 4095 - c0 - i; return (size_t)b * 4096 + t;
}

__device__ __forceinline__ void hgrn_scan(const Params& p, int l, int task, float* smem) {
  const int b = task >> 3, h = (task >> 1) & 3, d = task & 1;
  const int tid = tidx(), lane = tid & 63, wave = tid >> 6;
  const int kg = lane & 3, vv = wave * 16 + (lane >> 2);
  float* sq = smem;
  float* sf = smem + 2048;
  float* sv = smem + 4096;
  float* so = smem + 6144;
  bfr* P = WSP(bfr, OFF_PHG);
  const int ch = tid & 63, i0 = tid >> 6;
  const float lbv = WSP(float, OFF_LB)[l * 256 + h * 64 + ch];
  v2f S2[8];
#pragma unroll
  for (int i = 0; i < 8; ++i) S2[i] = (v2f){0.f, 0.f};
  __builtin_amdgcn_s_setprio(3);
  bfr rq[8], ri[8], rf[8];
#pragma unroll
  for (int j = 0; j < 8; ++j) {
    const bfr* pr = P + scan_row(b, d, 0, i0 + 4 * j) * 1280 + h * 64 + ch;
    rq[j] = pr[0]; ri[j] = pr[256]; rf[j] = pr[512 + d * 256];
  }
  for (int ci = 0; ci < 136; ++ci) {
#pragma unroll
    for (int j = 0; j < 8; ++j) {
      const int e = (i0 + 4 * j) * 64 + ch;
      sq[e] = siluf_(bf2f(rq[j]));
      sf[e] = lbv + (1.f - lbv) * sigmoidf_(bf2f(rf[j]));
      sv[e] = bf2f(ri[j]);
    }
    __syncthreads();
    if (ci + 1 < 136) {
#pragma unroll
      for (int j = 0; j < 8; ++j) {
        const bfr* pr = P + scan_row(b, d, ci + 1, i0 + 4 * j) * 1280 + h * 64 + ch;
        rq[j] = pr[0]; ri[j] = pr[256]; rf[j] = pr[512 + d * 256];
      }
    }
#pragma unroll 4
    for (int i = 0; i < 32; ++i) {
      const float vcur = sv[i * 64 + vv];
      const v2f vc2 = {vcur, vcur};
      const float4* f4 = (const float4*)(sf + i * 64 + kg * 16);
      const float4* q4 = (const float4*)(sq + i * 64 + kg * 16);
      v2f pa = {0.f, 0.f}, pb = {0.f, 0.f};
#pragma unroll
      for (int j = 0; j < 4; ++j) {
        float4 f = f4[j], q = q4[j];
        v2f fa = {f.x, f.y}, fb = {f.z, f.w}, qa = {q.x, q.y}, qb = {q.z, q.w};
        S2[2 * j] = fa * (S2[2 * j] - vc2) + vc2;
        S2[2 * j + 1] = fb * (S2[2 * j + 1] - vc2) + vc2;
        pa += S2[2 * j] * qa;
        pb += S2[2 * j + 1] * qb;
      }
      float po = quad_sum((pa.x + pa.y) + (pb.x + pb.y));
      if (kg == 0) so[i * 64 + vv] = po;
    }
    __syncthreads();
#pragma unroll
    for (int j = 0; j < 8; ++j) {
      const int i = i0 + 4 * j;
      P[scan_row(b, d, ci, i) * 1280 + 512 + d * 256 + h * 64 + ch] = f2bf(so[i * 64 + ch]);
    }
  }
  __builtin_amdgcn_s_setprio(0);
}

__device__ __forceinline__ bfr* sw_addr(bfr* base, int R, int chunk) { return base + R * 64 + ((chunk ^ (R & 7)) << 3); }
__device__ __forceinline__ bf16x8 frag_nat(bfr* base, int R, int kk, int hf) { return *(const bf16x8*)sw_addr(base, R, 2 * kk + hf); }
__device__ __forceinline__ bf16x8 frag_krow(bfr* base, int R, int c0, int hf) {
  uint2 lo = *(const uint2*)(sw_addr(base, R, c0) + 4 * hf);
  uint2 hi = *(const uint2*)(sw_addr(base, R, c0 + 1) + 4 * hf);
  return __builtin_bit_cast(bf16x8, (uint4){lo.x, lo.y, hi.x, hi.y});
}
__device__ __forceinline__ bf16x8 pack8(const f32x16& x, int st) {
  return __builtin_bit_cast(bf16x8, (uint4){pk2(x[8 * st + 0], x[8 * st + 1]), pk2(x[8 * st + 2], x[8 * st + 3]),
                                            pk2(x[8 * st + 4], x[8 * st + 5]), pk2(x[8 * st + 6], x[8 * st + 7])});
}
__device__ __forceinline__ int crow_(int reg, int hf) { return (reg & 3) + 8 * (reg >> 2) + 4 * hf; }
__device__ __forceinline__ size_t scan_row64(int b, int d, int ci, int i) {
  if (ci < 4) { int c0 = ci * 64; int t = d == 0 ? c0 + i : 255 - c0 - i; return (size_t)NLAT + b * 256 + t; }
  int c0 = (ci - 4) * 64; int t = d == 0 ? c0 + i : 4095 - c0 - i; return (size_t)b * 4096 + t;
}

__device__ __forceinline__ void hgrn_chunked(const Params& p, int l, int task, char* smemc) {
  const int b = task >> 3, h = (task >> 1) & 3, d = task & 1;
  const int tid = tidx(), lane = tid & 63, wave = tid >> 6, r = lane & 31, hf = lane >> 5;
  const int tb = wave >> 1, vb = wave & 1;
  bfr* QG = (bfr*)smemc;
  bfr* QT = QG + 4096;
  bfr* KT = QT + 4096;
  bfr* KET = KT + 4096;
  bfr* VT = KET + 4096;
  float* TOT = (float*)(smemc + 40960);
  float* EG = TOT + 256;
  bfr* P = WSP(bfr, OFF_PHG);
  const int c = tid & 63, qd = tid >> 6;
  const float lbv = WSP(float, OFF_LB)[l * 256 + h * 64 + c];
  f32x16 S[2];
#pragma unroll
  for (int m = 0; m < 2; ++m)
#pragma unroll
    for (int i = 0; i < 16; ++i) S[m][i] = 0.f;
  __builtin_amdgcn_s_setprio(3);
  bfr rq[16], ri[16], rf[16];
#pragma unroll
  for (int j = 0; j < 16; ++j) {
    const bfr* pr = P + scan_row64(b, d, 0, 16 * qd + j) * 1280 + h * 64 + c;
    rq[j] = pr[0]; ri[j] = pr[256]; rf[j] = pr[512 + d * 256];
  }
#pragma unroll 1
  for (int ci = 0; ci < 68; ++ci) {
    float g[16], ky[16], qh[16];
    float run = 0.f;
#pragma unroll
    for (int j = 0; j < 16; ++j) {
      float f = lbv + (1.f - lbv) * fsigmoid(bf2f(rf[j]));
      run += __logf(f);
      const float qv = bf2f(rq[j]);
      g[j] = run; ky[j] = 1.f - f; qh[j] = qv * fsigmoid(qv);
    }
    __syncthreads();
    TOT[qd * 64 + c] = run;
    __syncthreads();
    const float t0 = TOT[c], t1 = TOT[64 + c], t2 = TOT[128 + c], t3 = TOT[192 + c];
    const float off = (qd > 0 ? t0 : 0.f) + (qd > 1 ? t1 : 0.f) + (qd > 2 ? t2 : 0.f);
    const float gm = t0 + t1, g63 = (t0 + t1) + (t2 + t3);
    const float egm = __expf(gm), e6m = __expf(g63 - gm);
    unsigned wke[8], wvt[8];
#pragma unroll
    for (int j = 0; j < 16; ++j) {
      const int i = 16 * qd + j;
      const float gi = g[j] + off;
      const float e1 = __expf(fminf(fmaxf(gi - gm, -80.f), 80.f));
      const float e2 = __builtin_amdgcn_rcpf(e1);
      const float eg = e1 * egm;
      const float e3 = e2 * e6m;
      const int sw = ((c >> 3) ^ (i & 7)) * 8 + (c & 7);
      QG[i * 64 + sw] = f2bf(qh[j] * eg);
      QT[i * 64 + sw] = f2bf(qh[j] * e1);
      KT[i * 64 + sw] = f2bf(ky[j] * e2);
      const float ke = ky[j] * e3, vv = bf2f(ri[j]);
      if (j & 1) { wke[j >> 1] |= ((unsigned)f2bf(ke)) << 16; wvt[j >> 1] |= ((unsigned)ri[j]) << 16; }
      else { wke[j >> 1] = f2bf(ke); wvt[j >> 1] = ri[j]; }
      (void)vv;
    }
    *(uint4*)sw_addr(KET, c, 2 * qd) = (uint4){wke[0], wke[1], wke[2], wke[3]};
    *(uint4*)sw_addr(KET, c, 2 * qd + 1) = (uint4){wke[4], wke[5], wke[6], wke[7]};
    *(uint4*)sw_addr(VT, c, 2 * qd) = (uint4){wvt[0], wvt[1], wvt[2], wvt[3]};
    *(uint4*)sw_addr(VT, c, 2 * qd + 1) = (uint4){wvt[4], wvt[5], wvt[6], wvt[7]};
    if (qd == 0) EG[c] = __expf(g63);
    __syncthreads();
    if (ci + 1 < 68) {
#pragma unroll
      for (int j = 0; j < 16; ++j) {
        const bfr* pr = P + scan_row64(b, d, ci + 1, 16 * qd + j) * 1280 + h * 64 + c;
        rq[j] = pr[0]; ri[j] = pr[256]; rf[j] = pr[512 + d * 256];
      }
    }
    f32x16 AT[2];
#pragma unroll
    for (int m = 0; m < 2; ++m) {
#pragma unroll
      for (int i = 0; i < 16; ++i) AT[m][i] = 0.f;
      if (m <= tb) {
#pragma unroll
        for (int kk = 0; kk < 4; ++kk)
          AT[m] = __builtin_amdgcn_mfma_f32_32x32x16_bf16(frag_nat(KT, 32 * m + r, kk, hf), frag_nat(QT, 32 * tb + r, kk, hf), AT[m], 0, 0, 0);
        if (m == tb) {
#pragma unroll
          for (int i = 0; i < 16; ++i) if (crow_(i, hf) > r) AT[m][i] = 0.f;
        }
      }
    }
    f32x16 o;
#pragma unroll
    for (int i = 0; i < 16; ++i) o[i] = 0.f;
#pragma unroll
    for (int m = 0; m < 2; ++m)
#pragma unroll
      for (int st = 0; st < 2; ++st)
        o = __builtin_amdgcn_mfma_f32_32x32x16_bf16(frag_krow(QG, 32 * tb + r, 4 * m + 2 * st, hf), pack8(S[m], st), o, 0, 0, 0);
#pragma unroll
    for (int m = 0; m < 2; ++m) {
      if (m <= tb) {
#pragma unroll
        for (int st = 0; st < 2; ++st)
          o = __builtin_amdgcn_mfma_f32_32x32x16_bf16(pack8(AT[m], st), frag_krow(VT, 32 * vb + r, 4 * m + 2 * st, hf), o, 0, 0, 0);
      }
    }
#pragma unroll
    for (int m = 0; m < 2; ++m) {
#pragma unroll
      for (int gq = 0; gq < 4; ++gq) {
        float4 e4 = *(const float4*)(EG + 32 * m + 8 * gq + 4 * hf);
        S[m][4 * gq + 0] *= e4.x; S[m][4 * gq + 1] *= e4.y; S[m][4 * gq + 2] *= e4.z; S[m][4 * gq + 3] *= e4.w;
      }
#pragma unroll
      for (int kk = 0; kk < 4; ++kk)
        S[m] = __builtin_amdgcn_mfma_f32_32x32x16_bf16(frag_nat(KET, 32 * m + r, kk, hf), frag_nat(VT, 32 * vb + r, kk, hf), S[m], 0, 0, 0);
    }
#pragma unroll
    for (int i = 0; i < 16; ++i) {
      const int t = 32 * tb + crow_(i, hf);
      P[scan_row64(b, d, ci, t) * 1280 + 512 + d * 256 + h * 64 + 32 * vb + r] = f2bf(o[i]);
    }
  }
  __builtin_amdgcn_s_setprio(0);
}

__device__ __forceinline__ void gdn_solve_task(const Params& p, int l, int task, char* smemc) {
  const int tid = tidx(), lane = tid & 63, wave = __builtin_amdgcn_readfirstlane(tid >> 6), r = lane & 31, hf = lane >> 5;
  const int chunk = task >> 2, h = task & 3;
  const int row0 = chunk * 64;
  int t0, n;
  if (row0 < NLAT) { t0 = row0 & 4095; n = 4096; } else { t0 = (row0 - NLAT) & 255; n = 256; }
  bfr* Kt = (bfr*)smemc;
  float* T0 = (float*)(smemc + 8192);
  float* T1 = T0 + 4096;
  float* GC = T1 + 4096;
  float* BT = GC + 128;
  {
    const int c = lane, qd = wave;
    const int ch = 256 + h * 64 + c;
    const float* gw = p.in[9] + l * 3 * 768;
    const float w0 = gw[ch], w1 = gw[768 + ch], w2 = gw[1536 + ch];
    const bfr* pg = WSP(bfr, OFF_PGDN);
    float x[18];
#pragma unroll
    for (int j = 0; j < 18; ++j) {
      const int tt = t0 + 16 * qd - 1 + j;
      x[j] = (tt >= 0 && tt < n) ? bf2f(pg[(size_t)(row0 + 16 * qd - 1 + j) * 1024 + ch]) : 0.f;
    }
#pragma unroll
    for (int j = 0; j < 16; ++j) {
      float a = w0 * x[j] + w1 * x[j + 1] + w2 * x[j + 2];
      a *= fsigmoid(a);
      float ss = wave_sum(a * a);
      a *= rsqrtf(ss + 1e-6f);
      const int i = 16 * qd + j;
      Kt[i * 64 + (((c >> 3) ^ (i & 7)) << 3) + (c & 7)] = f2bf(a);
    }
  }
  if (wave < 2) {
    const int d = wave, i = lane;
    const int tok = d == 0 ? i : 63 - i;
    const float* ar = WSP(float, OFF_AB) + (size_t)(row0 + tok) * 16;
    const float x = ar[d * 4 + h] + p.in[11][l * 8 + d * 4 + h];
    const float sp = fmaxf(x, 0.f) + log1pf(expf(-fabsf(x)));
    float g = -expf(p.in[10][l * 8 + d * 4 + h]) * sp;
#pragma unroll
    for (int off = 1; off < 64; off <<= 1) { float t = __shfl_up(g, off); if (lane >= off) g += t; }
    GC[d * 64 + i] = g;
    BT[d * 64 + i] = sigmoidf_(ar[8 + d * 4 + h]);
    (WSP(float, OFF_AB) + (size_t)(row0 + tok) * 16)[d * 4 + h] = g;
  }
  __syncthreads();
  {
    const int mi = wave >> 1, nj = wave & 1;
    f32x16 acc;
#pragma unroll
    for (int i = 0; i < 16; ++i) acc[i] = 0.f;
#pragma unroll
    for (int kk = 0; kk < 4; ++kk)
      acc = __builtin_amdgcn_mfma_f32_32x32x16_bf16(frag_nat(Kt, 32 * mi + r, kk, hf), frag_nat(Kt, 32 * nj + r, kk, hf), acc, 0, 0, 0);
    const int tj = 32 * nj + r;
#pragma unroll
    for (int reg = 0; reg < 16; ++reg) {
      const int ti = 32 * mi + crow_(reg, hf);
      if (tj < ti) T0[ti * 64 + tj] = BT[ti] * acc[reg] * __expf(GC[ti] - GC[tj]);
      else if (tj > ti) { const int i = 63 - ti, j = 63 - tj; T1[i * 64 + j] = BT[64 + i] * acc[reg] * __expf(GC[64 + i] - GC[64 + j]); }
    }
  }
  __syncthreads();
  if (wave < 2) {
    const int d = wave, c = lane;
    const float* T = T0 + d * 4096;
    float X[64];
#pragma unroll
    for (int i = 0; i < 64; ++i) {
      float a0 = (i == c) ? 1.f : 0.f, a1 = 0.f, a2 = 0.f, a3 = 0.f;
#pragma unroll
      for (int j = 0; j < i; ++j) {
        const float tx = T[i * 64 + j] * X[j];
        if ((j & 3) == 0) a0 -= tx; else if ((j & 3) == 1) a1 -= tx; else if ((j & 3) == 2) a2 -= tx; else a3 -= tx;
      }
      X[i] = (a0 + a1) + (a2 + a3);
    }
    const float bc = BT[d * 64 + c];
    const int hd = h * 2 + d;
    const int colbase = hd < 4 ? hd * 64 : 512 + (hd - 4) * 64;
    bfr* oc = WSP(bfr, OFF_HN) + (size_t)row0 * 1024 + colbase + c;
#pragma unroll
    for (int i = 0; i < 64; ++i) {
      const int tok = d == 0 ? i : 63 - i;
      oc[(size_t)tok * 1024] = f2bf(X[i] * bc);
    }
  }
  __syncthreads();
}

__device__ __forceinline__ void gdn_chunked(const Params& p, int l, int task, char* smemc) {
  const int b = task >> 3, h = (task >> 1) & 3, d = task & 1;
  const int tid = tidx(), lane = tid & 63, wave = tid >> 6, r = lane & 31, hf = lane >> 5;
  const int tb = wave >> 1, vb = wave & 1;
  bfr* Qn = (bfr*)smemc;
  bfr* Kn = Qn + 4096;
  bfr* NKG = Kn + 4096;
  bfr* QG = NKG + 4096;
  bfr* KGET = QG + 4096;
  bfr* ABm = KGET + 4096;
  bfr* Vn = ABm + 4096;
  float* GC = (float*)(smemc + 57344);
  float* EGC = GC + 64;
  float* EGE = EGC + 64;
  const int cp = tid & 31, og = tid >> 5;
  const int hd = h * 2 + d;
  const int colbase = hd < 4 ? hd * 64 : 512 + (hd - 4) * 64;
  const float Aexp = expf(p.in[10][l * 8 + d * 4 + h]);
  const float dtb = p.in[11][l * 8 + d * 4 + h];
  const bfr* gq = WSP(bfr, OFF_GQ);
  const bfr* oc = WSP(bfr, OFF_HN);
  const float* ab = WSP(float, OFF_AB);
  bfr* P = WSP(bfr, OFF_PGDN);
  f32x16 S[2];
#pragma unroll
  for (int m = 0; m < 2; ++m)
#pragma unroll
    for (int i = 0; i < 16; ++i) S[m][i] = 0.f;
  __builtin_amdgcn_s_setprio(3);
  unsigned rq[8], rk[8], rv[8], ra[8];
  float rga = 0.f;
#pragma unroll
  for (int j = 0; j < 8; ++j) {
    const size_t row = scan_row64(b, d, 0, 8 * og + j);
    const bfr* pr = gq + row * 768 + h * 64 + 2 * cp;
    rq[j] = *(const unsigned*)pr; rk[j] = *(const unsigned*)(pr + 256); rv[j] = *(const unsigned*)(pr + 512);
    ra[j] = *(const unsigned*)(oc + row * 1024 + colbase + 2 * cp);
  }
  if (tid < 64) rga = ab[scan_row64(b, d, 0, tid) * 16 + d * 4 + h];
#pragma unroll 1
  for (int ci = 0; ci < 68; ++ci) {
    __syncthreads();
    if (wave == 0) {
      const float g = rga;
      const float g63 = __shfl(g, 63);
      GC[lane] = g; EGC[lane] = __expf(g); EGE[lane] = __expf(g63 - g);
    }
    __syncthreads();
    {
      unsigned w0[4], w1[4];
#pragma unroll
      for (int j = 0; j < 8; ++j) {
        const int i = 8 * og + j;
        const float eg = EGC[i], ee = EGE[i];
        const int addr = i * 64 + ((((cp >> 2) ^ (i & 7))) << 3) + 2 * (cp & 3);
        const float q0 = __uint_as_float(rq[j] << 16), q1 = __uint_as_float(rq[j] & 0xffff0000u);
        const float k0 = __uint_as_float(rk[j] << 16), k1 = __uint_as_float(rk[j] & 0xffff0000u);
        *(unsigned*)(Qn + addr) = rq[j];
        *(unsigned*)(Kn + addr) = rk[j];
        *(unsigned*)(Vn + addr) = rv[j];
        *(unsigned*)(ABm + addr) = ra[j];
        *(unsigned*)(NKG + addr) = pk2(-k0 * eg, -k1 * eg);
        *(unsigned*)(QG + addr) = pk2(q0 * 0.125f * eg, q1 * 0.125f * eg);
        const unsigned e0 = f2bf(k0 * ee), e1 = f2bf(k1 * ee);
        if (j & 1) { w0[j >> 1] |= e0 << 16; w1[j >> 1] |= e1 << 16; } else { w0[j >> 1] = e0; w1[j >> 1] = e1; }
      }
      *(uint4*)sw_addr(KGET, 2 * cp, og) = (uint4){w0[0], w0[1], w0[2], w0[3]};
      *(uint4*)sw_addr(KGET, 2 * cp + 1, og) = (uint4){w1[0], w1[1], w1[2], w1[3]};
    }
    __syncthreads();
    if (ci + 1 < 68) {
#pragma unroll
      for (int j = 0; j < 8; ++j) {
        const size_t row = scan_row64(b, d, ci + 1, 8 * og + j);
        const bfr* pr = gq + row * 768 + h * 64 + 2 * cp;
        rq[j] = *(const unsigned*)pr; rk[j] = *(const unsigned*)(pr + 256); rv[j] = *(const unsigned*)(pr + 512);
        ra[j] = *(const unsigned*)(oc + row * 1024 + colbase + 2 * cp);
      }
      if (tid < 64) rga = ab[scan_row64(b, d, ci + 1, tid) * 16 + d * 4 + h];
    }
    f32x16 vn[2];
#pragma unroll
    for (int mt = 0; mt < 2; ++mt)
#pragma unroll
      for (int i = 0; i < 16; ++i) vn[mt][i] = 0.f;
#pragma unroll
    for (int m = 0; m < 2; ++m) {
      f32x16 rr;
#pragma unroll
      for (int reg = 0; reg < 16; ++reg) {
        const int i = 32 * m + crow_(reg, hf), v = 32 * vb + r;
        rr[reg] = bf2f(Vn[i * 64 + (((v >> 3) ^ (i & 7)) << 3) + (v & 7)]);
      }
#pragma unroll
      for (int mp = 0; mp < 2; ++mp)
#pragma unroll
        for (int st = 0; st < 2; ++st)
          rr = __builtin_amdgcn_mfma_f32_32x32x16_bf16(frag_krow(NKG, 32 * m + r, 4 * mp + 2 * st, hf), pack8(S[mp], st), rr, 0, 0, 0);
#pragma unroll
      for (int mt = 0; mt < 2; ++mt) {
        if (m <= mt) {
#pragma unroll
          for (int st = 0; st < 2; ++st)
            vn[mt] = __builtin_amdgcn_mfma_f32_32x32x16_bf16(frag_krow(ABm, 32 * mt + r, 4 * m + 2 * st, hf), pack8(rr, st), vn[mt], 0, 0, 0);
        }
      }
    }
    f32x16 o;
#pragma unroll
    for (int i = 0; i < 16; ++i) o[i] = 0.f;
#pragma unroll
    for (int mp = 0; mp < 2; ++mp)
#pragma unroll
      for (int st = 0; st < 2; ++st)
        o = __builtin_amdgcn_mfma_f32_32x32x16_bf16(frag_krow(QG, 32 * tb + r, 4 * mp + 2 * st, hf), pack8(S[mp], st), o, 0, 0, 0);
    const float gct = GC[32 * tb + r];
#pragma unroll
    for (int m = 0; m < 2; ++m) {
      if (m <= tb) {
        f32x16 AT;
#pragma unroll
        for (int i = 0; i < 16; ++i) AT[i] = 0.f;
#pragma unroll
        for (int kk = 0; kk < 4; ++kk)
          AT = __builtin_amdgcn_mfma_f32_32x32x16_bf16(frag_nat(Kn, 32 * m + r, kk, hf), frag_nat(Qn, 32 * tb + r, kk, hf), AT, 0, 0, 0);
#pragma unroll
        for (int g4i = 0; g4i < 4; ++g4i) {
          const float4 g4 = *(const float4*)(GC + 32 * m + 8 * g4i + 4 * hf);
          const float gs[4] = {g4.x, g4.y, g4.z, g4.w};
#pragma unroll
          for (int jj = 0; jj < 4; ++jj) {
            const int reg = 4 * g4i + jj;
            const bool keep = (m < tb) || (crow_(reg, hf) <= r);
            AT[reg] = keep ? AT[reg] * 0.125f * __expf(gct - gs[jj]) : 0.f;
          }
        }
#pragma unroll
        for (int st = 0; st < 2; ++st)
          o = __builtin_amdgcn_mfma_f32_32x32x16_bf16(pack8(AT, st), pack8(vn[m], st), o, 0, 0, 0);
      }
    }
    const float eg63 = EGC[63];
#pragma unroll
    for (int mp = 0; mp < 2; ++mp) {
#pragma unroll
      for (int i = 0; i < 16; ++i) S[mp][i] *= eg63;
#pragma unroll
      for (int m = 0; m < 2; ++m)
#pragma unroll
        for (int st = 0; st < 2; ++st)
          S[mp] = __builtin_amdgcn_mfma_f32_32x32x16_bf16(frag_krow(KGET, 32 * mp + r, 4 * m + 2 * st, hf), pack8(vn[m], st), S[mp], 0, 0, 0);
    }
#pragma unroll
    for (int i = 0; i < 16; ++i) {
      const int t = 32 * tb + crow_(i, hf);
      P[scan_row64(b, d, ci, t) * 1024 + d * 256 + h * 64 + 32 * vb + r] = f2bf(o[i]);
    }
  }
  __builtin_amdgcn_s_setprio(0);
}

__device__ __forceinline__ void gdn_scan(const Params& p, int l, int task, float* smem) {
  const int b = task >> 3, h = (task >> 1) & 3, d = task & 1;
  const int tid = tidx(), lane = tid & 63, wave = tid >> 6;
  const int kg = lane & 3, vv = wave * 16 + (lane >> 2);
  float* sq = smem;
  float* sk = smem + 2048;
  float* sv = smem + 4096;
  float* so = smem + 6144;
  float* seg_ = smem + 8192;
  float* sbt = smem + 8192 + 32;
  const bfr* gq = WSP(bfr, OFF_GQ);
  const float* ab = WSP(float, OFF_AB);
  bfr* P = WSP(bfr, OFF_PGDN);
  const float Aexp = expf(p.in[10][l * 8 + d * 4 + h]);
  const float dtb = p.in[11][l * 8 + d * 4 + h];
  const int ch = tid & 63, i0 = tid >> 6;
  v2f S2[8];
#pragma unroll
  for (int i = 0; i < 8; ++i) S2[i] = (v2f){0.f, 0.f};
  __builtin_amdgcn_s_setprio(3);
  bfr rq[8], rk[8], rv[8];
  float ra = 0.f, rb = 0.f;
#pragma unroll
  for (int j = 0; j < 8; ++j) {
    const bfr* pr = gq + scan_row(b, d, 0, i0 + 4 * j) * 768 + h * 64 + ch;
    rq[j] = pr[0]; rk[j] = pr[256]; rv[j] = pr[512];
  }
  if (tid < 32) { const float* ar = ab + scan_row(b, d, 0, tid) * 16; ra = ar[d * 4 + h]; rb = ar[8 + d * 4 + h]; }
  for (int ci = 0; ci < 136; ++ci) {
#pragma unroll
    for (int j = 0; j < 8; ++j) {
      const int e = (i0 + 4 * j) * 64 + ch;
      sq[e] = bf2f(rq[j]) * 0.125f;
      sk[e] = bf2f(rk[j]);
      sv[e] = bf2f(rv[j]);
    }
    if (tid < 32) {
      float x = ra + dtb;
      float sp = fmaxf(x, 0.f) + log1pf(expf(-fabsf(x)));
      seg_[tid] = expf(-Aexp * sp);
      sbt[tid] = sigmoidf_(rb);
    }
    __syncthreads();
    if (ci + 1 < 136) {
#pragma unroll
      for (int j = 0; j < 8; ++j) {
        const bfr* pr = gq + scan_row(b, d, ci + 1, i0 + 4 * j) * 768 + h * 64 + ch;
        rq[j] = pr[0]; rk[j] = pr[256]; rv[j] = pr[512];
      }
      if (tid < 32) { const float* ar = ab + scan_row(b, d, ci + 1, tid) * 16; ra = ar[d * 4 + h]; rb = ar[8 + d * 4 + h]; }
    }
#pragma unroll 4
    for (int i = 0; i < 32; ++i) {
      const float vcur = sv[i * 64 + vv];
      const float eg = seg_[i], bt = sbt[i];
      const float4* k4 = (const float4*)(sk + i * 64 + kg * 16);
      const float4* q4 = (const float4*)(sq + i * 64 + kg * 16);
      v2f kk[8], qq[8];
#pragma unroll
      for (int j = 0; j < 4; ++j) {
        float4 a = k4[j], c = q4[j];
        kk[2 * j] = (v2f){a.x, a.y}; kk[2 * j + 1] = (v2f){a.z, a.w};
        qq[2 * j] = (v2f){c.x, c.y}; qq[2 * j + 1] = (v2f){c.z, c.w};
      }
      v2f ka = {0.f, 0.f}, kb = {0.f, 0.f};
#pragma unroll
      for (int j = 0; j < 4; ++j) { ka += kk[2 * j] * S2[2 * j]; kb += kk[2 * j + 1] * S2[2 * j + 1]; }
      const float ks = quad_sum((ka.x + ka.y) + (kb.x + kb.y));
      const float cfac = bt * (vcur - eg * ks);
      const v2f eg2 = {eg, eg}, cf2 = {cfac, cfac};
      v2f pa = {0.f, 0.f}, pb = {0.f, 0.f};
#pragma unroll
      for (int j = 0; j < 4; ++j) {
        S2[2 * j] = kk[2 * j] * cf2 + eg2 * S2[2 * j];
        S2[2 * j + 1] = kk[2 * j + 1] * cf2 + eg2 * S2[2 * j + 1];
        pa += qq[2 * j] * S2[2 * j];
        pb += qq[2 * j + 1] * S2[2 * j + 1];
      }
      const float po = quad_sum((pa.x + pa.y) + (pb.x + pb.y));
      if (kg == 0) so[i * 64 + vv] = po;
    }
    __syncthreads();
#pragma unroll
    for (int j = 0; j < 8; ++j) {
      const int i = i0 + 4 * j;
      P[scan_row(b, d, ci, i) * 1024 + d * 256 + h * 64 + ch] = f2bf(so[i * 64 + ch]);
    }
  }
  __builtin_amdgcn_s_setprio(0);
}

__device__ __forceinline__ void hy_conv(const Params& p, int l, int stage, int task) {
  const int c = tidx();
  int n, t0;
  size_t rowbase;
  const float* G;
  { int tk = task; int b = tk >> 4; n = 256; t0 = (tk & 15) * 16; rowbase = (size_t)NLAT + b * 256; G = ((l & 1) ? WSP(float, OFF_GFC2) : WSP(float, OFF_GFC)) + (size_t)stage * 511 * 256; }
  const bfr* U = (stage == 0 ? WSP(bfr, OFF_HVC) : WSP(bfr, OFF_HZC)) - (size_t)NLAT * 256;
  float acc[16];
#pragma unroll
  for (int i = 0; i < 16; ++i) acc[i] = 0.f;
  for (int s0 = 0; s0 < n; s0 += 16) {
    float u[16], w[31];
#pragma unroll
    for (int j = 0; j < 16; ++j) u[j] = bf2f(U[(rowbase + s0 + j) * 256 + c]);
    const float* Gb = G + (size_t)(t0 - s0 - 15 + n - 1) * 256 + c;
#pragma unroll
    for (int m = 0; m < 31; ++m) w[m] = Gb[(size_t)m * 256];
#pragma unroll
    for (int i = 0; i < 16; ++i)
#pragma unroll
      for (int j = 0; j < 16; ++j) acc[i] += w[i - j + 15] * u[j];
  }
  const bfr* ph = WSP(bfr, OFF_PHY);
  const float* hw = p.in[13] + l * 3 * 768;
  const int xc = 256 + stage * 256 + c;
  float w0 = hw[xc], w1 = hw[768 + xc], w2 = hw[1536 + xc];
#pragma unroll
  for (int i = 0; i < 16; ++i) {
    int t = t0 + i;
    size_t row = rowbase + t;
    float xg = w1 * bf2f(ph[row * 768 + xc]);
    if (t > 0) xg += w0 * bf2f(ph[(row - 1) * 768 + xc]);
    if (t < n - 1) xg += w2 * bf2f(ph[(row + 1) * 768 + xc]);
    float val = xg * acc[i];
    if (stage == 0) (WSP(bfr, OFF_HZC) - (size_t)NLAT * 256)[row * 256 + c] = f2bf(val);
    else WSP(bfr, OFF_HN)[row * 1024 + 256 + c] = f2bf(val);
  }
}

__device__ __forceinline__ bf16x8 toep_frag(const unsigned* Rs, int e0) {
  const int dw = e0 >> 1;
  const unsigned sh = (unsigned)(e0 & 1) * 16u;
  unsigned d0 = Rs[dw], d1 = Rs[dw + 1], d2 = Rs[dw + 2], d3 = Rs[dw + 3], d4 = Rs[dw + 4];
  uint4 o;
  o.x = __builtin_amdgcn_alignbit(d1, d0, sh);
  o.y = __builtin_amdgcn_alignbit(d2, d1, sh);
  o.z = __builtin_amdgcn_alignbit(d3, d2, sh);
  o.w = __builtin_amdgcn_alignbit(d4, d3, sh);
  return __builtin_bit_cast(bf16x8, o);
}
__device__ __forceinline__ void hy_task(const Params& p, int l, int task, char* smemc) {
  const int tid = tidx(), lane = tid & 63, wave = tid >> 6, r = lane & 31, hf = lane >> 5;
  const int c = task >> 1, bh = task & 1;
  unsigned* Rs = (unsigned*)smemc;
  bfr* Us = (bfr*)(smemc + 16384 + 64);
  constexpr int USTR = 4104;
  const int bl = r & 3, t1l = r >> 2;
  f32x16 acc[2][2];
  __syncthreads();
  for (int i = tid; i < 2048; i += 256) {
    int b4 = i >> 9, c16 = i & 511;
    *(uint4*)(Us + b4 * USTR + c16 * 8) = *(const uint4*)(WSP(bfr, OFF_HVT) + ((size_t)(c * 8 + bh * 4 + b4)) * 4096 + c16 * 8);
  }
#pragma unroll 1
  for (int stage = 0; stage < 2; ++stage) {
    {
      const uint4* rsrc = (const uint4*)(WSP(bfr, OFF_RF) + (size_t)(l & 1) * (4 * MIB) + ((size_t)(stage * 256 + c)) * 8192);
      for (int i = tid; i < 1024; i += 256) ((uint4*)Rs)[i] = rsrc[i];
      if (tid < 8) Rs[4096 + tid] = 0u;
    }
    __syncthreads();
#pragma unroll
    for (int a = 0; a < 2; ++a)
#pragma unroll
      for (int m = 0; m < 2; ++m)
#pragma unroll
        for (int i = 0; i < 16; ++i) acc[a][m][i] = 0.f;
#pragma unroll 1
    for (int d1 = 16 * wave - 63; d1 <= 16 * wave + 15; ++d1) {
      const int eb = 4096 - 64 * d1 - r + 8 * hf;
      bf16x8 f0 = toep_frag(Rs, eb);
      bf16x8 f1 = toep_frag(Rs, eb + 16);
      bf16x8 f2 = toep_frag(Rs, eb + 32);
      bf16x8 f3 = toep_frag(Rs, eb + 48);
      bf16x8 f4 = toep_frag(Rs, eb - 32);
      bf16x8 f5 = toep_frag(Rs, eb - 16);
#pragma unroll
      for (int nt = 0; nt < 2; ++nt) {
        const int t1lo = 16 * wave + 8 * nt;
        if (t1lo + 7 - d1 < 0 || t1lo - d1 > 63) continue;
        const int s1 = t1lo + t1l - d1;
        const bool valid = (s1 >= 0) && (s1 < 64);
        const bfr* up = Us + bl * USTR + 64 * (valid ? s1 : 0) + 8 * hf;
        bf16x8 b0 = *(const bf16x8*)(up), b1 = *(const bf16x8*)(up + 16), b2 = *(const bf16x8*)(up + 32), b3 = *(const bf16x8*)(up + 48);
        if (!valid) {
#pragma unroll
          for (int i = 0; i < 8; ++i) { b0[i] = 0; b1[i] = 0; b2[i] = 0; b3[i] = 0; }
        }
        acc[nt][0] = __builtin_amdgcn_mfma_f32_32x32x16_bf16(f0, b0, acc[nt][0], 0, 0, 0);
        acc[nt][0] = __builtin_amdgcn_mfma_f32_32x32x16_bf16(f1, b1, acc[nt][0], 0, 0, 0);
        acc[nt][0] = __builtin_amdgcn_mfma_f32_32x32x16_bf16(f2, b2, acc[nt][0], 0, 0, 0);
        acc[nt][0] = __builtin_amdgcn_mfma_f32_32x32x16_bf16(f3, b3, acc[nt][0], 0, 0, 0);
        acc[nt][1] = __builtin_amdgcn_mfma_f32_32x32x16_bf16(f4, b0, acc[nt][1], 0, 0, 0);
        acc[nt][1] = __builtin_amdgcn_mfma_f32_32x32x16_bf16(f5, b1, acc[nt][1], 0, 0, 0);
        acc[nt][1] = __builtin_amdgcn_mfma_f32_32x32x16_bf16(f0, b2, acc[nt][1], 0, 0, 0);
        acc[nt][1] = __builtin_amdgcn_mfma_f32_32x32x16_bf16(f1, b3, acc[nt][1], 0, 0, 0);
      }
    }
    const bfr* gate = WSP(bfr, stage == 0 ? OFF_X1T : OFF_X2T) + ((size_t)(c * 8 + bh * 4 + bl)) * 4096;
    __syncthreads();
#pragma unroll
    for (int nt = 0; nt < 2; ++nt)
#pragma unroll
      for (int m = 0; m < 2; ++m)
#pragma unroll
        for (int g = 0; g < 4; ++g) {
          const int t = 64 * (16 * wave + 8 * nt + t1l) + 32 * m + 8 * g + 4 * hf;
          uint2 gw = *(const uint2*)(gate + t);
          float v0 = acc[nt][m][4 * g + 0] * __uint_as_float(gw.x << 16);
          float v1 = acc[nt][m][4 * g + 1] * __uint_as_float(gw.x & 0xffff0000u);
          float v2 = acc[nt][m][4 * g + 2] * __uint_as_float(gw.y << 16);
          float v3 = acc[nt][m][4 * g + 3] * __uint_as_float(gw.y & 0xffff0000u);
          uint2 o; o.x = pk2(v0, v1); o.y = pk2(v2, v3);
          *(uint2*)(Us + bl * USTR + t) = o;
        }
  }
  __syncthreads();
  for (int i = tid; i < 2048; i += 256) {
    int b4 = i >> 9, c16 = i & 511;
    *(uint4*)(WSP(bfr, OFF_HVT) + ((size_t)(c * 8 + bh * 4 + b4)) * 4096 + c16 * 8) = *(const uint4*)(Us + b4 * USTR + c16 * 8);
  }
}

__device__ __forceinline__ void attn_task(const Params& p, int l, int task, char* smemc) {
  const int tid = tidx(), lane = tid & 63, wave = tid >> 6, r = lane & 31, hf = lane >> 5;
  int b, h, q0, kbeg;
  size_t qrowbase;
  if (task < 1024) { b = task >> 7; h = (task >> 5) & 3; q0 = (task & 31) * 128; qrowbase = (size_t)b * 4096; kbeg = 0; }
  else { int tk = task - 1024; b = tk >> 3; h = (tk >> 1) & 3; q0 = (tk & 1) * 128; qrowbase = (size_t)NLAT + b * 256; kbeg = 4096; }
  bfr* Ks = (bfr*)smemc;
  bfr* Vs = Ks + 2 * 64 * 72;
  const bfr* pd = WSP(bfr, OFF_PDA);
  const bfr* vt = WSP(bfr, OFF_VT) + (size_t)((b * 4 + h) * 64) * 4352;
  const size_t qrow = qrowbase + q0 + wave * 32 + r;
  bf16x8 qf[2][2];
#pragma unroll
  for (int j = 0; j < 2; ++j)
#pragma unroll
    for (int s = 0; s < 2; ++s) qf[j][s] = *(const bf16x8*)(pd + qrow * 768 + h * 64 + j * 32 + 16 * s + 8 * hf);
  float mq = 0.f, mk = 0.f;
  for (int i = 0; i < 32; ++i) { mq = fmaxf(mq, fabsf(p.in[25][l * 32 + i])); mk = fmaxf(mk, fabsf(p.in[26][l * 32 + i])); }
  const float Mb = 5.6568542f * 1.03f * mq * mk * 1.44269504f;
  f32x16 O[2][2];
#pragma unroll
  for (int j = 0; j < 2; ++j)
#pragma unroll
    for (int d = 0; d < 2; ++d)
#pragma unroll
      for (int i = 0; i < 16; ++i) O[j][d][i] = 0.f;
  float ls[2] = {0.f, 0.f};
  const int nt = (4352 - kbeg) >> 6;
  const int lrow = tid >> 3, lpart = (tid & 7) * 8;
  uint4 rk0, rk1, rv0, rv1;
  auto kptr = [&](int k0, int rowi) -> const bfr* {
    int kidx = k0 + rowi;
    size_t krow = kidx < 4096 ? (size_t)b * 4096 + kidx : (size_t)NLAT + b * 256 + (kidx - 4096);
    return pd + krow * 768 + 256 + h * 64 + lpart;
  };
  rk0 = *(const uint4*)kptr(kbeg, lrow);
  rk1 = *(const uint4*)kptr(kbeg, lrow + 32);
  rv0 = *(const uint4*)(vt + (size_t)lrow * 4352 + kbeg + lpart);
  rv1 = *(const uint4*)(vt + (size_t)(lrow + 32) * 4352 + kbeg + lpart);
  __syncthreads();
  *(uint4*)(Ks + (lrow)*72 + lpart) = rk0;
  *(uint4*)(Ks + (lrow + 32) * 72 + lpart) = rk1;
  *(uint4*)(Vs + (lrow)*72 + lpart) = rv0;
  *(uint4*)(Vs + (lrow + 32) * 72 + lpart) = rv1;
  __syncthreads();
  for (int kt = 0; kt < nt; ++kt) {
    const int cur = kt & 1;
    if (kt + 1 < nt) {
      const int k0 = kbeg + (kt + 1) * 64;
      rk0 = *(const uint4*)kptr(k0, lrow);
      rk1 = *(const uint4*)kptr(k0, lrow + 32);
      rv0 = *(const uint4*)(vt + (size_t)lrow * 4352 + k0 + lpart);
      rv1 = *(const uint4*)(vt + (size_t)(lrow + 32) * 4352 + k0 + lpart);
    }
#pragma unroll
    for (int sub = 0; sub < 2; ++sub) {
      bf16x8 vf[2][2];
#pragma unroll
      for (int d = 0; d < 2; ++d)
#pragma unroll
        for (int s = 0; s < 2; ++s) vf[d][s] = *(const bf16x8*)(Vs + (cur * 64 + d * 32 + r) * 72 + sub * 32 + 16 * s + 8 * hf);
#pragma unroll
      for (int j = 0; j < 2; ++j) {
        bf16x8 kf0 = *(const bf16x8*)(Ks + (cur * 64 + sub * 32 + r) * 72 + j * 32 + 8 * hf);
        bf16x8 kf1 = *(const bf16x8*)(Ks + (cur * 64 + sub * 32 + r) * 72 + j * 32 + 16 + 8 * hf);
        f32x16 S;
#pragma unroll
        for (int i = 0; i < 16; ++i) S[i] = -Mb;
        __builtin_amdgcn_s_setprio(1);
        S = __builtin_amdgcn_mfma_f32_32x32x16_bf16(kf0, qf[j][0], S, 0, 0, 0);
        S = __builtin_amdgcn_mfma_f32_32x32x16_bf16(kf1, qf[j][1], S, 0, 0, 0);
        __builtin_amdgcn_s_setprio(0);
#pragma unroll
        for (int i = 0; i < 16; ++i) S[i] = __builtin_amdgcn_exp2f(S[i]);
        v2f ps2 = {0.f, 0.f};
#pragma unroll
        for (int i = 0; i < 8; ++i) ps2 += (v2f){S[2 * i], S[2 * i + 1]};
        ls[j] += ps2.x + ps2.y;
        unsigned pw[8];
#pragma unroll
        for (int i = 0; i < 8; ++i) pw[i] = pk2(S[2 * i], S[2 * i + 1]);
        bf16x8 pf0 = __builtin_bit_cast(bf16x8, (uint4){pw[0], pw[1], pw[2], pw[3]});
        bf16x8 pf1 = __builtin_bit_cast(bf16x8, (uint4){pw[4], pw[5], pw[6], pw[7]});
        __builtin_amdgcn_s_setprio(1);
#pragma unroll
        for (int d = 0; d < 2; ++d) {
          O[j][d] = __builtin_amdgcn_mfma_f32_32x32x16_bf16(vf[d][0], pf0, O[j][d], 0, 0, 0);
          O[j][d] = __builtin_amdgcn_mfma_f32_32x32x16_bf16(vf[d][1], pf1, O[j][d], 0, 0, 0);
        }
        __builtin_amdgcn_s_setprio(0);
      }
    }
    if (kt + 1 < nt) {
      const int nx = cur ^ 1;
      *(uint4*)(Ks + (nx * 64 + lrow) * 72 + lpart) = rk0;
      *(uint4*)(Ks + (nx * 64 + lrow + 32) * 72 + lpart) = rk1;
      *(uint4*)(Vs + (nx * 64 + lrow) * 72 + lpart) = rv0;
      *(uint4*)(Vs + (nx * 64 + lrow + 32) * 72 + lpart) = rv1;
    }
    __syncthreads();
  }
  ls[0] += __shfl_xor(ls[0], 32);
  ls[1] += __shfl_xor(ls[1], 32);
  const float* lp = p.in[27] + l * 128;
  float d01 = 0.f, d23 = 0.f;
  for (int i = 0; i < 32; ++i) { d01 += lp[i] * lp[32 + i]; d23 += lp[64 + i] * lp[96 + i]; }
  const float lam_init = 0.8f - 0.6f * expf(-0.3f * (float)l);
  const float lam = expf(d01) - expf(d23) + lam_init;
  const float i0 = 1.f / ls[0], i1 = lam / ls[1];
  float ss = 0.f;
#pragma unroll
  for (int d = 0; d < 2; ++d)
#pragma unroll
    for (int i = 0; i < 16; ++i) { float o = O[0][d][i] * i0 - O[1][d][i] * i1; O[0][d][i] = o; ss += o * o; }
  ss += __shfl_xor(ss, 32);
  const float rn = rsqrtf(ss * (1.f / 64.f) + 1e-6f) * (1.f - lam_init);
  const float* sw = p.in[28] + l * 64;
  bfr* op = WSP(bfr, OFF_HN) + qrow * 1024 + 768 + h * 64;
#pragma unroll
  for (int d = 0; d < 2; ++d)
#pragma unroll
    for (int g = 0; g < 4; ++g) {
      const int dv = d * 32 + 8 * g + 4 * hf;
      float4 w4 = *(const float4*)(sw + dv);
      uint2 o;
      o.x = pk2(O[0][d][4 * g + 0] * rn * w4.x, O[0][d][4 * g + 1] * rn * w4.y);
      o.y = pk2(O[0][d][4 * g + 2] * rn * w4.z, O[0][d][4 * g + 3] * rn * w4.w);
      *(uint2*)(op + dv) = o;
    }
}

__device__ __forceinline__ void finish_task(const Params& p, int l, int task  , char* smemc) {
  const int tid = tidx();
  if (task < 1024) {
    bfr* tile = (bfr*)smemc;
    const int row0 = task * 32, bb = row0 >> 12, t0 = row0 & 4095;
    const bfr* src = WSP(bfr, OFF_HVT) + ((size_t)(tid * 8 + bb)) * 4096 + t0;
#pragma unroll
    for (int i = 0; i < 4; ++i) *(uint4*)(tile + tid * 40 + 8 * i) = ((const uint4*)src)[i];
    __syncthreads();
    const int rr = tid >> 3, part = tid & 7;
    bfr* dst = WSP(bfr, OFF_HN) + (size_t)(row0 + rr) * 1024 + 256 + part * 32;
#pragma unroll
    for (int i = 0; i < 4; ++i) {
      unsigned w[4];
#pragma unroll
      for (int q = 0; q < 4; ++q) {
        const int c0 = part * 32 + i * 8 + q * 2;
        w[q] = (unsigned)tile[c0 * 40 + rr] | ((unsigned)tile[(c0 + 1) * 40 + rr] << 16);
      }
      ((uint4*)dst)[i] = (uint4){w[0], w[1], w[2], w[3]};
    }
    __syncthreads();
  }
  const int rr = tid >> 3, hd = tid & 7;
  const size_t row = (size_t)task * 32 + rr;
  const bfr *pf, *pb, *pgt;
  const float* nw;
  bfr* dst;
  if (hd < 4) {
    const bfr* r = WSP(bfr, OFF_PGDN) + row * 1024;
    pf = r + hd * 64; pb = r + 256 + hd * 64; pgt = r + 768 + hd * 64;
    nw = p.in[12] + l * 64; dst = WSP(bfr, OFF_HN) + row * 1024 + hd * 64;
  } else {
    const int hh = hd - 4;
    const bfr* r = WSP(bfr, OFF_PHG) + row * 1280;
    pf = r + 512 + hh * 64; pb = r + 768 + hh * 64; pgt = r + 1024 + hh * 64;
    nw = p.in[24] + l * 64; dst = WSP(bfr, OFF_HN) + row * 1024 + 512 + hh * 64;
  }
  uint4 vf[8], vb[8], vg[8];
#pragma unroll
  for (int i = 0; i < 8; ++i) { vf[i] = ((const uint4*)pf)[i]; vb[i] = ((const uint4*)pb)[i]; vg[i] = ((const uint4*)pgt)[i]; }
  float o[64];
  float ss = 0.f;
#pragma unroll
  for (int i = 0; i < 8; ++i) {
    const unsigned a[4] = {vf[i].x, vf[i].y, vf[i].z, vf[i].w};
    const unsigned c[4] = {vb[i].x, vb[i].y, vb[i].z, vb[i].w};
#pragma unroll
    for (int q = 0; q < 4; ++q) {
      float lo = __uint_as_float(a[q] << 16) + __uint_as_float(c[q] << 16);
      float hi = __uint_as_float(a[q] & 0xffff0000u) + __uint_as_float(c[q] & 0xffff0000u);
      o[8 * i + 2 * q] = lo; o[8 * i + 2 * q + 1] = hi;
      ss += lo * lo + hi * hi;
    }
  }
  const float rn = rsqrtf(ss * (1.f / 64.f) + 1e-6f);
#pragma unroll
  for (int i = 0; i < 8; ++i) {
    const unsigned g[4] = {vg[i].x, vg[i].y, vg[i].z, vg[i].w};
    unsigned w[4];
#pragma unroll
    for (int q = 0; q < 4; ++q) {
      float g0 = __uint_as_float(g[q] << 16), g1 = __uint_as_float(g[q] & 0xffff0000u);
      float y0 = o[8 * i + 2 * q] * rn * nw[8 * i + 2 * q] * siluf_(g0);
      float y1 = o[8 * i + 2 * q + 1] * rn * nw[8 * i + 2 * q + 1] * siluf_(g1);
      w[q] = pk2(y0, y1);
    }
    ((uint4*)dst)[i] = (uint4){w[0], w[1], w[2], w[3]};
  }
}

__global__ void __launch_bounds__(256, 2) mega(Params p) {
  extern __shared__ __attribute__((aligned(1024))) char smemc[];
  __shared__ int s_task;
  float* smem = (float*)smemc;
  cg::grid_group grid = cg::this_grid();
  unsigned* ctr = WSP(unsigned, OFF_CTR);
  const int G = gridDim.x, bid = blockIdx.x;

  __shared__ uint4 xb_words;
  if (threadIdx.x == 0) xb_words = make_uint4(0u, 0u, 0u, 0u);
  __syncthreads();
  XcdBarrier xb = xcd_barrier_post(WSP(unsigned, OFF_CTR) + 1024, (volatile LAS unsigned*)&xb_words);
  phase_mod(p, smem);
  for (int task = G - 1 - bid; task < 272; task += G) { int l0 = 0; asm volatile("" : "+s"(l0)); filt_task(p, l0, task, smem); }
  grid.sync();

  for (int l = 0; l < 4; ++l) {
    const bool want_ctx = l < 3;
    for (int task = bid; task < 3296; task += 4 * G) {
      int lq = l; asm volatile("" : "+s"(lq));
      wconv_quad(p, lq, task, task + G < 3296 ? task + G : -1, task + 2 * G < 3296 ? task + 2 * G : -1, task + 3 * G < 3296 ? task + 3 * G : -1, smem);
    }
    for (int task = bid; task < 1088; task += G) {
      int lq = l; asm volatile("" : "+s"(lq));
      norm_rows(p, lq, 0, task);
    }
    xcd_barrier(xb);
    { int lq = l; asm volatile("" : "+s"(lq));
    gemm_phase<0>(p, lq, WSP(bfr, OFF_HN), 1024, WSP(bfr, OFF_WIN), 1024, 136, 31, smemc); }
    xcd_barrier(xb);
    for (int task = bid; task < 1088 + 2176; task += G) {
      int lq = l; asm volatile("" : "+s"(lq));
      if (task < 2176) gdn_solve_task(p, lq, task, smemc);
      else prep_task(p, lq, task - 2176, smemc);
    }
    xcd_barrier(xb);
    {
      const int nhy = want_ctx ? 640 : 512, nat = want_ctx ? 1088 : 1024;
      const int nflt = want_ctx ? 272 : 0;
      const int total = 128 + nhy + nat + nflt;
      while (true) {
        __syncthreads();
        if (threadIdx.x == 0) s_task = (int)atomicAdd(&ctr[l * 2], 1u);
        __syncthreads();
        int task = s_task;
        if (task >= total) break;
        int lq = l; asm volatile("" : "+s"(lq));
        if (task < 64) gdn_chunked(p, lq, task, smemc);
        else if (task < 128) hgrn_chunked(p, lq, task - 64, smemc);
        else if (task < 128 + 512) hy_task(p, lq, task - 128, smemc);
        else if (task < 128 + nhy) hy_conv(p, lq, 0, task - 640);
        else if (task < 128 + nhy + nat) attn_task(p, lq, task - 128 - nhy, smemc);
        else filt_task(p, lq + 1, task - 128 - nhy - nat, smem);
      }
    }
    xcd_barrier(xb);
    {
      const int nhy = want_ctx ? 128 : 0, nfin = want_ctx ? 1088 : 1024;
      const int total = nhy + nfin;
      while (true) {
        __syncthreads();
        if (threadIdx.x == 0) s_task = (int)atomicAdd(&ctr[l * 2 + 1], 1u);
        __syncthreads();
        int task = s_task;
        if (task >= total) break;
        int lq = l; asm volatile("" : "+s"(lq));
        if (task < nhy) hy_conv(p, lq, 1, task);
        else finish_task(p, lq, task - nhy, smemc);
      }
    }
    xcd_barrier(xb);
    const int mt = want_ctx ? 136 : 128;
    { int lq = l; asm volatile("" : "+s"(lq));
    gemm_phase<1>(p, lq, WSP(bfr, OFF_HN), 1024, WSP(bfr, OFF_WOUT), 1024, mt, 8, smemc); }
    xcd_barrier(xb);
    for (int task = bid; task < mt * 8; task += G) { int lq = l; asm volatile("" : "+s"(lq)); norm_rows(p, lq, 1, task); }
    xcd_barrier(xb);
    { int lq = l; asm volatile("" : "+s"(lq));
    gemm_phase<2>(p, lq, WSP(bfr, OFF_HN), 1024, WSP(bfr, OFF_W1), 1024, mt, 32, smemc); }
    xcd_barrier(xb);
    { int lq = l; asm volatile("" : "+s"(lq));
    gemm_phase<3>(p, lq, WSP(bfr, OFF_HID), 4096, WSP(bfr, OFF_W2), 4096, mt, 8, smemc); }
    if (l < 3) xcd_barrier(xb);
  }
}

extern "C" void kernel_launch(void* const* d_in, const int* in_sizes, int n_in, void* d_out, int out_size, void* d_ws, size_t ws_size,
                              hipStream_t stream) {
  static int grid_blocks = 0;
  if (!grid_blocks) {
    int dev = 0, cus = 0, per_cu = 0;
    hipGetDevice(&dev);
    hipDeviceGetAttribute(&cus, hipDeviceAttributeMultiprocessorCount, dev);
    (void)hipFuncSetAttribute((const void*)mega, hipFuncAttributeMaxDynamicSharedMemorySize, LDS_BYTES);
    hipOccupancyMaxActiveBlocksPerMultiprocessor(&per_cu, mega, 256, LDS_BYTES);
    if (per_cu < 1) per_cu = 1;
    if (per_cu > 2) per_cu = 2;
    grid_blocks = cus * per_cu;
    if (ws_size < WS_NEED) fprintf(stderr, "kernel_launch: workspace too small: %zu < %zu\n", ws_size, (size_t)WS_NEED);
  }
  Params p{};
  for (int i = 0; i < 32; ++i) p.in[i] = (const float*)d_in[i];
  p.out = (float*)d_out;
  p.ws = (unsigned char*)d_ws;
  hipMemsetAsync(d_ws, 0, 32768, stream);
  void* args[] = {&p};
  hipError_t e = hipLaunchCooperativeKernel((void*)mega, dim3(grid_blocks), dim3(256), args, LDS_BYTES, stream);
  if (e != hipSuccess) fprintf(stderr, "cooperative launch failed: %s (grid %d)\n", hipGetErrorString(e), grid_blocks);
}
```
